# Optimizing an MI355X kernel written in HIP

```python
import math
import jax, jax.numpy as jnp
from jax import lax
import numpy as np

D_MODEL = 1024
BATCH = 4
SEQ = 4096
DEPTH = 1
DEC_BATCH = 32
DEC_SEQ = 8
PAST_LEN = 8192
PAGE_SIZE = 128

HEAD_DIM = 64
HEADS_PER_GROUP = 4
ATTN_GROUPS = ((128, 1), (512, 4), (2048, 16))
N_HEADS = HEADS_PER_GROUP * len(ATTN_GROUPS)
ATTN_WIDTH = N_HEADS * HEAD_DIM
ATTN_OUT_WIDTH = HEADS_PER_GROUP * HEAD_DIM
N_BUCKETS = 32
MAX_DISTANCE = 2048
QUERY_BLOCK = 128
POOL_WINDOWS = (2, 4, 8, 16)
POOL_WIDTH = D_MODEL // 2
POOL_GROUP_WIDTH = POOL_WIDTH // len(POOL_WINDOWS)
POOL_STATE = max(POOL_WINDOWS) - 1
D_FF = ((8 * D_MODEL // 3 + 127) // 128) * 128
EPS = 1e-6
IN_WIDTH = 3 * ATTN_WIDTH + POOL_WIDTH + 2 * D_MODEL
IN_SPLITS = (ATTN_WIDTH, 2 * ATTN_WIDTH, 3 * ATTN_WIDTH,
             3 * ATTN_WIDTH + POOL_WIDTH, 3 * ATTN_WIDTH + POOL_WIDTH + D_MODEL)

kernel_name = "hybrid_dilated_attn_pool_macaron_step"


def _rmsnorm(x, g):
    xf = x.astype(jnp.float32)
    y = xf * lax.rsqrt(jnp.mean(xf * xf, axis=-1, keepdims=True) + EPS)
    return (y * g.astype(jnp.float32)).astype(x.dtype)


def _head_rmsnorm(x, g):
    xf = x.astype(jnp.float32)
    y = xf * lax.rsqrt(jnp.mean(xf * xf, axis=-1, keepdims=True) + EPS)
    return (y * g.astype(jnp.float32)[None, None]).astype(x.dtype)


def _swiglu(x, w_up, w_down):
    gate, up = jnp.split(x @ w_up, 2, axis=-1)
    return (jax.nn.silu(gate) * up) @ w_down


def _t5_buckets(distance):
    max_exact = N_BUCKETS // 2
    d = np.asarray(distance, dtype=np.int32)
    ratio = np.log(np.maximum(d, 1).astype(np.float32) / np.float32(max_exact))
    large = max_exact + (ratio / np.float32(math.log(MAX_DISTANCE / max_exact))
                         * (N_BUCKETS - max_exact)).astype(np.int32)
    large = np.minimum(large, N_BUCKETS - 1)
    return np.where(d < max_exact, d, large).astype(np.int32)


def _dilated_attention(q, k, v, past_kv, rel_bias_table):
    B, T = q.shape[:2]
    qb = math.gcd(T, QUERY_BLOCK)
    n_blocks = T // qb
    scale = HEAD_DIM ** -0.5
    neg = jnp.finfo(jnp.float32).min
    kv_new = jnp.stack([k, v], axis=2)
    kv_alls, offsets, biases, new_state = [], [], [], []
    for g, (win, dil) in enumerate(ATTN_GROUPS):
        kv_g = kv_new[:, :, :, g * HEADS_PER_GROUP:(g + 1) * HEADS_PER_GROUP]
        if past_kv is None:
            kv_all = kv_g
            keep = min(win, T)
        else:
            kv_all = jnp.concatenate([past_kv[g].astype(kv_g.dtype), kv_g], axis=1)
            keep = past_kv[g].shape[1]
        new_state.append(kv_all[:, kv_all.shape[1] - keep:])
        kv_alls.append(kv_all)
        offsets.append(kv_all.shape[1] - T)
        dist = dil * np.arange(win // dil + 1)
        biases.append(rel_bias_table[_t5_buckets(dist)][:, g * HEADS_PER_GROUP:(g + 1) * HEADS_PER_GROUP]
                      .astype(jnp.float32))

    def block(i):
        start = i * qb
        q_blk = lax.dynamic_slice_in_dim(q, start, qb, axis=1)
        outs, lses = [], []
        for g, (win, dil) in enumerate(ATTN_GROUPS):
            n_keys = win // dil + 1
            idx = offsets[g] + start + jnp.arange(qb)[:, None] - dil * jnp.arange(n_keys)[None, :]
            valid = idx >= 0
            kv_blk = jnp.take(kv_alls[g], jnp.maximum(idx, 0), axis=1)
            qg = q_blk[:, :, g * HEADS_PER_GROUP:(g + 1) * HEADS_PER_GROUP].astype(jnp.float32)
            logits = jnp.einsum('bqhd,bqjhd->bqjh', qg, kv_blk[:, :, :, 0].astype(jnp.float32)) * scale
            logits = jnp.where(valid[None, :, :, None], logits + biases[g][None, None], neg)
            m = jnp.max(logits, axis=2, keepdims=True)
            p = jnp.exp(logits - m)
            denom = jnp.sum(p, axis=2)
            o = jnp.einsum('bqjh,bqjhd->bqhd', p, kv_blk[:, :, :, 1].astype(jnp.float32)) / denom[..., None]
            outs.append(o)
            lses.append(m[:, :, 0] + jnp.log(denom))
        wts = jax.nn.softmax(jnp.stack(lses, axis=0), axis=0)
        o = jnp.sum(wts[..., None] * jnp.stack(outs, axis=0), axis=0)
        return o.astype(q.dtype)

    o = lax.map(block, jnp.arange(n_blocks))
    o = o.transpose(1, 0, 2, 3, 4).reshape(B, T, ATTN_OUT_WIDTH)
    return o, new_state


def _multiscale_pool(u, past, pos0, w_group, scale):
    B, T, C = u.shape
    ue = jnp.concatenate([past.astype(u.dtype), u], axis=1)
    cs = jnp.cumsum(ue.astype(jnp.float32), axis=1)
    cs = jnp.concatenate([jnp.zeros((B, 1, C), jnp.float32), cs], axis=1)
    pos = pos0 + jnp.arange(T)
    outs = []
    for gi, win in enumerate(POOL_WINDOWS):
        sl = slice(gi * POOL_GROUP_WIDTH, (gi + 1) * POOL_GROUP_WIDTH)
        s = cs[:, POOL_STATE + 1:, sl] - cs[:, POOL_STATE + 1 - win:POOL_STATE + 1 - win + T, sl]
        cnt = jnp.minimum(pos + 1, win).astype(jnp.float32)[None, :, None]
        outs.append(s / cnt - u[:, :, sl].astype(jnp.float32))
    d = jnp.stack(outs, axis=2)
    y = jnp.einsum('btgc,gcd->btgd', d, w_group.astype(jnp.float32)).reshape(B, T, C)
    y = y * scale.astype(jnp.float32)
    return y.astype(u.dtype), ue[:, ue.shape[1] - POOL_STATE:]


def _layer(x, pos0, past_kv, past_pool, w, rel_bias_table):
    B, T, _ = x.shape
    x = x + 0.5 * _swiglu(_rmsnorm(x, w["norm_ffn1"]), w["ffn1_w_up"], w["ffn1_w_down"])
    h = _rmsnorm(x, w["norm_mix"])
    q, k, v, u, g_a, g_b = jnp.split(h @ w["w_in"], IN_SPLITS, axis=-1)
    q = _head_rmsnorm(q.reshape(B, T, N_HEADS, HEAD_DIM), w["q_norm"])
    k = _head_rmsnorm(k.reshape(B, T, N_HEADS, HEAD_DIM), w["k_norm"])
    v = v.reshape(B, T, N_HEADS, HEAD_DIM)
    attn, new_kv = _dilated_attention(q, k, v, past_kv, rel_bias_table)
    pooled, new_pool = _multiscale_pool(u, past_pool, pos0, w["pool_w_group"], w["pool_scale"])
    merged = (jax.nn.sigmoid(g_a) * (attn @ w["w_attn_branch"])
              + jax.nn.sigmoid(g_b) * (pooled @ w["w_pool_branch"]))
    x = x + merged @ w["w_out"]
    x = x + 0.5 * _swiglu(_rmsnorm(x, w["norm_ffn2"]), w["ffn2_w_up"], w["ffn2_w_down"])
    return x, new_kv, new_pool


def setup_inputs(seed: int = 0) -> dict:
    key = jax.random.key(seed)
    ks = jax.random.split(key, 24)
    f32 = jnp.float32

    def nrm(k, shape, s=1.0):
        return jax.random.normal(k, shape, f32) * s

    def gain(k, shape):
        return 1.0 + 0.05 * jax.random.normal(k, shape, f32)

    win_len = [min(win, PAST_LEN) for win, _ in ATTN_GROUPS]
    return {
        "x_prompt": nrm(ks[0], (BATCH, SEQ, D_MODEL)),
        "x_sample": nrm(ks[1], (DEC_BATCH, DEC_SEQ, D_MODEL)),
        "cache_kv_w128": nrm(ks[2], (DEPTH, DEC_BATCH, win_len[0], 2, HEADS_PER_GROUP, HEAD_DIM)),
        "cache_kv_w512": nrm(ks[3], (DEPTH, DEC_BATCH, win_len[1], 2, HEADS_PER_GROUP, HEAD_DIM)),
        "cache_kv_w2048": nrm(ks[4], (DEPTH, DEC_BATCH, win_len[2], 2, HEADS_PER_GROUP, HEAD_DIM)),
        "state_pool": nrm(ks[5], (DEPTH, DEC_BATCH, POOL_STATE, POOL_WIDTH)),
        "rel_bias_table": nrm(ks[6], (N_BUCKETS, N_HEADS), 0.5),
        "norm_ffn1": gain(ks[7], (DEPTH, D_MODEL)),
        "ffn1_w_up": nrm(ks[8], (DEPTH, D_MODEL, 2 * D_FF), D_MODEL ** -0.5),
        "ffn1_w_down": nrm(ks[9], (DEPTH, D_FF, D_MODEL), D_FF ** -0.5),
        "norm_mix": gain(ks[10], (DEPTH, D_MODEL)),
        "w_in": nrm(ks[11], (DEPTH, D_MODEL, IN_WIDTH), D_MODEL ** -0.5),
        "q_norm": gain(ks[12], (DEPTH, N_HEADS, HEAD_DIM)),
        "k_norm": gain(ks[13], (DEPTH, N_HEADS, HEAD_DIM)),
        "pool_w_group": nrm(ks[14], (DEPTH, len(POOL_WINDOWS), POOL_GROUP_WIDTH, POOL_GROUP_WIDTH),
                            POOL_GROUP_WIDTH ** -0.5),
        "pool_scale": gain(ks[15], (DEPTH, POOL_WIDTH)),
        "w_attn_branch": nrm(ks[16], (DEPTH, ATTN_OUT_WIDTH, D_MODEL), ATTN_OUT_WIDTH ** -0.5),
        "w_pool_branch": nrm(ks[17], (DEPTH, POOL_WIDTH, D_MODEL), POOL_WIDTH ** -0.5),
        "w_out": nrm(ks[18], (DEPTH, D_MODEL, D_MODEL), D_MODEL ** -0.5),
        "norm_ffn2": gain(ks[19], (DEPTH, D_MODEL)),
        "ffn2_w_up": nrm(ks[20], (DEPTH, D_MODEL, 2 * D_FF), D_MODEL ** -0.5),
        "ffn2_w_down": nrm(ks[21], (DEPTH, D_FF, D_MODEL), D_FF ** -0.5),
    }


def reference(x_prompt, x_sample, cache_kv_w128, cache_kv_w512, cache_kv_w2048, state_pool,
              rel_bias_table, norm_ffn1, ffn1_w_up, ffn1_w_down, norm_mix, w_in, q_norm, k_norm,
              pool_w_group, pool_scale, w_attn_branch, w_pool_branch, w_out,
              norm_ffn2, ffn2_w_up, ffn2_w_down):
    xp, xs = x_prompt, x_sample
    kv_p, kv_s = ([], [], []), ([], [], [])
    pool_p, pool_s = [], []
    for layer in range(DEPTH):
        w = dict(norm_ffn1=norm_ffn1[layer], ffn1_w_up=ffn1_w_up[layer], ffn1_w_down=ffn1_w_down[layer],
                 norm_mix=norm_mix[layer], w_in=w_in[layer], q_norm=q_norm[layer], k_norm=k_norm[layer],
                 pool_w_group=pool_w_group[layer], pool_scale=pool_scale[layer],
                 w_attn_branch=w_attn_branch[layer], w_pool_branch=w_pool_branch[layer],
                 w_out=w_out[layer], norm_ffn2=norm_ffn2[layer], ffn2_w_up=ffn2_w_up[layer],
                 ffn2_w_down=ffn2_w_down[layer])
        zero_pool = jnp.zeros((xp.shape[0], POOL_STATE, POOL_WIDTH), xp.dtype)
        xp, nkv_p, npool_p = _layer(xp, 0, None, zero_pool, w, rel_bias_table)
        past = (cache_kv_w128[layer], cache_kv_w512[layer], cache_kv_w2048[layer])
        xs, nkv_s, npool_s = _layer(xs, PAST_LEN, past, state_pool[layer], w, rel_bias_table)
        for g in range(len(ATTN_GROUPS)):
            kv_p[g].append(nkv_p[g])
            kv_s[g].append(nkv_s[g])
        pool_p.append(npool_p)
        pool_s.append(npool_s)
    kv128_prompt = jnp.stack(kv_p[0], axis=0)
    kv512_prompt = jnp.stack(kv_p[1], axis=0)
    kv2048_prompt = jnp.stack(kv_p[2], axis=0)
    kv128_sample = jnp.stack(kv_s[0], axis=0)
    kv512_sample = jnp.stack(kv_s[1], axis=0)
    kv2048_sample = jnp.stack(kv_s[2], axis=0)
    pool_prompt = jnp.stack(pool_p, axis=0)
    pool_sample = jnp.stack(pool_s, axis=0)
    return (xp, xs, kv128_prompt, kv512_prompt, kv2048_prompt, pool_prompt,
            kv128_sample, kv512_sample, kv2048_sample, pool_sample)
```

```cpp
#include <hip/hip_runtime.h>
#include <cstdio>
#include <cstdint>

namespace pg8 {
#define PG8_LAS __attribute__((address_space(3)))
typedef unsigned short bf16_t;
typedef short bf16x8 __attribute__((ext_vector_type(8)));
typedef float f32x4 __attribute__((ext_vector_type(4)));
typedef unsigned u32x4 __attribute__((ext_vector_type(4)));
constexpr int BM = 256, BK = 64, HALF = 128, HTB = HALF * BK * 2  , STAGE_BYTES = 8 * HTB, NXCD = 8, WGM = 8;

__host__ __device__ __forceinline__ int lds_byte(int r, int c) { const int st = (r >> 4) * 2 + (c >> 5), rr = r & 15, cc = c & 31, ob = rr * 64 + cc * 2; return st * 1024 + (ob ^ (((ob >> 9) & 1) << 5)); }
__host__ __device__ __forceinline__ void stage_rc(int b, int& R, int& C) { const int st = b / 1024, sb = b % 1024, swz = sb ^ (((sb >> 9) & 1) << 5); R = (st >> 1) * 16 + swz / 64; C = (st & 1) * 32 + (swz % 64) / 2; }
__host__ __device__ __forceinline__ int perm32(int rho) { const int n = rho >> 4, i = rho & 15; return 8 * (i >> 2) + 4 * n + (i & 3); }

struct Unit { int pm, pn; };
struct Gemm { const bf16_t* A; const bf16_t* Bt; int M, N, K; };

struct StaticOrder {
    int nM, nN, nwg, G, c;
    __host__ __device__ void init(int M, int N, int G_, int c_) { nM = M / BM; nN = N / BM; nwg = nM * nN; G = G_; c = c_; }
    __host__ __device__ bool next(int i, Unit& u) const {
        const long L = (long)i * G + c; if (L >= nwg) return false;
        int wgid = (int)L; { const int q = nwg / NXCD, r = nwg % NXCD, xcd = wgid % NXCD, off = wgid / NXCD; wgid = (xcd < r ? xcd * (q + 1) : r * (q + 1) + (xcd - r) * q) + off; }
        const int nig = WGM * nN, gid = wgid / nig, fm = gid * WGM, gsz = (nM - fm) < WGM ? (nM - fm) : WGM;
        u.pm = fm + ((wgid % nig) % gsz); u.pn = (wgid % nig) / gsz; return true;
    }
    __device__ __forceinline__ void a_ready(const Unit&) const {}
    __device__ __forceinline__ void done(const Unit&) const {}
};


typedef float f32x2 __attribute__((ext_vector_type(2)));
typedef __bf16 bf16x2_t __attribute__((ext_vector_type(2)));
__device__ __forceinline__ unsigned cvt_pk_bf16(float lo, float hi) { f32x2 v = {lo, hi}; bf16x2_t b = __builtin_convertvector(v, bf16x2_t); return __builtin_bit_cast(unsigned, b); }
__device__ __forceinline__ u32x4 pack8(const f32x4 a, const f32x4 b) { u32x4 w; w.x = cvt_pk_bf16(a[0], a[1]); w.y = cvt_pk_bf16(a[2], a[3]); w.z = cvt_pk_bf16(b[0], b[1]); w.w = cvt_pk_bf16(b[2], b[3]); return w; }
__device__ __forceinline__ float bf2f(unsigned short h) { return __uint_as_float((unsigned)h << 16); }
constexpr float RMS_EPS = 1e-6f;
constexpr float LOG2E = 1.4426950408889634f;
__device__ __forceinline__ float rstd_from_partials(const float* ssp, int row) {
    const f32x4* p = (const f32x4*)(ssp + (size_t)row * 16);
    const f32x4 a = p[0], b = p[1], c = p[2], d = p[3];
    const float s = (((a[0] + a[1]) + (a[2] + a[3])) + ((b[0] + b[1]) + (b[2] + b[3]))) + (((c[0] + c[1]) + (c[2] + c[3])) + ((d[0] + d[1]) + (d[2] + d[3])));
    return __builtin_amdgcn_rsqf(s * (1.0f / 1024.0f) + RMS_EPS);
}
__device__ __forceinline__ float sigmoidf_fast(float x) { return __builtin_amdgcn_rcpf(1.0f + __builtin_amdgcn_exp2f(-x * LOG2E)); }

template <bool PARTIAL> struct EpiSwiglu {
    static constexpr bool PERM = true, AFTER_DRAIN = false;
    bf16_t* H; const float* rs;
    __device__ __forceinline__ void operator()(const f32x4 (&acc)[2][2][4][2], const Unit& u, int wr, int wc, int fr, int fq) const {
        const int row0 = u.pm * BM + wr * 64 + fr, col0 = u.pn * 128 + wc * 32 + 8 * fq;
#pragma unroll
        for (int ai = 0; ai < 2; ++ai)
#pragma unroll
            for (int m = 0; m < 4; ++m) {
                const int row = row0 + ai * HALF + m * 16;
                const float r = PARTIAL ? rstd_from_partials(rs, row) : rs[row];
                f32x4 o[2];
#pragma unroll
                for (int n = 0; n < 2; ++n) {
                    const f32x4 g = acc[ai][0][m][n] * r, up = acc[ai][1][m][n] * r;
#pragma unroll
                    for (int e = 0; e < 4; ++e) o[n][e] = g[e] * sigmoidf_fast(g[e]) * up[e];
                }
                *(u32x4*)(H + (size_t)row * 2816 + col0) = pack8(o[0], o[1]);
            }
    }
};

template <int MODE> struct EpiResid {
    static constexpr bool PERM = true, AFTER_DRAIN = false;
    const float* xp; const float* xs; float* X1; bf16_t* XB; float* ssp; float* out;
    __device__ __forceinline__ void operator()(const f32x4 (&acc)[2][2][4][2], const Unit& u, int wr, int wc, int fr, int fq) const {
        const int row0 = u.pm * BM + wr * 64 + fr, col0 = u.pn * BM + wc * 32 + 8 * fq;
        const float alpha = (MODE == 1) ? 1.0f : 0.5f;
#pragma unroll
        for (int ai = 0; ai < 2; ++ai)
#pragma unroll
            for (int m = 0; m < 4; ++m) {
                const int row = row0 + ai * HALF + m * 16;
                const float* bp = (MODE == 0) ? ((row < 16384) ? xp + (size_t)row * 1024 : xs + (size_t)(row - 16384) * 1024) : X1 + (size_t)row * 1024;
                float ss = 0.f;
#pragma unroll
                for (int bj = 0; bj < 2; ++bj) {
                    const int col = col0 + bj * HALF;
                    const f32x4 b0 = *(const f32x4*)(bp + col), b1 = *(const f32x4*)(bp + col + 4);
                    const f32x4 v0 = b0 + acc[ai][bj][m][0] * alpha, v1 = b1 + acc[ai][bj][m][1] * alpha;
                    if (MODE == 2) { *(f32x4*)(out + (size_t)row * 1024 + col) = v0; *(f32x4*)(out + (size_t)row * 1024 + col + 4) = v1; }
                    else {
                        *(f32x4*)(X1 + (size_t)row * 1024 + col) = v0; *(f32x4*)(X1 + (size_t)row * 1024 + col + 4) = v1;
                        *(u32x4*)(XB + (size_t)row * 1024 + col) = pack8(v0, v1);
                        ss += ((v0[0] * v0[0] + v0[1] * v0[1]) + (v0[2] * v0[2] + v0[3] * v0[3])) + ((v1[0] * v1[0] + v1[1] * v1[1]) + (v1[2] * v1[2] + v1[3] * v1[3]));
                    }
                }
                if (MODE != 2) { ss += __shfl_xor(ss, 16); ss += __shfl_xor(ss, 32); if (fq == 0) ssp[(size_t)row * 16 + u.pn * 4 + wc] = ss; }
            }
    }
};

struct EpiIn {
    static constexpr bool PERM = true, AFTER_DRAIN = false;
    const float* ssp; bf16_t *Q, *K, *V; float* U; bf16_t *GA, *GB; const float *qn, *kn; float* out;
    __device__ __forceinline__ void operator()(const f32x4 (&acc)[2][2][4][2], const Unit& u, int wr, int wc, int fr, int fq) const {
        const int row0 = u.pm * BM + wr * 64 + fr, pn = u.pn;
        constexpr size_t O_KVP[3] = {17039360u, 17301504u, 18350080u}, O_KVS[3] = {22575104u, 24672256u, 33060864u};
        constexpr size_t O_POOLP = 22544384u, O_POOLS = 66615296u;
        if (pn < 6) {
            const bool isk = pn >= 3; const int head = 4 * (isk ? pn - 3 : pn) + wc, g = head >> 2, hs = head & 3, win = 128 << (2 * g);
            const float* gn = (isk ? kn : qn) + head * 64 + 8 * fq;
            f32x4 gv[2][2];
#pragma unroll
            for (int bj = 0; bj < 2; ++bj)
#pragma unroll
                for (int n = 0; n < 2; ++n) gv[bj][n] = *(const f32x4*)(gn + 32 * bj + 4 * n);
            bf16_t* dst = isk ? K : Q;
#pragma unroll
            for (int ai = 0; ai < 2; ++ai)
#pragma unroll
                for (int m = 0; m < 4; ++m) {
                    const int row = row0 + ai * HALF + m * 16; const float rs = rstd_from_partials(ssp, row);
                    f32x4 v[2][2]; float ss = 0.f;
#pragma unroll
                    for (int bj = 0; bj < 2; ++bj)
#pragma unroll
                        for (int n = 0; n < 2; ++n) { v[bj][n] = acc[ai][bj][m][n] * rs; const f32x4 x = v[bj][n]; ss += (x[0] * x[0] + x[1] * x[1]) + (x[2] * x[2] + x[3] * x[3]); }
                    ss += __shfl_xor(ss, 16); ss += __shfl_xor(ss, 32);
                    const float r2 = __builtin_amdgcn_rsqf(ss * (1.0f / 64.0f) + RMS_EPS);
                    float* fo = nullptr;
                    if (isk) {
                        if (row < 16384) { const int b = row >> 12, t = row & 4095; if (t >= 4096 - win) fo = out + O_KVP[g] + ((size_t)(b * win + t - (4096 - win)) * 512 + hs * 64 + 8 * fq); }
                        else { const int s = row - 16384, b = s >> 3, t = s & 7; fo = out + O_KVS[g] + ((size_t)(b * win + win - 8 + t) * 512 + hs * 64 + 8 * fq); }
                    }
#pragma unroll
                    for (int bj = 0; bj < 2; ++bj) {
                        const f32x4 o0 = v[bj][0] * r2 * gv[bj][0], o1 = v[bj][1] * r2 * gv[bj][1];
                        *(u32x4*)(dst + (size_t)row * 768 + head * 64 + 32 * bj + 8 * fq) = pack8(o0, o1);
                        if (fo) { *(f32x4*)(fo + 32 * bj) = o0; *(f32x4*)(fo + 32 * bj + 4) = o1; }
                    }
                }
        } else if (pn < 9) {
            const int cb = (pn - 6) * 256 + wc * 32 + 8 * fq;
#pragma unroll
            for (int ai = 0; ai < 2; ++ai)
#pragma unroll
                for (int m = 0; m < 4; ++m) {
                    const int row = row0 + ai * HALF + m * 16; const float rs = rstd_from_partials(ssp, row);
#pragma unroll
                    for (int bj = 0; bj < 2; ++bj) {
                        const int c = cb + 128 * bj, head = c >> 6, g = head >> 2, hs = head & 3, win = 128 << (2 * g), dim = c & 63;
                        const f32x4 o0 = acc[ai][bj][m][0] * rs, o1 = acc[ai][bj][m][1] * rs;
                        *(u32x4*)(V + (size_t)row * 768 + c) = pack8(o0, o1);
                        float* fo = nullptr;
                        if (row < 16384) { const int b = row >> 12, t = row & 4095; if (t >= 4096 - win) fo = out + O_KVP[g] + ((size_t)(b * win + t - (4096 - win)) * 512 + 256 + hs * 64 + dim); }
                        else { const int s = row - 16384, b = s >> 3, t = s & 7; fo = out + O_KVS[g] + ((size_t)(b * win + win - 8 + t) * 512 + 256 + hs * 64 + dim); }
                        if (fo) { *(f32x4*)(fo) = o0; *(f32x4*)(fo + 4) = o1; }
                    }
                }
        } else if (pn < 11) {
            const int cb = (pn - 9) * 256 + wc * 32 + 8 * fq;
#pragma unroll
            for (int ai = 0; ai < 2; ++ai)
#pragma unroll
                for (int m = 0; m < 4; ++m) {
                    const int row = row0 + ai * HALF + m * 16; const float rs = rstd_from_partials(ssp, row);
                    float* fo = nullptr;
                    if (row < 16384) { const int b = row >> 12, t = row & 4095; if (t >= 4081) fo = out + O_POOLP + (size_t)(b * 15 + t - 4081) * 512 + cb; }
                    else { const int s = row - 16384, b = s >> 3, t = s & 7; fo = out + O_POOLS + (size_t)(b * 15 + 7 + t) * 512 + cb; }
#pragma unroll
                    for (int bj = 0; bj < 2; ++bj) {
                        const f32x4 o0 = acc[ai][bj][m][0] * rs, o1 = acc[ai][bj][m][1] * rs;
                        float* up = U + (size_t)row * 512 + cb + 128 * bj;
                        *(f32x4*)(up) = o0; *(f32x4*)(up + 4) = o1;
                        if (fo) { *(f32x4*)(fo + 128 * bj) = o0; *(f32x4*)(fo + 128 * bj + 4) = o1; }
                    }
                }
        } else {
            const bool isb = pn >= 15; bf16_t* G = isb ? GB : GA; const int cb = (pn - (isb ? 15 : 11)) * 256 + wc * 32 + 8 * fq;
#pragma unroll
            for (int ai = 0; ai < 2; ++ai)
#pragma unroll
                for (int m = 0; m < 4; ++m) {
                    const int row = row0 + ai * HALF + m * 16; const float rs = rstd_from_partials(ssp, row);
#pragma unroll
                    for (int bj = 0; bj < 2; ++bj) {
                        f32x4 o0 = acc[ai][bj][m][0] * rs, o1 = acc[ai][bj][m][1] * rs;
#pragma unroll
                        for (int e = 0; e < 4; ++e) { o0[e] = sigmoidf_fast(o0[e]); o1[e] = sigmoidf_fast(o1[e]); }
                        *(u32x4*)(G + (size_t)row * 1024 + cb + 128 * bj) = pack8(o0, o1);
                    }
                }
        }
    }
};

template <int PART> struct EpiMerge {
    static constexpr bool PERM = true, AFTER_DRAIN = false;
    const bf16_t* G; bf16_t* T; bf16_t* MG;
    __device__ __forceinline__ void operator()(const f32x4 (&acc)[2][2][4][2], const Unit& u, int wr, int wc, int fr, int fq) const {
        const int row0 = u.pm * BM + wr * 64 + fr, col0 = u.pn * BM + wc * 32 + 8 * fq;
#pragma unroll
        for (int ai = 0; ai < 2; ++ai)
#pragma unroll
            for (int m = 0; m < 4; ++m) {
                const int row = row0 + ai * HALF + m * 16;
#pragma unroll
                for (int bj = 0; bj < 2; ++bj) {
                    const size_t off = (size_t)row * 1024 + col0 + bj * HALF;
                    const u32x4 gw = *(const u32x4*)(G + off);
                    f32x4 o0, o1;
                    o0[0] = __uint_as_float(gw.x << 16) * acc[ai][bj][m][0][0]; o0[1] = __uint_as_float(gw.x & 0xffff0000u) * acc[ai][bj][m][0][1];
                    o0[2] = __uint_as_float(gw.y << 16) * acc[ai][bj][m][0][2]; o0[3] = __uint_as_float(gw.y & 0xffff0000u) * acc[ai][bj][m][0][3];
                    o1[0] = __uint_as_float(gw.z << 16) * acc[ai][bj][m][1][0]; o1[1] = __uint_as_float(gw.z & 0xffff0000u) * acc[ai][bj][m][1][1];
                    o1[2] = __uint_as_float(gw.w << 16) * acc[ai][bj][m][1][2]; o1[3] = __uint_as_float(gw.w & 0xffff0000u) * acc[ai][bj][m][1][3];
                    if (PART == 1) {
                        const u32x4 tw = *(const u32x4*)(T + off);
                        o0[0] += __uint_as_float(tw.x << 16); o0[1] += __uint_as_float(tw.x & 0xffff0000u); o0[2] += __uint_as_float(tw.y << 16); o0[3] += __uint_as_float(tw.y & 0xffff0000u);
                        o1[0] += __uint_as_float(tw.z << 16); o1[1] += __uint_as_float(tw.z & 0xffff0000u); o1[2] += __uint_as_float(tw.w << 16); o1[3] += __uint_as_float(tw.w & 0xffff0000u);
                        *(u32x4*)(MG + off) = pack8(o0, o1);
                    } else {
                        *(u32x4*)(T + off) = pack8(o0, o1);
                    }
                }
            }
    }
};
template <class Epi, class Sched, bool ALIGN_EPI = false, bool SP2 = false>
__device__ __forceinline__ void gemm_phase(PG8_LAS unsigned char* lds, const Gemm g, const Sched& S, const Epi& E) {
    int tid_ = threadIdx.x; asm volatile("" : "+v"(tid_));
    const int tid = tid_, wid = __builtin_amdgcn_readfirstlane(tid >> 6), lane = tid & 63, wr = wid >> 2, wc = wid & 3, fr = lane & 15, fq = lane >> 4;
    const int K = g.K, nt = K / BK;
    unsigned voffA[2], voffB[2];
#pragma unroll
    for (int i = 0; i < 2; ++i) { int R, C; stage_rc(tid * 16 + i * 8192, R, C); const int Rb = Epi::PERM ? ((R & ~31) + perm32(R & 31)) : R;
        voffA[i] = (unsigned)(R * K + C) * 2u; voffB[i] = (unsigned)(Rb * K + C) * 2u; }
    const size_t kstep = (size_t)(BK * 2);
    const size_t hstep = (size_t)HALF * K * 2;
    const size_t tstep = 2 * hstep;
    const unsigned ldsw = (unsigned)wid * 1024u;
    const int aoff = lds_byte(wr * 64 + fr, fq * 8), boff = lds_byte(wc * 32 + fr, fq * 8);
#define PG8_SA(b, h) (((b) * 2 + (h)) * HTB)
#define PG8_SB(b, h) ((4 + (b) * 2 + (h)) * HTB)
#define PG8_STAGE(bufoff, gbase, voff) do { _Pragma("unroll") for (int _i = 0; _i < 2; ++_i) \
        __builtin_amdgcn_global_load_lds((const unsigned*)((const char*)(gbase) + (voff)[_i]), (PG8_LAS unsigned*)(lds + (bufoff) + ldsw + _i * 8192), 16, 0, 0); } while (0)
#define PG8_LDA(dst, b, h) do { _Pragma("unroll") for (int m = 0; m < 4; ++m) _Pragma("unroll") for (int k = 0; k < 2; ++k) dst[m][k] = *(const PG8_LAS bf16x8*)(lds + PG8_SA(b, h) + aoff + m * 2048 + k * 1024); } while (0)
#define PG8_LDB(dst, b, h) do { _Pragma("unroll") for (int n = 0; n < 2; ++n) _Pragma("unroll") for (int k = 0; k < 2; ++k) dst[n][k] = *(const PG8_LAS bf16x8*)(lds + PG8_SB(b, h) + boff + n * 2048 + k * 1024); } while (0)
#define PG8_MMA(ai, bj, At, Bt) do { __builtin_amdgcn_s_setprio(1); _Pragma("unroll") for (int m = 0; m < 4; ++m) _Pragma("unroll") for (int n = 0; n < 2; ++n) _Pragma("unroll") for (int k = 0; k < 2; ++k) \
        acc[ai][bj][m][n] = __builtin_amdgcn_mfma_f32_16x16x32_bf16(Bt[n][k], At[m][k], acc[ai][bj][m][n], 0, 0, 0); __builtin_amdgcn_s_setprio(0); } while (0)
#define PG8_WAIT_V(n) asm volatile("s_waitcnt vmcnt(" #n ")" ::: "memory")
#define PG8_WAIT_L(n) asm volatile("s_waitcnt lgkmcnt(" #n ")" ::: "memory")
#define PG8_BAR __builtin_amdgcn_s_barrier()
#define PG8_SCHED __builtin_amdgcn_sched_barrier(0)
    Unit cur, nxt; int ui = 0;
    if (!S.next(0, cur)) return;
    f32x4 acc[2][2][4][2];
#pragma unroll
    for (int a = 0; a < 2; ++a)
#pragma unroll
        for (int b = 0; b < 2; ++b)
#pragma unroll
            for (int m = 0; m < 4; ++m)
#pragma unroll
                for (int n = 0; n < 2; ++n) acc[a][b][m][n] = (f32x4){0.f, 0.f, 0.f, 0.f};
    bf16x8 At[4][2], B0[2][2], B1[2][2];
    const char* cA = (const char*)g.A + (size_t)cur.pm * tstep; const char* cB = (const char*)g.Bt + (size_t)cur.pn * tstep;
    S.a_ready(cur);
    if constexpr (SP2) {
        PG8_STAGE(PG8_SB(0, 0), cB, voffB); PG8_STAGE(PG8_SB(0, 1), cB + hstep, voffB); PG8_STAGE(PG8_SA(0, 0), cA, voffA); PG8_STAGE(PG8_SA(0, 1), cA + hstep, voffA);
        if (wr == 1) PG8_BAR;
        PG8_WAIT_V(2); PG8_BAR;
        PG8_STAGE(PG8_SB(1, 0), cB + kstep, voffB); PG8_STAGE(PG8_SA(1, 0), cA + kstep, voffA); PG8_STAGE(PG8_SB(1, 1), cB + hstep + kstep, voffB);
        PG8_WAIT_V(6); PG8_BAR;
    } else {
        PG8_STAGE(PG8_SB(0, 0), cB, voffB); PG8_STAGE(PG8_SA(0, 0), cA, voffA); PG8_STAGE(PG8_SB(0, 1), cB + hstep, voffB); PG8_STAGE(PG8_SA(0, 1), cA + hstep, voffA);
        if (wr == 1) PG8_BAR;
        PG8_WAIT_V(4); PG8_BAR;
        PG8_STAGE(PG8_SB(1, 0), cB + kstep, voffB); PG8_STAGE(PG8_SA(1, 0), cA + kstep, voffA); PG8_STAGE(PG8_SB(1, 1), cB + hstep + kstep, voffB);
        PG8_WAIT_V(6); PG8_BAR;
    }
    for (;;) {
        const bool has_next = S.next(ui + 1, nxt);
        const char* nA = has_next ? (const char*)g.A + (size_t)nxt.pm * tstep : cA; const char* nB = has_next ? (const char*)g.Bt + (size_t)nxt.pn * tstep : cB;
        for (int t = 0; t < nt; t += 2) {
            const bool last = (t == nt - 2);
            const char* a1 = cA + (size_t)(t + 1) * kstep;
            const char* a2 = last ? nA : cA + (size_t)(t + 2) * kstep; const char* b2 = last ? nB : cB + (size_t)(t + 2) * kstep;
            const char* a3 = a2 + kstep; const char* b3 = b2 + kstep;
            if (last && has_next) S.a_ready(nxt);
            if constexpr (SP2) {
            PG8_LDB(B0, 0, 0); PG8_LDB(B1, 0, 1); PG8_SCHED; PG8_LDA(At, 0, 0); PG8_STAGE(PG8_SA(1, 1), a1 + hstep, voffA);
            PG8_WAIT_V(8); PG8_WAIT_L(0); PG8_BAR; PG8_MMA(0, 0, At, B0); PG8_MMA(0, 1, At, B1); PG8_BAR; PG8_SCHED;
            PG8_LDA(At, 0, 1); PG8_STAGE(PG8_SB(0, 0), b2, voffB); PG8_STAGE(PG8_SB(0, 1), b2 + hstep, voffB); PG8_STAGE(PG8_SA(0, 0), a2, voffA);
            PG8_WAIT_V(8); PG8_WAIT_L(0); PG8_BAR; PG8_MMA(1, 0, At, B0); PG8_MMA(1, 1, At, B1); PG8_BAR; PG8_SCHED;
            PG8_LDB(B0, 1, 0); PG8_LDB(B1, 1, 1); PG8_SCHED; PG8_LDA(At, 1, 0); PG8_STAGE(PG8_SA(0, 1), a2 + hstep, voffA);
            PG8_WAIT_V(8); PG8_WAIT_L(0); PG8_BAR; PG8_MMA(0, 0, At, B0); PG8_MMA(0, 1, At, B1); PG8_BAR; PG8_SCHED;
            PG8_LDA(At, 1, 1); PG8_STAGE(PG8_SB(1, 0), b3, voffB); PG8_STAGE(PG8_SB(1, 1), b3 + hstep, voffB); PG8_STAGE(PG8_SA(1, 0), a3, voffA);
            PG8_WAIT_V(8); PG8_WAIT_L(0); PG8_BAR; PG8_MMA(1, 0, At, B0); PG8_MMA(1, 1, At, B1); PG8_BAR; PG8_SCHED;
            } else {
            PG8_LDB(B0, 0, 0); PG8_SCHED; PG8_LDA(At, 0, 0); PG8_STAGE(PG8_SA(1, 1), a1 + hstep, voffA);
            PG8_WAIT_L(8); PG8_BAR; PG8_WAIT_L(0); PG8_MMA(0, 0, At, B0); PG8_BAR; PG8_SCHED;
            PG8_LDB(B1, 0, 1); PG8_STAGE(PG8_SB(0, 0), b2, voffB);
            PG8_BAR; PG8_WAIT_L(0); PG8_MMA(0, 1, At, B1); PG8_BAR;
            PG8_LDA(At, 0, 1); PG8_STAGE(PG8_SA(0, 0), a2, voffA);
            PG8_BAR; PG8_WAIT_L(0); PG8_MMA(1, 0, At, B0); PG8_BAR; PG8_SCHED;
            PG8_STAGE(PG8_SB(0, 1), b2 + hstep, voffB);
            PG8_WAIT_V(6); PG8_BAR; PG8_MMA(1, 1, At, B1); PG8_BAR;
            PG8_LDB(B0, 1, 0); PG8_SCHED; PG8_LDA(At, 1, 0); PG8_STAGE(PG8_SA(0, 1), a2 + hstep, voffA);
            PG8_WAIT_L(8); PG8_BAR; PG8_WAIT_L(0); PG8_MMA(0, 0, At, B0); PG8_BAR; PG8_SCHED;
            PG8_LDB(B1, 1, 1); PG8_STAGE(PG8_SB(1, 0), b3, voffB);
            PG8_BAR; PG8_WAIT_L(0); PG8_MMA(0, 1, At, B1); PG8_BAR;
            PG8_LDA(At, 1, 1); PG8_STAGE(PG8_SA(1, 0), a3, voffA);
            PG8_BAR; PG8_WAIT_L(0); PG8_MMA(1, 0, At, B0); PG8_BAR; PG8_SCHED;
            PG8_STAGE(PG8_SB(1, 1), b3 + hstep, voffB);
            PG8_WAIT_V(6); PG8_BAR; PG8_MMA(1, 1, At, B1); PG8_BAR;
            }
        }
        if constexpr (ALIGN_EPI) { if (wr == 0) PG8_BAR; }
        if constexpr (!Epi::AFTER_DRAIN) { E(acc, cur, wr, wc, fr, fq); S.done(cur); }
        if (!has_next) break;
#pragma unroll
        for (int a = 0; a < 2; ++a)
#pragma unroll
            for (int b = 0; b < 2; ++b)
#pragma unroll
                for (int m = 0; m < 4; ++m)
#pragma unroll
                    for (int n = 0; n < 2; ++n) acc[a][b][m][n] = (f32x4){0.f, 0.f, 0.f, 0.f};
        cur = nxt; cA = nA; cB = nB; ++ui;
        if constexpr (ALIGN_EPI) { if (wr == 1) PG8_BAR; }
    }
    PG8_WAIT_V(0);
    if constexpr (!ALIGN_EPI) { if (wr == 0) PG8_BAR; }
    PG8_BAR;
    if constexpr (Epi::AFTER_DRAIN) { E.fused(acc, cur, wr, wc, fr, fq, lds, wid, lane); S.done(cur); }
#undef PG8_SA
#undef PG8_SB
#undef PG8_STAGE
#undef PG8_LDA
#undef PG8_LDB
#undef PG8_MMA
#undef PG8_WAIT_V
#undef PG8_WAIT_L
#undef PG8_BAR
#undef PG8_SCHED
}
}

constexpr int NWAVES = 8;
constexpr int DM = 1024, NBATCH = 4, SEQ = 4096, DBATCH = 32, DSEQ = 8;
constexpr int MP = NBATCH * SEQ, MS = DBATCH * DSEQ, M = MP + MS;
constexpr int FF = 2816, FF2 = 5632, INW = 4864, AW = 768, AOW = 256, PW = 512;
constexpr size_t O_Y = 0, O_KV128P = 17039360u, O_KV512P = 17301504u, O_KV2048P = 18350080u, O_POOLP = 22544384u,
                 O_KV128S = 22575104u, O_KV512S = 24672256u, O_KV2048S = 33060864u, O_POOLS = 66615296u, O_END = 66861056u;
constexpr size_t MiB = 1u << 20;
constexpr size_t WS_CTL = 0, CTL_ZERO_BYTES = 1 * MiB;
constexpr size_t WS_WUP1 = 2 * MiB, WS_WDN1 = 13 * MiB, WS_WIN = 19 * MiB, WS_WAB = 29 * MiB, WS_WEFF = 30 * MiB, WS_WOUT = 31 * MiB, WS_WUP2 = 33 * MiB, WS_WDN2 = 44 * MiB;
constexpr size_t WS_RSTD0 = 50 * MiB, WS_SSP1 = 51 * MiB, WS_SSP2 = 53 * MiB, WS_BIAS = 55 * MiB;
constexpr size_t WS_XB = 56 * MiB;
constexpr size_t WS_X1 = 90 * MiB;
constexpr size_t WS_R = 156 * MiB;
constexpr size_t WS_Q = WS_R, WS_K = WS_Q + 25 * MiB, WS_V = WS_K + 25 * MiB;
constexpr size_t WS_U = WS_V + 25 * MiB;
constexpr size_t WS_GA = WS_U + 33 * MiB, WS_GB = WS_GA + 33 * MiB;
constexpr size_t WS_AA = WS_GB + 33 * MiB, WS_DD = WS_AA + 9 * MiB;
constexpr size_t WS_T = WS_DD + 17 * MiB, WS_MG = WS_T + 33 * MiB, WS_END = WS_MG + 33 * MiB;
static_assert(WS_END <= 512 * MiB, "d_ws map");
static_assert(WS_R + (size_t)M * FF * 2 <= WS_END, "H fits");
constexpr int CW_TMO = 0, CW_BAR = 4096;
constexpr int RING_OFF = 0, RING_BYTES = 131072;
constexpr int LDSCTL_OFF = RING_BYTES, MISC_OFF = LDSCTL_OFF + 320;
constexpr int LDS_BYTES = 147456;
#define GAS __attribute__((address_space(1)))
#define LAS __attribute__((address_space(3)))
typedef unsigned short bf16;
typedef unsigned v4u __attribute__((ext_vector_type(4)));
typedef float f32x4 __attribute__((ext_vector_type(4)));
typedef short bf16x8 __attribute__((ext_vector_type(8)));
typedef GAS unsigned gu32;
typedef GAS unsigned long long gu64;
#define RLX_AGENT __ATOMIC_RELAXED, __HIP_MEMORY_SCOPE_AGENT
#define LDS_WAIT() asm volatile("s_waitcnt lgkmcnt(0)" ::: "memory")
#define VM_WAIT() asm volatile("s_waitcnt vmcnt(0)" ::: "memory")
__device__ __forceinline__ unsigned long long rt() { return __builtin_amdgcn_s_memrealtime(); }
__device__ __forceinline__ unsigned f2bf(float f) { unsigned u = __builtin_bit_cast(unsigned, f); return (u + 0x7fffu + ((u >> 16) & 1u)) >> 16; }
__device__ __forceinline__ unsigned pk2(float lo, float hi) { return f2bf(lo) | (f2bf(hi) << 16); }

#define XB_TMO      128
#define XB_XCNT(j)  (256  + 64 * (j))
#define XB_XSUB(j)  (1280 + 64 * (j))
#define XB_XGEN(j)  (2304 + 64 * (j))
#define XB_TOP      3328
#define XB_TOPGEN   3392
#define XCD_BAR_WORDS 3456
#define XB_SPIN_CAP (1u << 18)

__device__ __forceinline__ unsigned xb_ld(unsigned* p)              { return __hip_atomic_load(p, __ATOMIC_RELAXED, __HIP_MEMORY_SCOPE_AGENT); }
__device__ __forceinline__ unsigned xb_add(unsigned* p, unsigned v) { return __hip_atomic_fetch_add(p, v, __ATOMIC_RELAXED, __HIP_MEMORY_SCOPE_AGENT); }
__device__ __forceinline__ unsigned xb_xcc_id() { return (unsigned)__builtin_amdgcn_s_getreg((3 << 11) | 20) & 0xFu; }
#define XB_SPIN(cond, bar) do { unsigned _sp = 0; while (cond) { __builtin_amdgcn_s_sleep(1); \
    if ((++_sp & 255u) == 0u) { if (xb_ld(&(bar)[XB_TMO])) break; if (_sp > XB_SPIN_CAP) { atomicAdd(&(bar)[XB_TMO], 1u); break; } } } } while (0)

struct XcdBarrier {
    unsigned* bar; unsigned x;
    volatile LAS unsigned* st;
};

__device__ __forceinline__ XcdBarrier xcd_barrier_post(unsigned* bar, volatile LAS unsigned* st) {
    XcdBarrier b; b.bar = bar; b.x = xb_xcc_id(); b.st = st;
    if (threadIdx.x == 0) (void)xb_add(&bar[XB_XCNT(b.x)], 1u);
    return b;
}
__device__ __forceinline__ void xcd_barrier_complete(unsigned* bar, unsigned x, unsigned& nloc, unsigned& nx) {
    const unsigned G = gridDim.x * gridDim.y * gridDim.z;
    unsigned sum, cnt, mine, sp = 0u;
    for (;;) {
        sum = 0u; cnt = 0u; mine = 0u;
#pragma unroll
        for (unsigned j = 0; j < 16; ++j) { const unsigned c = xb_ld(&bar[XB_XCNT(j)]); sum += c; cnt += (c > 0u) ? 1u : 0u; mine = (j == x) ? c : mine; }
        if (sum == G) break;
        __builtin_amdgcn_s_sleep(1);
        if ((++sp & 255u) == 0u) { if (xb_ld(&bar[XB_TMO])) break; if (sp > XB_SPIN_CAP) { atomicAdd(&bar[XB_TMO], 1u); break; } }
    }
    nloc = mine > 0u ? mine : 1u; nx = cnt > 0u ? cnt : 1u;
}

__device__ __forceinline__ void xcd_barrier(const XcdBarrier& b) {
    asm volatile("s_waitcnt vmcnt(0)" ::: "memory");
    __syncthreads();
    if (threadIdx.x == 0) {
        unsigned* bar = b.bar;
        __builtin_amdgcn_s_waitcnt(0);
        unsigned nloc = b.st[0], nx = b.st[1];
        if (nloc == 0u) { xcd_barrier_complete(bar, b.x, nloc, nx); b.st[0] = nloc; b.st[1] = nx; }
        const unsigned old = xb_add(&bar[XB_XSUB(b.x)], 1u);
        const unsigned gen = old / nloc;
        if (old + 1u == (gen + 1u) * nloc) {
            __builtin_amdgcn_fence(__ATOMIC_RELEASE, "agent");
            asm volatile("s_waitcnt vmcnt(0)" ::: "memory");
            const unsigned og = xb_add(&bar[XB_TOP], 1u);
            const unsigned tg = og / nx;
            if (og + 1u == (tg + 1u) * nx) xb_add(&bar[XB_TOPGEN], 1u);
            else XB_SPIN(xb_ld(&bar[XB_TOPGEN]) == tg, bar);
            __builtin_amdgcn_fence(__ATOMIC_ACQUIRE, "agent");
            xb_add(&bar[XB_XGEN(b.x)], 1u);
            asm volatile("s_waitcnt vmcnt(0)" ::: "memory");
        } else {
            XB_SPIN(xb_ld(&bar[XB_XGEN(b.x)]) == gen, bar);
            __builtin_amdgcn_fence(__ATOMIC_ACQUIRE, "agent");
            asm volatile("s_waitcnt vmcnt(0)" ::: "memory");
        }
    }
    __syncthreads();
}

struct Frame {
    LAS unsigned char* lds;
    volatile LAS unsigned* MISC;
    gu32* ctl;
    int tid, lane, wave;
    int vcu, G;
};
__device__ __forceinline__ float wave_sum(float v) {
#pragma unroll
    for (int o = 1; o < 64; o <<= 1) v += __shfl_xor(v, o);
    return v;
}
__device__ __forceinline__ float wave_max(float v) {
#pragma unroll
    for (int o = 1; o < 64; o <<= 1) v = fmaxf(v, __shfl_xor(v, o));
    return v;
}
__constant__ unsigned char T5B[3][132] = {
 {0,1,2,3,4,5,6,7,8,9,10,11,12,13,14,15,16,16,16,16,16,16,17,17,17,17,17,17,17,17,18,18,18,18,18,18,18,18,18,18,19,19,19,19,19,19,19,19,19,19,19,19,19,19,20,20,20,20,20,20,20,20,20,20,20,20,20,20,20,20,20,20,20,21,21,21,21,21,21,21,21,21,21,21,21,21,21,21,21,21,21,21,21,21,21,21,21,21,21,22,22,22,22,22,22,22,22,22,22,22,22,22,22,22,22,22,22,22,22,22,22,22,22,22,22,22,22,22,22,0,0,0},
 {0,4,8,12,16,16,17,17,18,18,19,19,19,19,20,20,20,20,20,21,21,21,21,21,21,22,22,22,22,22,22,22,22,22,23,23,23,23,23,23,23,23,23,23,23,23,24,24,24,24,24,24,24,24,24,24,24,24,24,24,24,24,25,25,25,25,25,25,25,25,25,25,25,25,25,25,25,25,25,25,25,25,25,26,26,26,26,26,26,26,26,26,26,26,26,26,26,26,26,26,26,26,26,26,26,26,26,26,26,26,26,26,26,27,27,27,27,27,27,27,27,27,27,27,27,27,27,27,27,0,0,0},
 {0,16,18,19,20,21,21,22,22,23,23,23,24,24,24,24,25,25,25,25,25,26,26,26,26,26,26,26,26,27,27,27,27,27,27,27,27,27,27,28,28,28,28,28,28,28,28,28,28,28,28,28,29,29,29,29,29,29,29,29,29,29,29,29,29,29,29,29,29,29,30,30,30,30,30,30,30,30,30,30,30,30,30,30,30,30,30,30,30,30,30,30,30,30,30,31,31,31,31,31,31,31,31,31,31,31,31,31,31,31,31,31,31,31,31,31,31,31,31,31,31,31,31,31,31,31,31,31,31,0,0,0}};

template <int MAP> __device__ __forceinline__ void p0_transpose_item(const float* W, int K, int N, bf16* WT, const float* gain, LAS float* scr, int item, int lane) {
    const int nblk = N / 32, kb = item / nblk, nb = item % nblk, k0 = 64 * kb, n0 = 32 * nb;
    int v0 = n0;
    if (MAP == 1) { const int c = n0 < FF ? n0 : n0 - FF; v0 = 256 * (c >> 7) + (n0 < FF ? 0 : 128) + (c & 127); }
    if (MAP == 2) { if (n0 < 1536) { const int o = n0 & 255; v0 = (n0 & ~255) + 128 * ((o >> 5) & 1) + 32 * (o >> 6); } }
#pragma unroll 8
    for (int i = 0; i < 32; ++i) { const int kk = 2 * i + (lane >> 5); float w = W[(size_t)(k0 + kk) * N + n0 + (lane & 31)]; if (gain) w *= gain[k0 + kk]; scr[kk * 33 + (lane & 31)] = w; }
    LDS_WAIT(); asm volatile("" ::: "memory");
    const int c = lane & 7;
#pragma unroll
    for (int j = 0; j < 4; ++j) { const int n = (lane >> 3) + 8 * j; const LAS float* s = scr + (8 * c) * 33 + n;
        v4u o; o.x = pk2(s[0 * 33], s[1 * 33]); o.y = pk2(s[2 * 33], s[3 * 33]); o.z = pk2(s[4 * 33], s[5 * 33]); o.w = pk2(s[6 * 33], s[7 * 33]);
        *(GAS v4u*)(WT + (size_t)(v0 + n) * K + k0 + 8 * c) = o; }
    LDS_WAIT(); asm volatile("" ::: "memory");
}
struct Ptrs {
    const float *xp, *xs, *c128, *c512, *c2048, *spool, *rbias, *n1, *wup1, *wdn1, *nmix, *win, *qn, *kn, *wg, *pscale, *wab, *wpb, *wout, *n2, *wup2, *wdn2;
    float* out; unsigned char* ws;
};
__device__ __forceinline__ void copy_caches(const Ptrs& P, long gtid, long gthreads) {
    const float* src[3] = {P.c128, P.c512, P.c2048};
    const size_t dsto[3] = {O_KV128S, O_KV512S, O_KV2048S};
#pragma unroll
    for (int g = 0; g < 3; ++g) {
        const int win = 128 << (2 * g); const long per_b = (long)(win - 8) * 128;
        const long total = per_b * DBATCH;
        for (long i = gtid; i < total; i += gthreads) {
            const long b = i / per_b, r = i - b * per_b;
            const f32x4 v = __builtin_nontemporal_load((const f32x4*)(src[g] + ((size_t)b * win + 8) * 512) + r);
            __builtin_nontemporal_store(v, (f32x4*)(P.out + dsto[g] + (size_t)b * win * 512) + r);
        }
    }
    for (long i = gtid; i < (long)DBATCH * 7 * 128; i += gthreads) {
        const long b = i / (7 * 128), r = i - b * (7 * 128);
        ((f32x4*)(P.out + O_POOLS + (size_t)b * 15 * 512))[r] = ((const f32x4*)(P.spool + ((size_t)b * 15 + 8) * 512))[r];
    }
}

__device__ __forceinline__ void p0_prologue(Frame& F, const Ptrs& P) {
    LAS float* scr = (LAS float*)(F.lds + RING_OFF + F.wave * 16384);
    const int gw = F.vcu * NWAVES + F.wave, NGW = F.G * NWAVES;
    unsigned char* ws = P.ws;
    for (int m = gw; m < M; m += NGW) {
        const float* xrow = (m < MP) ? P.xp + (size_t)m * DM : P.xs + (size_t)(m - MP) * DM;
        const GAS f32x4* xr = (const GAS f32x4*)xrow + F.lane;
        f32x4 v[4]; float s = 0.f;
#pragma unroll
        for (int j = 0; j < 4; ++j) { v[j] = xr[64 * j]; s += (v[j].x * v[j].x + v[j].y * v[j].y) + (v[j].z * v[j].z + v[j].w * v[j].w); }
        s = wave_sum(s);
        if (F.lane == 0) ((float*)(ws + WS_RSTD0))[m] = __builtin_amdgcn_rsqf(s * (1.0f / DM) + 1e-6f);
        GAS unsigned long long* o8 = (GAS unsigned long long*)((bf16*)(ws + WS_XB) + (size_t)m * DM) + F.lane;
#pragma unroll
        for (int j = 0; j < 4; ++j) o8[64 * j] = (unsigned long long)pk2(v[j].x, v[j].y) | ((unsigned long long)pk2(v[j].z, v[j].w) << 32);
    }
    constexpr int I_UP = (DM / 64) * (FF2 / 32), I_DN = (FF / 64) * (DM / 32), I_IN = (DM / 64) * (INW / 32), I_AB = (AOW / 64) * (DM / 32), I_OUT = (DM / 64) * (DM / 32);
    constexpr int NITEMS = 2 * I_UP + 2 * I_DN + I_IN + I_AB + I_OUT;
    for (int it = gw; it < NITEMS; it += NGW) {
        int r = it;
        if (r < I_UP) { p0_transpose_item<1>(P.wup1, DM, FF2, (bf16*)(ws + WS_WUP1), P.n1, scr, r, F.lane); continue; } r -= I_UP;
        if (r < I_UP) { p0_transpose_item<1>(P.wup2, DM, FF2, (bf16*)(ws + WS_WUP2), P.n2, scr, r, F.lane); continue; } r -= I_UP;
        if (r < I_DN) { p0_transpose_item<0>(P.wdn1, FF, DM, (bf16*)(ws + WS_WDN1), nullptr, scr, r, F.lane); continue; } r -= I_DN;
        if (r < I_DN) { p0_transpose_item<0>(P.wdn2, FF, DM, (bf16*)(ws + WS_WDN2), nullptr, scr, r, F.lane); continue; } r -= I_DN;
        if (r < I_IN) { p0_transpose_item<2>(P.win, DM, INW, (bf16*)(ws + WS_WIN), P.nmix, scr, r, F.lane); continue; } r -= I_IN;
        if (r < I_AB) { p0_transpose_item<0>(P.wab, AOW, DM, (bf16*)(ws + WS_WAB), nullptr, scr, r, F.lane); continue; } r -= I_AB;
        p0_transpose_item<0>(P.wout, DM, DM, (bf16*)(ws + WS_WOUT), nullptr, scr, r, F.lane);
    }
    for (int it = gw; it < 128 * 16; it += NGW) {
        const int kq = it >> 4, nb = it & 15, k = 4 * kq, g = k >> 7, kp = k & 127, n = nb * 64 + F.lane;
        const float* wgr = P.wg + ((size_t)g * 128 + kp) * 128; const float* sc = P.pscale + 128 * g; const float* wp = P.wpb + (size_t)(128 * g) * DM + n;
        float a0 = 0.f, a1 = 0.f, a2 = 0.f, a3 = 0.f;
#pragma unroll 8
        for (int c = 0; c < 128; ++c) { const float s = sc[c], w = wp[(size_t)c * DM];
            a0 += wgr[c] * s * w; a1 += wgr[128 + c] * s * w; a2 += wgr[256 + c] * s * w; a3 += wgr[384 + c] * s * w; }
        *(GAS unsigned long long*)((bf16*)(ws + WS_WEFF) + (size_t)n * PW + k) = (unsigned long long)pk2(a0, a1) | ((unsigned long long)pk2(a2, a3) << 32);
    }
    if (blockIdx.x == 0) {
        for (int i = F.tid; i < 3 * 4 * 132; i += NWAVES * 64) { const int g = i / (4 * 132), h = (i / 132) & 3, j = i % 132;
            ((float*)(ws + WS_BIAS))[i] = (j <= 128) ? P.rbias[(int)T5B[g][j] * 12 + 4 * g + h] * 1.4426950408889634f : 0.f; }
    }
}

typedef float f32x16 __attribute__((ext_vector_type(16)));
typedef short s16x4 __attribute__((ext_vector_type(4)));
typedef short v4i16_t __attribute__((ext_vector_type(4)));
__device__ __forceinline__ int crow(int r, int hi) { return (r & 3) + 8 * (r >> 2) + 4 * hi; }
__device__ __forceinline__ s16x4 vtr(const LAS unsigned char* p) { return __builtin_bit_cast(s16x4, __builtin_amdgcn_ds_read_tr16_b64_v4i16((LAS v4i16_t*)p)); }
__device__ __forceinline__ unsigned cvtpk(float lo, float hi) { typedef float f2 __attribute__((ext_vector_type(2))); typedef __bf16 b2 __attribute__((ext_vector_type(2))); f2 v = {lo, hi}; b2 b = __builtin_convertvector(v, b2); return __builtin_bit_cast(unsigned, b); }

constexpr int ATT_WLDS = 8192;
constexpr int ATT_BIAS_OFF = 8 * ATT_WLDS;

struct AttnState { f32x16 o0, o1; float m, l; };

template <int G> __device__ __forceinline__ void attn_group(AttnState& st, const bf16* __restrict__ Qb, const bf16* __restrict__ Kb, const bf16* __restrict__ Vb,
                                                            int b, int s, int h, int r, LAS unsigned char* wl, const LAS float* biasg, int lane) {
    constexpr int D = 1 << (2 * G), E = 16 / D, NT = (G == 0) ? 20 : (G == 1) ? 8 : 5;
    const int i = lane & 31, hi = lane >> 5;
    const int rg = r & (D - 1), cg = r >> (2 * G), P0 = (512 * s) >> (2 * G);
    const int p_i = P0 + E * i + cg, jmax = p_i < 128 ? p_i : 128, p_lo = P0 + cg - 128;
    const int pmax = (SEQ >> (2 * G)) - 1;
    const int col = (4 * G + h) * 64;
    const size_t rowb = (size_t)b * SEQ;
    bf16x8 qf[4];
    { const bf16* qp = Qb + (rowb + 512 * s + 16 * i + r) * AW + col + 32 * hi;
#pragma unroll
      for (int s4 = 0; s4 < 4; ++s4) qf[s4] = *(const bf16x8*)(qp + 8 * s4); }
    LAS float* wsf = (LAS float*)(wl + 4096);
    const LAS unsigned char* vb0 = wl + ((lane >> 4) & 1) * 32 + (lane & 3) * 8 + (4 * hi + ((lane & 15) >> 2)) * 64;
    constexpr float C2 = 0.125f * 1.4426950408889634f;
    bf16x8 kf[4]; v4u vv[4];
    auto load_tile = [&](int kt, bf16x8 (&kk)[4], v4u (&vw)[4]) {
        int p = p_lo + 32 * kt + i; p = p < 0 ? 0 : (p > pmax ? pmax : p);
        const bf16* kp = Kb + (rowb + (size_t)(D * p + rg)) * AW + col + 32 * hi;
#pragma unroll
        for (int s4 = 0; s4 < 4; ++s4) kk[s4] = *(const bf16x8*)(kp + 8 * s4);
#pragma unroll
        for (int kg = 0; kg < 2; ++kg) { int pv = p_lo + 32 * kt + 16 * kg + (lane >> 2); pv = pv < 0 ? 0 : (pv > pmax ? pmax : pv);
            const bf16* vp = Vb + (rowb + (size_t)(D * pv + rg)) * AW + col + 8 * (lane & 3);
            vw[kg] = *(const v4u*)(vp); vw[2 + kg] = *(const v4u*)(vp + 32); }
    };
    load_tile(0, kf, vv);
    for (int kt = 0; kt < NT; ++kt) {
        bf16x8 kn[4]; v4u vn[4];
        if (kt + 1 < NT) load_tile(kt + 1, kn, vn);
        f32x16 sa = {};
#pragma unroll
        for (int s4 = 0; s4 < 4; ++s4) sa = __builtin_amdgcn_mfma_f32_32x32x16_bf16(kf[s4], qf[s4], sa, 0, 0, 0);
#pragma unroll
        for (int pc = 0; pc < 4; ++pc) *(LAS v4u*)(wl + ((pc >> 1) * 2048 + (pc & 1) * 1024) + lane * 16) = vv[(pc >> 1) * 2 + (pc & 1)];
        const int J0 = E * i + 128 - 32 * kt - 4 * hi;
        float mx = -INFINITY;
#pragma unroll
        for (int rho = 0; rho < 16; ++rho) {
            const int j = J0 - ((rho & 3) + 8 * (rho >> 2));
            const bool ok = (unsigned)j <= (unsigned)jmax;
            const int jc = ok ? j : 0;
            const float v = sa[rho] * C2 + biasg[jc];
            sa[rho] = ok ? v : -INFINITY;
            mx = fmaxf(mx, sa[rho]);
        }
        mx = fmaxf(mx, __shfl_xor(mx, 32));
        if (__any(mx > st.m + 6.0f)) {
            const float mn = fmaxf(st.m, mx), f = __builtin_amdgcn_exp2f(st.m - mn);
            st.m = mn; st.l *= f;
            if (hi == 0) wsf[i] = f;
            asm volatile("s_waitcnt lgkmcnt(0)" ::: "memory");
#pragma unroll
            for (int rho = 0; rho < 16; ++rho) { const float ff = wsf[crow(rho, hi)]; st.o0[rho] *= ff; st.o1[rho] *= ff; }
        }
        float ps = 0.f;
#pragma unroll
        for (int rho = 0; rho < 16; ++rho) { sa[rho] = __builtin_amdgcn_exp2f(sa[rho] - st.m); ps += sa[rho]; }
        st.l += ps;
        v4u pw0, pw1;
        pw0.x = cvtpk(sa[0], sa[1]); pw0.y = cvtpk(sa[2], sa[3]); pw0.z = cvtpk(sa[4], sa[5]); pw0.w = cvtpk(sa[6], sa[7]);
        pw1.x = cvtpk(sa[8], sa[9]); pw1.y = cvtpk(sa[10], sa[11]); pw1.z = cvtpk(sa[12], sa[13]); pw1.w = cvtpk(sa[14], sa[15]);
        asm volatile("s_waitcnt lgkmcnt(0)" ::: "memory");
#pragma unroll
        for (int dh = 0; dh < 2; ++dh) {
#pragma unroll
            for (int ks = 0; ks < 2; ++ks) {
                const s16x4 lo = vtr(vb0 + dh * 2048 + ks * 1024), hh = vtr(vb0 + dh * 2048 + ks * 1024 + 512);
                const bf16x8 vf = {lo[0], lo[1], lo[2], lo[3], hh[0], hh[1], hh[2], hh[3]};
                const bf16x8 pf = __builtin_bit_cast(bf16x8, ks == 0 ? pw0 : pw1);
                if (dh == 0) st.o0 = __builtin_amdgcn_mfma_f32_32x32x16_bf16(pf, vf, st.o0, 0, 0, 0);
                else         st.o1 = __builtin_amdgcn_mfma_f32_32x32x16_bf16(pf, vf, st.o1, 0, 0, 0);
            }
        }
        asm volatile("" ::: "memory");
        if (kt + 1 < NT) {
#pragma unroll
            for (int q = 0; q < 4; ++q) { kf[q] = kn[q]; vv[q] = vn[q]; }
        }
    }
}

__device__ __forceinline__ void attn_prompt_unit(int unit, const bf16* Qb, const bf16* Kb, const bf16* Vb, bf16* AA, LAS unsigned char* wl, const LAS float* biasT, int lane) {
    const int r = unit & 15, h = (unit >> 4) & 3, s = (unit >> 6) & 7, b = unit >> 9;
    AttnState st; st.o0 = f32x16{}; st.o1 = f32x16{}; st.m = -30000.0f; st.l = 0.f;
    attn_group<2>(st, Qb, Kb, Vb, b, s, h, r, wl, biasT + 2 * 132, lane);
    attn_group<1>(st, Qb, Kb, Vb, b, s, h, r, wl, biasT + 1 * 132, lane);
    attn_group<0>(st, Qb, Kb, Vb, b, s, h, r, wl, biasT + 0 * 132, lane);
    const int i = lane & 31, hi = lane >> 5;
    LAS float* wsf = (LAS float*)(wl + 4096);
    const float lt = st.l + __shfl_xor(st.l, 32);
    if (hi == 0) wsf[i] = __builtin_amdgcn_rcpf(lt);
    asm volatile("s_waitcnt lgkmcnt(0)" ::: "memory");
#pragma unroll
    for (int rho = 0; rho < 16; ++rho) {
        const int qi = crow(rho, hi); const float ff = wsf[qi];
        bf16* op = AA + ((size_t)b * SEQ + 512 * s + 16 * qi + r) * AOW + h * 64 + i;
        op[0] = (bf16)f2bf(st.o0[rho] * ff); op[32] = (bf16)f2bf(st.o1[rho] * ff);
    }
    asm volatile("s_waitcnt lgkmcnt(0)" ::: "memory");
}

__device__ __forceinline__ void attn_sample_unit(int su, const Ptrs& P, const bf16* Qb, bf16* AA, const float* biasG, LAS unsigned char* wl, int lane) {
    const int t = su & 7, h = (su >> 3) & 3, b = su >> 5;
    LAS float* sc = (LAS float*)(wl);
    LAS float* qs = (LAS float*)(wl + 2048);
    const float* cache[3] = {P.c128, P.c512, P.c2048};
    const size_t oks[3] = {O_KV128S, O_KV512S, O_KV2048S};
    const size_t qrow = (size_t)(MP + b * 8 + t) * AW;
#pragma unroll
    for (int g = 0; g < 3; ++g) qs[g * 64 + lane] = __uint_as_float((unsigned)Qb[qrow + (4 * g + h) * 64 + lane] << 16) * (0.125f * 1.4426950408889634f);
    asm volatile("s_waitcnt lgkmcnt(0)" ::: "memory");
    float mx = -INFINITY;
    for (int c = 0; c < 7; ++c) {
        const int n = c * 64 + lane;
        float sv = -INFINITY;
        if (n < 387) {
            const int g = n >= 258 ? 2 : (n >= 129 ? 1 : 0), j = n - 129 * g, d = 1 << (2 * g), win = 128 << (2 * g);
            const int idx = win + t - d * j;
            const float* kp = (idx >= win) ? P.out + oks[g] + ((size_t)(b * win + idx - 8) * 512 + h * 64) : cache[g] + ((size_t)(b * win + idx) * 512 + h * 64);
            const LAS f32x4* q4 = (const LAS f32x4*)(qs + g * 64);
            float acc = 0.f;
#pragma unroll
            for (int k = 0; k < 16; ++k) { const f32x4 kv = ((const f32x4*)kp)[k], qv = q4[k]; acc += (kv[0] * qv[0] + kv[1] * qv[1]) + (kv[2] * qv[2] + kv[3] * qv[3]); }
            sv = acc + biasG[(g * 4 + h) * 132 + j];
        }
        sc[n] = sv; mx = fmaxf(mx, sv);
    }
    mx = wave_max(mx);
    asm volatile("s_waitcnt lgkmcnt(0)" ::: "memory");
    float ps = 0.f;
    for (int c = 0; c < 7; ++c) { const int n = c * 64 + lane; const float p = __builtin_amdgcn_exp2f(sc[n] - mx); sc[n] = p; ps += p; }
    ps = wave_sum(ps);
    asm volatile("s_waitcnt lgkmcnt(0)" ::: "memory");
    const int kq = lane >> 4, d4 = (lane & 15) * 4;
    f32x4 o = {0.f, 0.f, 0.f, 0.f};
#pragma unroll
    for (int g = 0; g < 3; ++g) {
        const int d = 1 << (2 * g), win = 128 << (2 * g);
#pragma unroll 8
        for (int j0 = 0; j0 < 132; j0 += 4) {
            const int j = j0 + kq;
            if (j <= 128) {
                const int idx = win + t - d * j;
                const float* vp = (idx >= win) ? P.out + oks[g] + ((size_t)(b * win + idx - 8) * 512 + 256 + h * 64 + d4) : cache[g] + ((size_t)(b * win + idx) * 512 + 256 + h * 64 + d4);
                const f32x4 vv = *(const f32x4*)vp; const float p = sc[129 * g + j];
                o += vv * p;
            }
        }
    }
#pragma unroll
    for (int e = 0; e < 4; ++e) { o[e] += __shfl_xor(o[e], 16); o[e] += __shfl_xor(o[e], 32); }
    if (lane < 16) { const float inv = 1.0f / ps;
        *(GAS unsigned long long*)(AA + (size_t)(MP + b * 8 + t) * AOW + h * 64 + d4) = (unsigned long long)pk2(o[0] * inv, o[1] * inv) | ((unsigned long long)pk2(o[2] * inv, o[3] * inv) << 32); }
    asm volatile("s_waitcnt lgkmcnt(0)" ::: "memory");
}

__device__ __forceinline__ void pool_items(const Ptrs& P, const float* U, bf16* DD, long gtid, long gthreads) {
    for (long it = gtid; it < (long)M * 128; it += gthreads) {
        const int row = (int)(it >> 7), c4 = (int)(it & 127) * 4, w = 2 << (c4 >> 7);
        f32x4 s = {0.f, 0.f, 0.f, 0.f}; float cnt;
        const f32x4 own = *(const f32x4*)(U + (size_t)row * PW + c4);
        if (row < MP) {
            const int t = row & (SEQ - 1); cnt = (float)((t + 1 < w) ? t + 1 : w);
            for (int i = 0; i < w; ++i) if (t - i >= 0) s += *(const f32x4*)(U + (size_t)(row - i) * PW + c4);
        } else {
            const int sidx = row - MP, b = sidx >> 3, t = sidx & 7; cnt = (float)w;
            for (int i = 0; i < w; ++i) { const int idx = 15 + t - i;
                s += (idx >= 15) ? *(const f32x4*)(U + (size_t)(MP + b * 8 + idx - 15) * PW + c4) : *(const f32x4*)(P.spool + ((size_t)b * 15 + idx) * PW + c4); }
        }
        const float inv = 1.0f / cnt; const f32x4 dd = s * inv - own;
        *(GAS unsigned long long*)(DD + (size_t)row * PW + c4) = (unsigned long long)pk2(dd[0], dd[1]) | ((unsigned long long)pk2(dd[2], dd[3]) << 32);
    }
}

struct Args { Ptrs p; };
__global__ void __launch_bounds__(NWAVES * 64, 2) hybrid_fwd(Args args) {
    extern __shared__ __attribute__((aligned(16))) unsigned char lds[];
    Frame F;
    F.lds = (LAS unsigned char*)lds;
    F.MISC = (volatile LAS unsigned*)(F.lds + MISC_OFF);
    F.tid = threadIdx.x; F.lane = F.tid & 63; F.wave = __builtin_amdgcn_readfirstlane(F.tid >> 6);
    F.G = gridDim.x; { const int bx = blockIdx.x; F.vcu = (F.G % 8 == 0) ? (bx % 8) * (F.G / 8) + bx / 8 : bx; }
    const Ptrs& P = args.p;
    unsigned char* ws = P.ws;
    F.ctl = (gu32*)(ws + WS_CTL);
    for (int u = F.tid; u < (LDS_BYTES - LDSCTL_OFF) / 4; u += NWAVES * 64) ((LAS unsigned*)(F.lds + LDSCTL_OFF))[u] = 0u;
    __syncthreads();
    XcdBarrier bar = xcd_barrier_post((unsigned*)(F.ctl + CW_BAR), F.MISC + 8);
#define GRID_BAR() xcd_barrier(bar)
#define WSP(T, off) ((T*)(ws + (off)))
    typedef pg8::bf16_t b16;
    const int c = (int)blockIdx.x;

    p0_prologue(F, P);
    GRID_BAR();
    {   pg8::Gemm g{WSP(b16, WS_XB), WSP(b16, WS_WUP1), M, FF2, DM}; pg8::StaticOrder S; S.init(M, FF2, F.G, c);
        pg8::EpiSwiglu<false> E{WSP(b16, WS_R), WSP(float, WS_RSTD0)};
        pg8::gemm_phase<pg8::EpiSwiglu<false>, pg8::StaticOrder, true, true>(F.lds + RING_OFF, g, S, E); }
    GRID_BAR();
    {   pg8::Gemm g{WSP(b16, WS_R), WSP(b16, WS_WDN1), M, DM, FF}; pg8::StaticOrder S; S.init(M, DM, F.G, c);
        pg8::EpiResid<0> E{P.xp, P.xs, WSP(float, WS_X1), WSP(b16, WS_XB), WSP(float, WS_SSP1), nullptr};
        pg8::gemm_phase<pg8::EpiResid<0>, pg8::StaticOrder, true, true>(F.lds + RING_OFF, g, S, E); }
    GRID_BAR();
    {   pg8::Gemm g{WSP(b16, WS_XB), WSP(b16, WS_WIN), M, INW, DM}; pg8::StaticOrder S; S.init(M, INW, F.G, c);
        pg8::EpiIn E{WSP(float, WS_SSP1), WSP(b16, WS_Q), WSP(b16, WS_K), WSP(b16, WS_V), WSP(float, WS_U), WSP(b16, WS_GA), WSP(b16, WS_GB), P.qn, P.kn, P.out};
        pg8::gemm_phase<pg8::EpiIn, pg8::StaticOrder, true, true>(F.lds + RING_OFF, g, S, E); }
    GRID_BAR();
    {   int tid_ = threadIdx.x; asm volatile("" : "+v"(tid_));
        const int lane = tid_ & 63, wave = __builtin_amdgcn_readfirstlane(tid_ >> 6);
        const int gw = F.vcu * NWAVES + wave, NGW = F.G * NWAVES;
        LAS unsigned char* wl = F.lds + RING_OFF + wave * ATT_WLDS;
        const bf16* Qb = WSP(const bf16, WS_Q); const bf16* Kb = WSP(const bf16, WS_K); const bf16* Vb = WSP(const bf16, WS_V); bf16* AA = WSP(bf16, WS_AA);
        const float* BIAS = WSP(const float, WS_BIAS);
        for (int su = gw; su < DBATCH * 4 * DSEQ; su += NGW) attn_sample_unit(su, P, Qb, AA, BIAS, wl, lane);
        for (int unit = gw; unit < NBATCH * 8 * 4 * 16; unit += NGW) {
            LAS float* bt = (LAS float*)(wl + 4352); const int h = (unit >> 4) & 3;
            for (int i = lane; i < 3 * 132; i += 64) bt[i] = BIAS[((i / 132) * 4 + h) * 132 + (i % 132)];
            asm volatile("s_waitcnt lgkmcnt(0)" ::: "memory");
            attn_prompt_unit(unit, Qb, Kb, Vb, AA, wl, bt, lane);
        }
        const long gtid = (long)F.vcu * (NWAVES * 64) + tid_, gthreads = (long)F.G * (NWAVES * 64);
        pool_items(P, WSP(const float, WS_U), WSP(bf16, WS_DD), gtid, gthreads);
        copy_caches(P, gtid, gthreads);
    }
    GRID_BAR();
    {   pg8::StaticOrder S; S.init(M, DM, F.G, c);
        {   pg8::Gemm g{WSP(b16, WS_AA), WSP(b16, WS_WAB), M, DM, AOW}; pg8::EpiMerge<0> E{WSP(b16, WS_GA), WSP(b16, WS_T), WSP(b16, WS_MG)};
            pg8::gemm_phase<pg8::EpiMerge<0>, pg8::StaticOrder, true, true>(F.lds + RING_OFF, g, S, E); }
        {   pg8::Gemm g{WSP(b16, WS_DD), WSP(b16, WS_WEFF), M, DM, PW}; pg8::EpiMerge<1> E{WSP(b16, WS_GB), WSP(b16, WS_T), WSP(b16, WS_MG)};
            pg8::gemm_phase<pg8::EpiMerge<1>, pg8::StaticOrder, true, true>(F.lds + RING_OFF, g, S, E); }
    }
    GRID_BAR();
    {   pg8::Gemm g{WSP(b16, WS_MG), WSP(b16, WS_WOUT), M, DM, DM}; pg8::StaticOrder S; S.init(M, DM, F.G, c);
        pg8::EpiResid<1> E{nullptr, nullptr, WSP(float, WS_X1), WSP(b16, WS_XB), WSP(float, WS_SSP2), nullptr};
        pg8::gemm_phase<pg8::EpiResid<1>, pg8::StaticOrder, true, true>(F.lds + RING_OFF, g, S, E); }
    GRID_BAR();
    {   pg8::Gemm g{WSP(b16, WS_XB), WSP(b16, WS_WUP2), M, FF2, DM}; pg8::StaticOrder S; S.init(M, FF2, F.G, c);
        pg8::EpiSwiglu<true> E{WSP(b16, WS_R), WSP(float, WS_SSP2)};
        pg8::gemm_phase<pg8::EpiSwiglu<true>, pg8::StaticOrder, true, true>(F.lds + RING_OFF, g, S, E); }
    GRID_BAR();
    {   pg8::Gemm g{WSP(b16, WS_R), WSP(b16, WS_WDN2), M, DM, FF}; pg8::StaticOrder S; S.init(M, DM, F.G, c);
        pg8::EpiResid<2> E{nullptr, nullptr, WSP(float, WS_X1), nullptr, nullptr, P.out};
        pg8::gemm_phase<pg8::EpiResid<2>, pg8::StaticOrder, true, true>(F.lds + RING_OFF, g, S, E); }
}

extern "C" void kernel_launch(void* const* d_in, const int* in_sizes, int n_in, void* d_out, int out_size, void* d_ws, size_t ws_size, hipStream_t stream) {
    static int grid = 0;
    if (grid == 0) {
        if (n_in != 22 || (size_t)out_size != O_END || ws_size < WS_END) { fprintf(stderr, "kernel_launch: unexpected shapes (n_in %d, out %d, ws %zu); nothing launched\n", n_in, out_size, ws_size); grid = -1; return; }
        int dev = 0, cus = 0;
        if (hipGetDevice(&dev) != hipSuccess || hipDeviceGetAttribute(&cus, hipDeviceAttributeMultiprocessorCount, dev) != hipSuccess) { grid = -1; return; }
        if (hipFuncSetAttribute((const void*)hybrid_fwd, hipFuncAttributeMaxDynamicSharedMemorySize, LDS_BYTES) != hipSuccess) { fprintf(stderr, "kernel_launch: hipFuncSetAttribute failed\n"); grid = -1; return; }
        (void)hipGetLastError();
        grid = cus;
    }
    if (grid < 0) return;
    if (hipMemsetAsync((char*)d_ws + WS_CTL, 0, CTL_ZERO_BYTES, stream) != hipSuccess) return;
    Args a{};
    const float** pp = (const float**)&a.p;
    for (int i = 0; i < 22; ++i) pp[i] = (const float*)d_in[i];
    a.p.out = (float*)d_out; a.p.ws = (unsigned char*)d_ws;
    hipLaunchKernelGGL(hybrid_fwd, dim3(grid), dim3(NWAVES * 64), LDS_BYTES, stream, a);
}
```

```cpp
#include <hip/hip_runtime.h>
#include <cstdio>
#include <cstdint>

namespace pg8 {
#define PG8_LAS __attribute__((address_space(3)))
typedef unsigned short bf16_t;
typedef short bf16x8 __attribute__((ext_vector_type(8)));
typedef float f32x4 __attribute__((ext_vector_type(4)));
typedef unsigned u32x4 __attribute__((ext_vector_type(4)));
constexpr int BM = 256, BK = 64, HALF = 128, HTB = HALF * BK * 2  , STAGE_BYTES = 8 * HTB, NXCD = 8, WGM = 8;

__host__ __device__ __forceinline__ int lds_byte(int r, int c) { const int st = (r >> 4) * 2 + (c >> 5), rr = r & 15, cc = c & 31, ob = rr * 64 + cc * 2; return st * 1024 + (ob ^ (((ob >> 9) & 1) << 5)); }
__host__ __device__ __forceinline__ void stage_rc(int b, int& R, int& C) { const int st = b / 1024, sb = b % 1024, swz = sb ^ (((sb >> 9) & 1) << 5); R = (st >> 1) * 16 + swz / 64; C = (st & 1) * 32 + (swz % 64) / 2; }
__host__ __device__ __forceinline__ int perm32(int rho) { const int n = rho >> 4, i = rho & 15; return 8 * (i >> 2) + 4 * n + (i & 3); }

struct Unit { int pm, pn; };
struct Gemm { const bf16_t* A; const bf16_t* Bt; int M, N, K; };

struct StaticOrder {
    int nM, nN, nwg, G, c;
    __host__ __device__ void init(int M, int N, int G_, int c_) { nM = M / BM; nN = N / BM; nwg = nM * nN; G = G_; c = c_; }
    __host__ __device__ bool next(int i, Unit& u) const {
        const long L = (long)i * G + c; if (L >= nwg) return false;
        int wgid = (int)L; { const int q = nwg / NXCD, r = nwg % NXCD, xcd = wgid % NXCD, off = wgid / NXCD; wgid = (xcd < r ? xcd * (q + 1) : r * (q + 1) + (xcd - r) * q) + off; }
        const int nig = WGM * nN, gid = wgid / nig, fm = gid * WGM, gsz = (nM - fm) < WGM ? (nM - fm) : WGM;
        u.pm = fm + ((wgid % nig) % gsz); u.pn = (wgid % nig) / gsz; return true;
    }
    __device__ __forceinline__ void a_ready(const Unit&) const {}
    __device__ __forceinline__ void done(const Unit&) const {}
};


typedef float f32x2 __attribute__((ext_vector_type(2)));
typedef __bf16 bf16x2_t __attribute__((ext_vector_type(2)));
__device__ __forceinline__ unsigned cvt_pk_bf16(float lo, float hi) { f32x2 v = {lo, hi}; bf16x2_t b = __builtin_convertvector(v, bf16x2_t); return __builtin_bit_cast(unsigned, b); }
__device__ __forceinline__ u32x4 pack8(const f32x4 a, const f32x4 b) { u32x4 w; w.x = cvt_pk_bf16(a[0], a[1]); w.y = cvt_pk_bf16(a[2], a[3]); w.z = cvt_pk_bf16(b[0], b[1]); w.w = cvt_pk_bf16(b[2], b[3]); return w; }
__device__ __forceinline__ float bf2f(unsigned short h) { return __uint_as_float((unsigned)h << 16); }
constexpr float RMS_EPS = 1e-6f;
constexpr float LOG2E = 1.4426950408889634f;
__device__ __forceinline__ float rstd_from_partials(const float* ssp, int row) {
    const f32x4* p = (const f32x4*)(ssp + (size_t)row * 16);
    const f32x4 a = p[0], b = p[1], c = p[2], d = p[3];
    const float s = (((a[0] + a[1]) + (a[2] + a[3])) + ((b[0] + b[1]) + (b[2] + b[3]))) + (((c[0] + c[1]) + (c[2] + c[3])) + ((d[0] + d[1]) + (d[2] + d[3])));
    return __builtin_amdgcn_rsqf(s * (1.0f / 1024.0f) + RMS_EPS);
}
__device__ __forceinline__ void rstd8_from_partials(const float* ssp, int row0, int fq, float (&rs)[8]) {
    f32x4 q[8];
#pragma unroll
    for (int i = 0; i < 8; ++i) q[i] = *(const f32x4*)(ssp + (size_t)(row0 + (i >> 2) * HALF + (i & 3) * 16) * 16 + 4 * fq);
#pragma unroll
    for (int i = 0; i < 8; ++i) { float s = (q[i][0] + q[i][1]) + (q[i][2] + q[i][3]); s += __shfl_xor(s, 16); s += __shfl_xor(s, 32); rs[i] = __builtin_amdgcn_rsqf(s * (1.0f / 1024.0f) + RMS_EPS); }
    asm volatile("" ::: "memory");
}
__device__ __forceinline__ float sigmoidf_fast(float x) { return __builtin_amdgcn_rcpf(1.0f + __builtin_amdgcn_exp2f(-x * LOG2E)); }

template <bool PARTIAL> struct EpiSwiglu {
    static constexpr bool PERM = true, AFTER_DRAIN = false;
    bf16_t* H; const float* rs;
    __device__ __forceinline__ void operator()(const f32x4 (&acc)[2][2][4][2], const Unit& u, int wr, int wc, int fr, int fq) const {
        const int row0 = u.pm * BM + wr * 64 + fr, col0 = u.pn * 128 + wc * 32 + 8 * fq;
        float rsv[8];
        if (PARTIAL) rstd8_from_partials(rs, row0, fq, rsv);
        else {
#pragma unroll
            for (int i = 0; i < 8; ++i) rsv[i] = rs[row0 + (i >> 2) * HALF + (i & 3) * 16]; }
#pragma unroll
        for (int ai = 0; ai < 2; ++ai)
#pragma unroll
            for (int m = 0; m < 4; ++m) {
                const int row = row0 + ai * HALF + m * 16;
                const float r = rsv[ai * 4 + m];
                f32x4 o[2];
#pragma unroll
                for (int n = 0; n < 2; ++n) {
                    const f32x4 g = acc[ai][0][m][n] * r, up = acc[ai][1][m][n] * r;
#pragma unroll
                    for (int e = 0; e < 4; ++e) o[n][e] = g[e] * sigmoidf_fast(g[e]) * up[e];
                }
                *(u32x4*)(H + (size_t)row * 2816 + col0) = pack8(o[0], o[1]);
            }
    }
};

template <int MODE> struct EpiResid {
    static constexpr bool PERM = true, AFTER_DRAIN = false;
    const float* xp; const float* xs; float* X1; bf16_t* XB; float* ssp; float* out;
    __device__ __forceinline__ void operator()(const f32x4 (&acc)[2][2][4][2], const Unit& u, int wr, int wc, int fr, int fq) const {
        const int row0 = u.pm * BM + wr * 64 + fr, col0 = u.pn * BM + wc * 32 + 8 * fq;
        const float alpha = (MODE == 1) ? 1.0f : 0.5f;
#pragma unroll
        for (int ai = 0; ai < 2; ++ai)
#pragma unroll
            for (int m = 0; m < 4; ++m) {
                const int row = row0 + ai * HALF + m * 16;
                const float* bp = (MODE == 0) ? ((row < 16384) ? xp + (size_t)row * 1024 : xs + (size_t)(row - 16384) * 1024) : X1 + (size_t)row * 1024;
                float ss = 0.f;
#pragma unroll
                for (int bj = 0; bj < 2; ++bj) {
                    const int col = col0 + bj * HALF;
                    const f32x4 b0 = *(const f32x4*)(bp + col), b1 = *(const f32x4*)(bp + col + 4);
                    const f32x4 v0 = b0 + acc[ai][bj][m][0] * alpha, v1 = b1 + acc[ai][bj][m][1] * alpha;
                    if (MODE == 2) { *(f32x4*)(out + (size_t)row * 1024 + col) = v0; *(f32x4*)(out + (size_t)row * 1024 + col + 4) = v1; }
                    else {
                        *(f32x4*)(X1 + (size_t)row * 1024 + col) = v0; *(f32x4*)(X1 + (size_t)row * 1024 + col + 4) = v1;
                        *(u32x4*)(XB + (size_t)row * 1024 + col) = pack8(v0, v1);
                        ss += ((v0[0] * v0[0] + v0[1] * v0[1]) + (v0[2] * v0[2] + v0[3] * v0[3])) + ((v1[0] * v1[0] + v1[1] * v1[1]) + (v1[2] * v1[2] + v1[3] * v1[3]));
                    }
                }
                if (MODE != 2) { ss += __shfl_xor(ss, 16); ss += __shfl_xor(ss, 32); if (fq == 0) ssp[(size_t)row * 16 + u.pn * 4 + wc] = ss; }
                if (m & 1) asm volatile("" ::: "memory");
            }
    }
};

struct EpiIn {
    static constexpr bool PERM = true, AFTER_DRAIN = false;
    const float* ssp; bf16_t *Q, *K, *V; float* U; bf16_t *GA, *GB; const float *qn, *kn; float* out;
    __device__ __forceinline__ void operator()(const f32x4 (&acc)[2][2][4][2], const Unit& u, int wr, int wc, int fr, int fq) const {
        const int row0 = u.pm * BM + wr * 64 + fr, pn = u.pn;
        float rsv[8]; rstd8_from_partials(ssp, row0, fq, rsv);
        constexpr size_t O_KVP[3] = {17039360u, 17301504u, 18350080u}, O_KVS[3] = {22575104u, 24672256u, 33060864u};
        constexpr size_t O_POOLP = 22544384u, O_POOLS = 66615296u;
        if (pn < 6) {
            const bool isk = pn >= 3; const int head = 4 * (isk ? pn - 3 : pn) + wc, g = head >> 2, hs = head & 3, win = 128 << (2 * g);
            const float* gn = (isk ? kn : qn) + head * 64 + 8 * fq;
            f32x4 gv[2][2];
#pragma unroll
            for (int bj = 0; bj < 2; ++bj)
#pragma unroll
                for (int n = 0; n < 2; ++n) gv[bj][n] = *(const f32x4*)(gn + 32 * bj + 4 * n);
            bf16_t* dst = isk ? K : Q;
#pragma unroll
            for (int ai = 0; ai < 2; ++ai)
#pragma unroll
                for (int m = 0; m < 4; ++m) {
                    const int row = row0 + ai * HALF + m * 16; const float rs = rsv[ai * 4 + m];
                    f32x4 v[2][2]; float ss = 0.f;
#pragma unroll
                    for (int bj = 0; bj < 2; ++bj)
#pragma unroll
                        for (int n = 0; n < 2; ++n) { v[bj][n] = acc[ai][bj][m][n] * rs; const f32x4 x = v[bj][n]; ss += (x[0] * x[0] + x[1] * x[1]) + (x[2] * x[2] + x[3] * x[3]); }
                    ss += __shfl_xor(ss, 16); ss += __shfl_xor(ss, 32);
                    const float r2 = __builtin_amdgcn_rsqf(ss * (1.0f / 64.0f) + RMS_EPS);
                    float* fo = nullptr;
                    if (isk) {
                        if (row < 16384) { const int b = row >> 12, t = row & 4095; if (t >= 4096 - win) fo = out + O_KVP[g] + ((size_t)(b * win + t - (4096 - win)) * 512 + hs * 64 + 8 * fq); }
                        else { const int s = row - 16384, b = s >> 3, t = s & 7; fo = out + O_KVS[g] + ((size_t)(b * win + win - 8 + t) * 512 + hs * 64 + 8 * fq); }
                    }
#pragma unroll
                    for (int bj = 0; bj < 2; ++bj) {
                        const f32x4 o0 = v[bj][0] * r2 * gv[bj][0], o1 = v[bj][1] * r2 * gv[bj][1];
                        *(u32x4*)(dst + (size_t)row * 768 + head * 64 + 32 * bj + 8 * fq) = pack8(o0, o1);
                        if (fo) { *(f32x4*)(fo + 32 * bj) = o0; *(f32x4*)(fo + 32 * bj + 4) = o1; }
                    }
                }
        } else if (pn < 9) {
            const int cb = (pn - 6) * 256 + wc * 32 + 8 * fq;
#pragma unroll
            for (int ai = 0; ai < 2; ++ai)
#pragma unroll
                for (int m = 0; m < 4; ++m) {
                    const int row = row0 + ai * HALF + m * 16; const float rs = rsv[ai * 4 + m];
#pragma unroll
                    for (int bj = 0; bj < 2; ++bj) {
                        const int c = cb + 128 * bj, head = c >> 6, g = head >> 2, hs = head & 3, win = 128 << (2 * g), dim = c & 63;
                        const f32x4 o0 = acc[ai][bj][m][0] * rs, o1 = acc[ai][bj][m][1] * rs;
                        *(u32x4*)(V + (size_t)row * 768 + c) = pack8(o0, o1);
                        float* fo = nullptr;
                        if (row < 16384) { const int b = row >> 12, t = row & 4095; if (t >= 4096 - win) fo = out + O_KVP[g] + ((size_t)(b * win + t - (4096 - win)) * 512 + 256 + hs * 64 + dim); }
                        else { const int s = row - 16384, b = s >> 3, t = s & 7; fo = out + O_KVS[g] + ((size_t)(b * win + win - 8 + t) * 512 + 256 + hs * 64 + dim); }
                        if (fo) { *(f32x4*)(fo) = o0; *(f32x4*)(fo + 4) = o1; }
                    }
                }
        } else if (pn < 11) {
            const int cb = (pn - 9) * 256 + wc * 32 + 8 * fq;
#pragma unroll
            for (int ai = 0; ai < 2; ++ai)
#pragma unroll
                for (int m = 0; m < 4; ++m) {
                    const int row = row0 + ai * HALF + m * 16; const float rs = rsv[ai * 4 + m];
                    float* fo = nullptr;
                    if (row < 16384) { const int b = row >> 12, t = row & 4095; if (t >= 4081) fo = out + O_POOLP + (size_t)(b * 15 + t - 4081) * 512 + cb; }
                    else { const int s = row - 16384, b = s >> 3, t = s & 7; fo = out + O_POOLS + (size_t)(b * 15 + 7 + t) * 512 + cb; }
#pragma unroll
                    for (int bj = 0; bj < 2; ++bj) {
                        const f32x4 o0 = acc[ai][bj][m][0] * rs, o1 = acc[ai][bj][m][1] * rs;
                        float* up = U + (size_t)row * 512 + cb + 128 * bj;
                        *(f32x4*)(up) = o0; *(f32x4*)(up + 4) = o1;
                        if (fo) { *(f32x4*)(fo + 128 * bj) = o0; *(f32x4*)(fo + 128 * bj + 4) = o1; }
                    }
                }
        } else {
            const bool isb = pn >= 15; bf16_t* G = isb ? GB : GA; const int cb = (pn - (isb ? 15 : 11)) * 256 + wc * 32 + 8 * fq;
#pragma unroll
            for (int ai = 0; ai < 2; ++ai)
#pragma unroll
                for (int m = 0; m < 4; ++m) {
                    const int row = row0 + ai * HALF + m * 16; const float rs = rsv[ai * 4 + m];
#pragma unroll
                    for (int bj = 0; bj < 2; ++bj) {
                        f32x4 o0 = acc[ai][bj][m][0] * rs, o1 = acc[ai][bj][m][1] * rs;
#pragma unroll
                        for (int e = 0; e < 4; ++e) { o0[e] = sigmoidf_fast(o0[e]); o1[e] = sigmoidf_fast(o1[e]); }
                        *(u32x4*)(G + (size_t)row * 1024 + cb + 128 * bj) = pack8(o0, o1);
                    }
                }
        }
    }
};

template <int PART> struct EpiMerge {
    static constexpr bool PERM = true, AFTER_DRAIN = false;
    const bf16_t* G; bf16_t* T; bf16_t* MG;
    __device__ __forceinline__ void operator()(const f32x4 (&acc)[2][2][4][2], const Unit& u, int wr, int wc, int fr, int fq) const {
        const int row0 = u.pm * BM + wr * 64 + fr, col0 = u.pn * BM + wc * 32 + 8 * fq;
#pragma unroll
        for (int ai = 0; ai < 2; ++ai)
#pragma unroll
            for (int m = 0; m < 4; ++m) {
                const int row = row0 + ai * HALF + m * 16;
#pragma unroll
                for (int bj = 0; bj < 2; ++bj) {
                    const size_t off = (size_t)row * 1024 + col0 + bj * HALF;
                    const u32x4 gw = *(const u32x4*)(G + off);
                    f32x4 o0, o1;
                    o0[0] = __uint_as_float(gw.x << 16) * acc[ai][bj][m][0][0]; o0[1] = __uint_as_float(gw.x & 0xffff0000u) * acc[ai][bj][m][0][1];
                    o0[2] = __uint_as_float(gw.y << 16) * acc[ai][bj][m][0][2]; o0[3] = __uint_as_float(gw.y & 0xffff0000u) * acc[ai][bj][m][0][3];
                    o1[0] = __uint_as_float(gw.z << 16) * acc[ai][bj][m][1][0]; o1[1] = __uint_as_float(gw.z & 0xffff0000u) * acc[ai][bj][m][1][1];
                    o1[2] = __uint_as_float(gw.w << 16) * acc[ai][bj][m][1][2]; o1[3] = __uint_as_float(gw.w & 0xffff0000u) * acc[ai][bj][m][1][3];
                    if (PART == 1) {
                        const u32x4 tw = *(const u32x4*)(T + off);
                        o0[0] += __uint_as_float(tw.x << 16); o0[1] += __uint_as_float(tw.x & 0xffff0000u); o0[2] += __uint_as_float(tw.y << 16); o0[3] += __uint_as_float(tw.y & 0xffff0000u);
                        o1[0] += __uint_as_float(tw.z << 16); o1[1] += __uint_as_float(tw.z & 0xffff0000u); o1[2] += __uint_as_float(tw.w << 16); o1[3] += __uint_as_float(tw.w & 0xffff0000u);
                        *(u32x4*)(MG + off) = pack8(o0, o1);
                    } else {
                        *(u32x4*)(T + off) = pack8(o0, o1);
                    }
                }
                if (m & 1) asm volatile("" ::: "memory");
            }
    }
};

struct NoSide { static constexpr int NV = 1; __device__ __forceinline__ bool pre(f32x4 (&)[1], int) const { return false; } __device__ __forceinline__ void post(const f32x4 (&)[1], bool, int) const {} };
struct SideCopy {
    static constexpr int NV = 6;
    static constexpr int CPB2 = 680, CPB1 = 168, CPB0 = 40;
    static constexpr int NCH2 = 32 * CPB2, NCH1 = 32 * CPB1, NCH0 = 32 * CPB0, NCH = NCH2 + NCH1 + NCH0;
    const float *c128, *c512, *c2048; float* out; int gw; int* step;
    __device__ __forceinline__ bool locate(int id, const f32x4*& s, f32x4*& d) const {
        if (id >= NCH) return false;
        if (id < NCH2) { const int b = id / CPB2, k = id - b * CPB2; s = (const f32x4*)(c2048 + ((size_t)b * 2048 + 8) * 512) + k * 384; d = (f32x4*)(out + 33060864u + (size_t)b * 2048 * 512) + k * 384; return true; }
        id -= NCH2;
        if (id < NCH1) { const int b = id / CPB1, k = id - b * CPB1; s = (const f32x4*)(c512 + ((size_t)b * 512 + 8) * 512) + k * 384; d = (f32x4*)(out + 24672256u + (size_t)b * 512 * 512) + k * 384; return true; }
        id -= NCH1;
        { const int b = id / CPB0, k = id - b * CPB0; s = (const f32x4*)(c128 + ((size_t)b * 128 + 8) * 512) + k * 384; d = (f32x4*)(out + 22575104u + (size_t)b * 128 * 512) + k * 384; return true; }
    }
    __device__ __forceinline__ bool pre(f32x4 (&v)[NV], int lane) const {
        const f32x4* s; f32x4* d; if (!locate(*step * 2048 + gw, s, d)) return false;
#pragma unroll
        for (int q = 0; q < NV; ++q) v[q] = __builtin_nontemporal_load(s + q * 64 + lane);
        return true;
    }
    __device__ __forceinline__ void post(const f32x4 (&v)[NV], bool ok, int lane) const {
        if (ok) { const f32x4* s; f32x4* d; locate(*step * 2048 + gw, s, d);
#pragma unroll
            for (int q = 0; q < NV; ++q) __builtin_nontemporal_store(v[q], d + q * 64 + lane); }
        *step += 1;
    }
};
template <class Epi, class Sched, bool ALIGN_EPI = false, bool SP2 = false, class Side = NoSide>
__device__ __forceinline__ void gemm_phase(PG8_LAS unsigned char* lds, const Gemm g, const Sched& S, const Epi& E, const Side side = Side()) {
    int tid_ = threadIdx.x; asm volatile("" : "+v"(tid_));
    const int tid = tid_, wid = __builtin_amdgcn_readfirstlane(tid >> 6), lane = tid & 63, wr = wid >> 2, wc = wid & 3, fr = lane & 15, fq = lane >> 4;
    const int K = g.K, nt = K / BK;
    unsigned voffA[2], voffB[2];
#pragma unroll
    for (int i = 0; i < 2; ++i) { int R, C; stage_rc(tid * 16 + i * 8192, R, C); const int Rb = Epi::PERM ? ((R & ~31) + perm32(R & 31)) : R;
        voffA[i] = (unsigned)(R * K + C) * 2u; voffB[i] = (unsigned)(Rb * K + C) * 2u; }
    const size_t kstep = (size_t)(BK * 2);
    const size_t hstep = (size_t)HALF * K * 2;
    const size_t tstep = 2 * hstep;
    const unsigned ldsw = (unsigned)wid * 1024u;
    const int aoff = lds_byte(wr * 64 + fr, fq * 8), boff = lds_byte(wc * 32 + fr, fq * 8);
#define PG8_SA(b, h) (((b) * 2 + (h)) * HTB)
#define PG8_SB(b, h) ((4 + (b) * 2 + (h)) * HTB)
#define PG8_STAGE(bufoff, gbase, voff) do { _Pragma("unroll") for (int _i = 0; _i < 2; ++_i) \
        __builtin_amdgcn_global_load_lds((const unsigned*)((const char*)(gbase) + (voff)[_i]), (PG8_LAS unsigned*)(lds + (bufoff) + ldsw + _i * 8192), 16, 0, 0); } while (0)
#define PG8_LDA(dst, b, h) do { _Pragma("unroll") for (int m = 0; m < 4; ++m) _Pragma("unroll") for (int k = 0; k < 2; ++k) dst[m][k] = *(const PG8_LAS bf16x8*)(lds + PG8_SA(b, h) + aoff + m * 2048 + k * 1024); } while (0)
#define PG8_LDB(dst, b, h) do { _Pragma("unroll") for (int n = 0; n < 2; ++n) _Pragma("unroll") for (int k = 0; k < 2; ++k) dst[n][k] = *(const PG8_LAS bf16x8*)(lds + PG8_SB(b, h) + boff + n * 2048 + k * 1024); } while (0)
#define PG8_MMA(ai, bj, At, Bt) do { __builtin_amdgcn_s_setprio(1); _Pragma("unroll") for (int m = 0; m < 4; ++m) _Pragma("unroll") for (int n = 0; n < 2; ++n) _Pragma("unroll") for (int k = 0; k < 2; ++k) \
        acc[ai][bj][m][n] = __builtin_amdgcn_mfma_f32_16x16x32_bf16(Bt[n][k], At[m][k], acc[ai][bj][m][n], 0, 0, 0); __builtin_amdgcn_s_setprio(0); } while (0)
#define PG8_WAIT_V(n) asm volatile("s_waitcnt vmcnt(" #n ")" ::: "memory")
#define PG8_WAIT_L(n) asm volatile("s_waitcnt lgkmcnt(" #n ")" ::: "memory")
#define PG8_BAR __builtin_amdgcn_s_barrier()
#define PG8_SCHED __builtin_amdgcn_sched_barrier(0)
    Unit cur, nxt; int ui = 0;
    if (!S.next(0, cur)) return;
    f32x4 acc[2][2][4][2];
#pragma unroll
    for (int a = 0; a < 2; ++a)
#pragma unroll
        for (int b = 0; b < 2; ++b)
#pragma unroll
            for (int m = 0; m < 4; ++m)
#pragma unroll
                for (int n = 0; n < 2; ++n) acc[a][b][m][n] = (f32x4){0.f, 0.f, 0.f, 0.f};
    bf16x8 At[4][2], B0[2][2], B1[2][2];
    const char* cA = (const char*)g.A + (size_t)cur.pm * tstep; const char* cB = (const char*)g.Bt + (size_t)cur.pn * tstep;
    S.a_ready(cur);
    if constexpr (SP2) {
        PG8_STAGE(PG8_SB(0, 0), cB, voffB); PG8_STAGE(PG8_SB(0, 1), cB + hstep, voffB); PG8_STAGE(PG8_SA(0, 0), cA, voffA); PG8_STAGE(PG8_SA(0, 1), cA + hstep, voffA);
        if (wr == 1) PG8_BAR;
        PG8_WAIT_V(2); PG8_BAR;
        PG8_STAGE(PG8_SB(1, 0), cB + kstep, voffB); PG8_STAGE(PG8_SA(1, 0), cA + kstep, voffA); PG8_STAGE(PG8_SB(1, 1), cB + hstep + kstep, voffB);
        PG8_WAIT_V(6); PG8_BAR;
    } else {
        PG8_STAGE(PG8_SB(0, 0), cB, voffB); PG8_STAGE(PG8_SA(0, 0), cA, voffA); PG8_STAGE(PG8_SB(0, 1), cB + hstep, voffB); PG8_STAGE(PG8_SA(0, 1), cA + hstep, voffA);
        if (wr == 1) PG8_BAR;
        PG8_WAIT_V(4); PG8_BAR;
        PG8_STAGE(PG8_SB(1, 0), cB + kstep, voffB); PG8_STAGE(PG8_SA(1, 0), cA + kstep, voffA); PG8_STAGE(PG8_SB(1, 1), cB + hstep + kstep, voffB);
        PG8_WAIT_V(6); PG8_BAR;
    }
    for (;;) {
        const bool has_next = S.next(ui + 1, nxt);
        const char* nA = has_next ? (const char*)g.A + (size_t)nxt.pm * tstep : cA; const char* nB = has_next ? (const char*)g.Bt + (size_t)nxt.pn * tstep : cB;
        for (int t = 0; t < nt; t += 2) {
            const bool last = (t == nt - 2);
            const char* a1 = cA + (size_t)(t + 1) * kstep;
            const char* a2 = last ? nA : cA + (size_t)(t + 2) * kstep; const char* b2 = last ? nB : cB + (size_t)(t + 2) * kstep;
            const char* a3 = a2 + kstep; const char* b3 = b2 + kstep;
            if (last && has_next) S.a_ready(nxt);
            if constexpr (SP2) {
            PG8_LDB(B0, 0, 0); PG8_LDB(B1, 0, 1); PG8_SCHED; PG8_LDA(At, 0, 0); PG8_STAGE(PG8_SA(1, 1), a1 + hstep, voffA);
            PG8_WAIT_V(8); PG8_WAIT_L(0); PG8_BAR; PG8_MMA(0, 0, At, B0); PG8_MMA(0, 1, At, B1); PG8_BAR; PG8_SCHED;
            PG8_LDA(At, 0, 1); PG8_STAGE(PG8_SB(0, 0), b2, voffB); PG8_STAGE(PG8_SB(0, 1), b2 + hstep, voffB); PG8_STAGE(PG8_SA(0, 0), a2, voffA);
            PG8_WAIT_V(8); PG8_WAIT_L(0); PG8_BAR; PG8_MMA(1, 0, At, B0); PG8_MMA(1, 1, At, B1); PG8_BAR; PG8_SCHED;
            PG8_LDB(B0, 1, 0); PG8_LDB(B1, 1, 1); PG8_SCHED; PG8_LDA(At, 1, 0); PG8_STAGE(PG8_SA(0, 1), a2 + hstep, voffA);
            PG8_WAIT_V(8); PG8_WAIT_L(0); PG8_BAR; PG8_MMA(0, 0, At, B0); PG8_MMA(0, 1, At, B1); PG8_BAR; PG8_SCHED;
            PG8_LDA(At, 1, 1); PG8_STAGE(PG8_SB(1, 0), b3, voffB); PG8_STAGE(PG8_SB(1, 1), b3 + hstep, voffB); PG8_STAGE(PG8_SA(1, 0), a3, voffA);
            PG8_WAIT_V(8); PG8_WAIT_L(0); PG8_BAR; PG8_MMA(1, 0, At, B0); PG8_MMA(1, 1, At, B1); PG8_BAR; PG8_SCHED;
            } else {
            PG8_LDB(B0, 0, 0); PG8_SCHED; PG8_LDA(At, 0, 0); PG8_STAGE(PG8_SA(1, 1), a1 + hstep, voffA);
            PG8_WAIT_L(8); PG8_BAR; PG8_WAIT_L(0); PG8_MMA(0, 0, At, B0); PG8_BAR; PG8_SCHED;
            PG8_LDB(B1, 0, 1); PG8_STAGE(PG8_SB(0, 0), b2, voffB);
            PG8_BAR; PG8_WAIT_L(0); PG8_MMA(0, 1, At, B1); PG8_BAR;
            PG8_LDA(At, 0, 1); PG8_STAGE(PG8_SA(0, 0), a2, voffA);
            PG8_BAR; PG8_WAIT_L(0); PG8_MMA(1, 0, At, B0); PG8_BAR; PG8_SCHED;
            PG8_STAGE(PG8_SB(0, 1), b2 + hstep, voffB);
            PG8_WAIT_V(6); PG8_BAR; PG8_MMA(1, 1, At, B1); PG8_BAR;
            PG8_LDB(B0, 1, 0); PG8_SCHED; PG8_LDA(At, 1, 0); PG8_STAGE(PG8_SA(0, 1), a2 + hstep, voffA);
            PG8_WAIT_L(8); PG8_BAR; PG8_WAIT_L(0); PG8_MMA(0, 0, At, B0); PG8_BAR; PG8_SCHED;
            PG8_LDB(B1, 1, 1); PG8_STAGE(PG8_SB(1, 0), b3, voffB);
            PG8_BAR; PG8_WAIT_L(0); PG8_MMA(0, 1, At, B1); PG8_BAR;
            PG8_LDA(At, 1, 1); PG8_STAGE(PG8_SA(1, 0), a3, voffA);
            PG8_BAR; PG8_WAIT_L(0); PG8_MMA(1, 0, At, B0); PG8_BAR; PG8_SCHED;
            PG8_STAGE(PG8_SB(1, 1), b3 + hstep, voffB);
            PG8_WAIT_V(6); PG8_BAR; PG8_MMA(1, 1, At, B1); PG8_BAR;
            }
        }
        if constexpr (ALIGN_EPI) { if (wr == 0) PG8_BAR; }
        if constexpr (!Epi::AFTER_DRAIN) { int t2_ = threadIdx.x; asm volatile("" : "+v"(t2_)); const int lane2_ = t2_ & 63;
            f32x4 sv_[Side::NV]; const bool sok_ = side.pre(sv_, lane2_); E(acc, cur, wr, wc, lane2_ & 15, lane2_ >> 4); side.post(sv_, sok_, lane2_); S.done(cur); }
        if (!has_next) break;
#pragma unroll
        for (int a = 0; a < 2; ++a)
#pragma unroll
            for (int b = 0; b < 2; ++b)
#pragma unroll
                for (int m = 0; m < 4; ++m)
#pragma unroll
                    for (int n = 0; n < 2; ++n) acc[a][b][m][n] = (f32x4){0.f, 0.f, 0.f, 0.f};
        cur = nxt; cA = nA; cB = nB; ++ui;
        if constexpr (ALIGN_EPI) { if (wr == 1) PG8_BAR; }
    }
    PG8_WAIT_V(0);
    if constexpr (!ALIGN_EPI) { if (wr == 0) PG8_BAR; }
    PG8_BAR;
    if constexpr (Epi::AFTER_DRAIN) { E.fused(acc, cur, wr, wc, fr, fq, lds, wid, lane); S.done(cur); }
#undef PG8_SA
#undef PG8_SB
#undef PG8_STAGE
#undef PG8_LDA
#undef PG8_LDB
#undef PG8_MMA
#undef PG8_WAIT_V
#undef PG8_WAIT_L
#undef PG8_BAR
#undef PG8_SCHED
}
}

constexpr int NWAVES = 8;
constexpr int DM = 1024, NBATCH = 4, SEQ = 4096, DBATCH = 32, DSEQ = 8;
constexpr int MP = NBATCH * SEQ, MS = DBATCH * DSEQ, M = MP + MS;
constexpr int FF = 2816, FF2 = 5632, INW = 4864, AW = 768, AOW = 256, PW = 512;
constexpr size_t O_Y = 0, O_KV128P = 17039360u, O_KV512P = 17301504u, O_KV2048P = 18350080u, O_POOLP = 22544384u,
                 O_KV128S = 22575104u, O_KV512S = 24672256u, O_KV2048S = 33060864u, O_POOLS = 66615296u, O_END = 66861056u;
constexpr size_t MiB = 1u << 20;
constexpr size_t WS_CTL = 0, CTL_ZERO_BYTES = 1 * MiB;
constexpr size_t WS_WUP1 = 2 * MiB, WS_WDN1 = 13 * MiB, WS_WIN = 19 * MiB, WS_WAB = 29 * MiB, WS_WEFF = 30 * MiB, WS_WOUT = 31 * MiB, WS_WUP2 = 33 * MiB, WS_WDN2 = 44 * MiB;
constexpr size_t WS_RSTD0 = 50 * MiB, WS_SSP1 = 51 * MiB, WS_SSP2 = 53 * MiB, WS_BIAS = 55 * MiB;
constexpr size_t WS_XB = 56 * MiB;
constexpr size_t WS_X1 = 90 * MiB;
constexpr size_t WS_R = 156 * MiB;
constexpr size_t WS_Q = WS_R, WS_K = WS_Q + 25 * MiB, WS_V = WS_K + 25 * MiB;
constexpr size_t WS_U = WS_V + 25 * MiB;
constexpr size_t WS_GA = WS_U + 33 * MiB, WS_GB = WS_GA + 33 * MiB;
constexpr size_t WS_AA = WS_GB + 33 * MiB, WS_DD = WS_AA + 9 * MiB;
constexpr size_t WS_T = WS_DD + 17 * MiB, WS_MG = WS_T + 33 * MiB, WS_END = WS_MG + 33 * MiB;
static_assert(WS_END <= 512 * MiB, "d_ws map");
static_assert(WS_R + (size_t)M * FF * 2 <= WS_END, "H fits");
constexpr int CW_TMO = 0, CW_BAR = 4096;
constexpr int RING_OFF = 0, RING_BYTES = 131072;
constexpr int LDSCTL_OFF = RING_BYTES, MISC_OFF = LDSCTL_OFF + 320;
constexpr int LDS_BYTES = 147456;
#define GAS __attribute__((address_space(1)))
#define LAS __attribute__((address_space(3)))
typedef unsigned short bf16;
typedef unsigned v4u __attribute__((ext_vector_type(4)));
typedef float f32x4 __attribute__((ext_vector_type(4)));
typedef short bf16x8 __attribute__((ext_vector_type(8)));
typedef GAS unsigned gu32;
typedef GAS unsigned long long gu64;
#define RLX_AGENT __ATOMIC_RELAXED, __HIP_MEMORY_SCOPE_AGENT
#define LDS_WAIT() asm volatile("s_waitcnt lgkmcnt(0)" ::: "memory")
#define VM_WAIT() asm volatile("s_waitcnt vmcnt(0)" ::: "memory")
__device__ __forceinline__ unsigned long long rt() { return __builtin_amdgcn_s_memrealtime(); }
__device__ __forceinline__ unsigned f2bf(float f) { unsigned u = __builtin_bit_cast(unsigned, f); return (u + 0x7fffu + ((u >> 16) & 1u)) >> 16; }
__device__ __forceinline__ unsigned pk2(float lo, float hi) { return f2bf(lo) | (f2bf(hi) << 16); }

#define XB_TMO      128
#define XB_XCNT(j)  (256  + 64 * (j))
#define XB_XSUB(j)  (1280 + 64 * (j))
#define XB_XGEN(j)  (2304 + 64 * (j))
#define XB_TOP      3328
#define XB_TOPGEN   3392
#define XCD_BAR_WORDS 3456
#define XB_SPIN_CAP (1u << 18)

__device__ __forceinline__ unsigned xb_ld(unsigned* p)              { return __hip_atomic_load(p, __ATOMIC_RELAXED, __HIP_MEMORY_SCOPE_AGENT); }
__device__ __forceinline__ unsigned xb_add(unsigned* p, unsigned v) { return __hip_atomic_fetch_add(p, v, __ATOMIC_RELAXED, __HIP_MEMORY_SCOPE_AGENT); }
__device__ __forceinline__ unsigned xb_xcc_id() { return (unsigned)__builtin_amdgcn_s_getreg((3 << 11) | 20) & 0xFu; }
#define XB_SPIN(cond, bar) do { unsigned _sp = 0; while (cond) { __builtin_amdgcn_s_sleep(1); \
    if ((++_sp & 255u) == 0u) { if (xb_ld(&(bar)[XB_TMO])) break; if (_sp > XB_SPIN_CAP) { atomicAdd(&(bar)[XB_TMO], 1u); break; } } } } while (0)

struct XcdBarrier {
    unsigned* bar; unsigned x;
    volatile LAS unsigned* st;
};

__device__ __forceinline__ XcdBarrier xcd_barrier_post(unsigned* bar, volatile LAS unsigned* st) {
    XcdBarrier b; b.bar = bar; b.x = xb_xcc_id(); b.st = st;
    if (threadIdx.x == 0) (void)xb_add(&bar[XB_XCNT(b.x)], 1u);
    return b;
}
__device__ __forceinline__ void xcd_barrier_complete(unsigned* bar, unsigned x, unsigned& nloc, unsigned& nx) {
    const unsigned G = gridDim.x * gridDim.y * gridDim.z;
    unsigned sum, cnt, mine, sp = 0u;
    for (;;) {
        sum = 0u; cnt = 0u; mine = 0u;
#pragma unroll
        for (unsigned j = 0; j < 16; ++j) { const unsigned c = xb_ld(&bar[XB_XCNT(j)]); sum += c; cnt += (c > 0u) ? 1u : 0u; mine = (j == x) ? c : mine; }
        if (sum == G) break;
        __builtin_amdgcn_s_sleep(1);
        if ((++sp & 255u) == 0u) { if (xb_ld(&bar[XB_TMO])) break; if (sp > XB_SPIN_CAP) { atomicAdd(&bar[XB_TMO], 1u); break; } }
    }
    nloc = mine > 0u ? mine : 1u; nx = cnt > 0u ? cnt : 1u;
}

__device__ __forceinline__ void xcd_barrier(const XcdBarrier& b) {
    asm volatile("s_waitcnt vmcnt(0)" ::: "memory");
    __syncthreads();
    if (threadIdx.x == 0) {
        unsigned* bar = b.bar;
        __builtin_amdgcn_s_waitcnt(0);
        unsigned nloc = b.st[0], nx = b.st[1];
        if (nloc == 0u) { xcd_barrier_complete(bar, b.x, nloc, nx); b.st[0] = nloc; b.st[1] = nx; }
        const unsigned old = xb_add(&bar[XB_XSUB(b.x)], 1u);
        const unsigned gen = old / nloc;
        if (old + 1u == (gen + 1u) * nloc) {
            __builtin_amdgcn_fence(__ATOMIC_RELEASE, "agent");
            asm volatile("s_waitcnt vmcnt(0)" ::: "memory");
            const unsigned og = xb_add(&bar[XB_TOP], 1u);
            const unsigned tg = og / nx;
            if (og + 1u == (tg + 1u) * nx) xb_add(&bar[XB_TOPGEN], 1u);
            else XB_SPIN(xb_ld(&bar[XB_TOPGEN]) == tg, bar);
            __builtin_amdgcn_fence(__ATOMIC_ACQUIRE, "agent");
            xb_add(&bar[XB_XGEN(b.x)], 1u);
            asm volatile("s_waitcnt vmcnt(0)" ::: "memory");
        } else {
            XB_SPIN(xb_ld(&bar[XB_XGEN(b.x)]) == gen, bar);
            __builtin_amdgcn_fence(__ATOMIC_ACQUIRE, "agent");
            asm volatile("s_waitcnt vmcnt(0)" ::: "memory");
        }
    }
    __syncthreads();
}

struct Frame {
    LAS unsigned char* lds;
    volatile LAS unsigned* MISC;
    gu32* ctl;
    int tid, lane, wave;
    int vcu, G;
};
__device__ __forceinline__ float wave_sum(float v) {
#pragma unroll
    for (int o = 1; o < 64; o <<= 1) v += __shfl_xor(v, o);
    return v;
}
__device__ __forceinline__ float wave_max(float v) {
#pragma unroll
    for (int o = 1; o < 64; o <<= 1) v = fmaxf(v, __shfl_xor(v, o));
    return v;
}
__constant__ unsigned char T5B[3][132] = {
 {0,1,2,3,4,5,6,7,8,9,10,11,12,13,14,15,16,16,16,16,16,16,17,17,17,17,17,17,17,17,18,18,18,18,18,18,18,18,18,18,19,19,19,19,19,19,19,19,19,19,19,19,19,19,20,20,20,20,20,20,20,20,20,20,20,20,20,20,20,20,20,20,20,21,21,21,21,21,21,21,21,21,21,21,21,21,21,21,21,21,21,21,21,21,21,21,21,21,21,22,22,22,22,22,22,22,22,22,22,22,22,22,22,22,22,22,22,22,22,22,22,22,22,22,22,22,22,22,22,0,0,0},
 {0,4,8,12,16,16,17,17,18,18,19,19,19,19,20,20,20,20,20,21,21,21,21,21,21,22,22,22,22,22,22,22,22,22,23,23,23,23,23,23,23,23,23,23,23,23,24,24,24,24,24,24,24,24,24,24,24,24,24,24,24,24,25,25,25,25,25,25,25,25,25,25,25,25,25,25,25,25,25,25,25,25,25,26,26,26,26,26,26,26,26,26,26,26,26,26,26,26,26,26,26,26,26,26,26,26,26,26,26,26,26,26,26,27,27,27,27,27,27,27,27,27,27,27,27,27,27,27,27,0,0,0},
 {0,16,18,19,20,21,21,22,22,23,23,23,24,24,24,24,25,25,25,25,25,26,26,26,26,26,26,26,26,27,27,27,27,27,27,27,27,27,27,28,28,28,28,28,28,28,28,28,28,28,28,28,29,29,29,29,29,29,29,29,29,29,29,29,29,29,29,29,29,29,30,30,30,30,30,30,30,30,30,30,30,30,30,30,30,30,30,30,30,30,30,30,30,30,30,31,31,31,31,31,31,31,31,31,31,31,31,31,31,31,31,31,31,31,31,31,31,31,31,31,31,31,31,31,31,31,31,31,31,0,0,0}};

template <int MAP> __device__ __forceinline__ void p0_transpose_item(const float* W, int K, int N, bf16* WT, const float* gain, LAS float* scr, int item, int lane) {
    const int nblk = N / 32, kb = item / nblk, nb = item % nblk, k0 = 64 * kb, n0 = 32 * nb;
    int v0 = n0;
    if (MAP == 1) { const int c = n0 < FF ? n0 : n0 - FF; v0 = 256 * (c >> 7) + (n0 < FF ? 0 : 128) + (c & 127); }
    if (MAP == 2) { if (n0 < 1536) { const int o = n0 & 255; v0 = (n0 & ~255) + 128 * ((o >> 5) & 1) + 32 * (o >> 6); } }
    f32x4 wv[8]; const int kr = lane >> 3, n4 = (lane & 7) * 4;
#pragma unroll
    for (int i = 0; i < 8; ++i) wv[i] = *(const f32x4*)(W + (size_t)(k0 + kr + 8 * i) * N + n0 + n4);
#pragma unroll
    for (int i = 0; i < 8; ++i) { const int kk = kr + 8 * i; f32x4 w = wv[i]; if (gain) w = w * gain[k0 + kk];
        LAS float* d = scr + kk * 33 + n4; d[0] = w[0]; d[1] = w[1]; d[2] = w[2]; d[3] = w[3]; }
    LDS_WAIT(); asm volatile("" ::: "memory");
    const int c = lane & 7;
#pragma unroll
    for (int j = 0; j < 4; ++j) { const int n = (lane >> 3) + 8 * j; const LAS float* s = scr + (8 * c) * 33 + n;
        v4u o; o.x = pk2(s[0 * 33], s[1 * 33]); o.y = pk2(s[2 * 33], s[3 * 33]); o.z = pk2(s[4 * 33], s[5 * 33]); o.w = pk2(s[6 * 33], s[7 * 33]);
        *(GAS v4u*)(WT + (size_t)(v0 + n) * K + k0 + 8 * c) = o; }
    LDS_WAIT(); asm volatile("" ::: "memory");
}
struct Ptrs {
    const float *xp, *xs, *c128, *c512, *c2048, *spool, *rbias, *n1, *wup1, *wdn1, *nmix, *win, *qn, *kn, *wg, *pscale, *wab, *wpb, *wout, *n2, *wup2, *wdn2;
    float* out; unsigned char* ws;
};
constexpr int I_UP = (DM / 64) * (FF2 / 32), I_DN = (FF / 64) * (DM / 32), I_IN = (DM / 64) * (INW / 32), I_AB = (AOW / 64) * (DM / 32), I_OUT = (DM / 64) * (DM / 32);
constexpr int WI_WUP1 = 0, WI_WDN1 = I_UP, WI_WIN = WI_WDN1 + I_DN, WI_WAB = WI_WIN + I_IN, WI_WOUT = WI_WAB + I_AB, WI_WUP2 = WI_WOUT + I_OUT, WI_WDN2 = WI_WUP2 + I_UP, WI_END = WI_WDN2 + I_DN;
__device__ __forceinline__ void convert_items(const Ptrs& P, int first, int last, int gwh, int ngwh, LAS float* scr, int lane) {
    unsigned char* ws = P.ws;
    for (int it = first + gwh; it < last; it += ngwh) {
        if (it < WI_WDN1) p0_transpose_item<1>(P.wup1, DM, FF2, (bf16*)(ws + WS_WUP1), P.n1, scr, it - WI_WUP1, lane);
        else if (it < WI_WIN) p0_transpose_item<0>(P.wdn1, FF, DM, (bf16*)(ws + WS_WDN1), nullptr, scr, it - WI_WDN1, lane);
        else if (it < WI_WAB) p0_transpose_item<2>(P.win, DM, INW, (bf16*)(ws + WS_WIN), P.nmix, scr, it - WI_WIN, lane);
        else if (it < WI_WOUT) p0_transpose_item<0>(P.wab, AOW, DM, (bf16*)(ws + WS_WAB), nullptr, scr, it - WI_WAB, lane);
        else if (it < WI_WUP2) p0_transpose_item<0>(P.wout, DM, DM, (bf16*)(ws + WS_WOUT), nullptr, scr, it - WI_WOUT, lane);
        else if (it < WI_WDN2) p0_transpose_item<1>(P.wup2, DM, FF2, (bf16*)(ws + WS_WUP2), P.n2, scr, it - WI_WUP2, lane);
        else p0_transpose_item<0>(P.wdn2, FF, DM, (bf16*)(ws + WS_WDN2), nullptr, scr, it - WI_WDN2, lane);
    }
}

__device__ __forceinline__ void p0_prologue(Frame& F, const Ptrs& P) {
    LAS float* scr = (LAS float*)(F.lds + RING_OFF + F.wave * 16384);
    const int gw = F.vcu * NWAVES + F.wave, NGW = F.G * NWAVES;
    unsigned char* ws = P.ws;
    for (int m0 = gw; m0 < M; m0 += 2 * NGW) {
        f32x4 v[2][4];
#pragma unroll
        for (int q = 0; q < 2; ++q) { const int m = m0 + q * NGW; if (m < M) {
            const float* xrow = (m < MP) ? P.xp + (size_t)m * DM : P.xs + (size_t)(m - MP) * DM; const GAS f32x4* xr = (const GAS f32x4*)xrow + F.lane;
#pragma unroll
            for (int j = 0; j < 4; ++j) v[q][j] = xr[64 * j]; } }
#pragma unroll
        for (int q = 0; q < 2; ++q) { const int m = m0 + q * NGW; if (m < M) {
            float s = 0.f;
#pragma unroll
            for (int j = 0; j < 4; ++j) s += (v[q][j].x * v[q][j].x + v[q][j].y * v[q][j].y) + (v[q][j].z * v[q][j].z + v[q][j].w * v[q][j].w);
            s = wave_sum(s);
            if (F.lane == 0) ((float*)(ws + WS_RSTD0))[m] = __builtin_amdgcn_rsqf(s * (1.0f / DM) + 1e-6f);
            GAS unsigned long long* o8 = (GAS unsigned long long*)((bf16*)(ws + WS_XB) + (size_t)m * DM) + F.lane;
#pragma unroll
            for (int j = 0; j < 4; ++j) o8[64 * j] = (unsigned long long)pk2(v[q][j].x, v[q][j].y) | ((unsigned long long)pk2(v[q][j].z, v[q][j].w) << 32); } }
    }
    convert_items(P, WI_WUP1, WI_WDN1, gw, NGW, scr, F.lane);
    for (int it = gw; it < 128 * 16; it += NGW) {
        const int kq = it >> 4, nb = it & 15, k = 4 * kq, g = k >> 7, kp = k & 127, n = nb * 64 + F.lane;
        const float* wgr = P.wg + ((size_t)g * 128 + kp) * 128; const float* sc = P.pscale + 128 * g; const float* wp = P.wpb + (size_t)(128 * g) * DM + n;
        float cf[4][2];
        { const float s0 = sc[F.lane], s1 = sc[F.lane + 64];
#pragma unroll
          for (int q = 0; q < 4; ++q) { cf[q][0] = wgr[q * 128 + F.lane] * s0; cf[q][1] = wgr[q * 128 + F.lane + 64] * s1; } }
        float a0 = 0.f, a1 = 0.f, a2 = 0.f, a3 = 0.f;
#pragma unroll
        for (int cb = 0; cb < 128; cb += 32) {
            float w[32];
#pragma unroll
            for (int c = 0; c < 32; ++c) w[c] = wp[(size_t)(cb + c) * DM];
#pragma unroll
            for (int c = 0; c < 32; ++c) { const int cc = cb + c, hh = cc >> 6, ln = cc & 63;
                a0 += __int_as_float(__builtin_amdgcn_readlane(__float_as_int(cf[0][hh]), ln)) * w[c]; a1 += __int_as_float(__builtin_amdgcn_readlane(__float_as_int(cf[1][hh]), ln)) * w[c];
                a2 += __int_as_float(__builtin_amdgcn_readlane(__float_as_int(cf[2][hh]), ln)) * w[c]; a3 += __int_as_float(__builtin_amdgcn_readlane(__float_as_int(cf[3][hh]), ln)) * w[c];
            }
        }
        *(GAS unsigned long long*)((bf16*)(ws + WS_WEFF) + (size_t)n * PW + k) = (unsigned long long)pk2(a0, a1) | ((unsigned long long)pk2(a2, a3) << 32);
    }
    if (blockIdx.x == 0) {
        for (int i = F.tid; i < 3 * 4 * 132; i += NWAVES * 64) { const int g = i / (4 * 132), h = (i / 132) & 3, j = i % 132;
            ((float*)(ws + WS_BIAS))[i] = (j <= 128) ? P.rbias[(int)T5B[g][j] * 12 + 4 * g + h] * 1.4426950408889634f : 0.f; }
    }
    for (long i = (long)F.vcu * (NWAVES * 64) + F.tid; i < (long)DBATCH * 7 * 128; i += (long)F.G * (NWAVES * 64)) {
        const long b = i / (7 * 128), r = i - b * (7 * 128);
        ((f32x4*)(P.out + O_POOLS + (size_t)b * 15 * 512))[r] = ((const f32x4*)(P.spool + ((size_t)b * 15 + 8) * 512))[r];
    }
}

typedef float f32x16 __attribute__((ext_vector_type(16)));
typedef short s16x4 __attribute__((ext_vector_type(4)));
typedef short v4i16_t __attribute__((ext_vector_type(4)));
__device__ __forceinline__ int crow(int r, int hi) { return (r & 3) + 8 * (r >> 2) + 4 * hi; }
__device__ __forceinline__ s16x4 vtr(const LAS unsigned char* p) { return __builtin_bit_cast(s16x4, __builtin_amdgcn_ds_read_tr16_b64_v4i16((LAS v4i16_t*)p)); }
__device__ __forceinline__ unsigned cvtpk(float lo, float hi) { typedef float f2 __attribute__((ext_vector_type(2))); typedef __bf16 b2 __attribute__((ext_vector_type(2))); f2 v = {lo, hi}; b2 b = __builtin_convertvector(v, b2); return __builtin_bit_cast(unsigned, b); }

constexpr int ATT_WLDS = 16384;
constexpr int TB_JMIN0 = -512, TB_N0 = 1140, TB_JMIN1 = -128, TB_N1 = 384, TB_JMIN2 = -32, TB_N2 = 192;
constexpr int TB_OFF0 = 0, TB_OFF1 = TB_N0, TB_OFF2 = TB_N0 + TB_N1, TB_TOTAL = TB_N0 + TB_N1 + TB_N2;
constexpr int ATT_TB_OFF = 4096, ATT_SC_OFF = 4096 + 7168;

struct AttnState { f32x16 o0, o1, lacc; float m; };

__device__ __forceinline__ void attn_build_tables(const float* BIAS, int h, LAS float* tb, int lane) {
#pragma unroll 1
    for (int i = lane; i < TB_TOTAL; i += 64) {
        int g, j;
        if (i < TB_OFF1) { g = 0; j = i + TB_JMIN0; } else if (i < TB_OFF2) { g = 1; j = i - TB_OFF1 + TB_JMIN1; } else { g = 2; j = i - TB_OFF2 + TB_JMIN2; }
        tb[i] = ((unsigned)j <= 128u) ? BIAS[(g * 4 + h) * 132 + j] : -INFINITY;
    }
    asm volatile("s_waitcnt lgkmcnt(0)" ::: "memory");
}

template <int G, bool PMASK> __device__ __forceinline__ void attn_group(AttnState& st, const bf16* __restrict__ Qb, const bf16* __restrict__ Kb, const bf16* __restrict__ Vb,
                                                            int b, int s, int h, int r, LAS unsigned char* wl, int lane_in) {
    int lane = lane_in;
    constexpr int D = 1 << (2 * G), E = 16 / D, NT = (G == 0) ? 20 : (G == 1) ? 8 : 5;
    constexpr int TOFF = (G == 0) ? TB_OFF0 : (G == 1) ? TB_OFF1 : TB_OFF2, TJMIN = (G == 0) ? TB_JMIN0 : (G == 1) ? TB_JMIN1 : TB_JMIN2;
    asm volatile("" : "+v"(lane));
    const int i = lane & 31, hi = lane >> 5;
    const int rg = r & (D - 1), cg = r >> (2 * G), P0 = (512 * s) >> (2 * G);
    const int p_i = P0 + E * i + cg, p_lo = P0 + cg - 128;
    const int pmax = (SEQ >> (2 * G)) - 1;
    const int col = (4 * G + h) * 64;
    const size_t rowb = (size_t)b * SEQ;
    bf16x8 qf[4];
    { const bf16* qp = Qb + (rowb + 512 * s + 16 * i + r) * AW + col + 32 * hi;
#pragma unroll
      for (int s4 = 0; s4 < 4; ++s4) qf[s4] = *(const bf16x8*)(qp + 8 * s4); }
    const LAS unsigned char* vb0 = wl + ((lane >> 4) & 1) * 32 + (lane & 3) * 8 + (4 * hi + ((lane & 15) >> 2)) * 64;
    const LAS float* tbg = (const LAS float*)(wl + ATT_TB_OFF) + TOFF - TJMIN - 27;
    constexpr float C2 = 0.125f * 1.4426950408889634f;
    const bf16x8 ones = {(short)0x3f80, (short)0x3f80, (short)0x3f80, (short)0x3f80, (short)0x3f80, (short)0x3f80, (short)0x3f80, (short)0x3f80};
    bf16x8 kf[4]; v4u vv[4];
#define ATT_LOAD_TILE(kt, kk, vw) do { \
        int p_ = p_lo + 32 * (kt) + i; p_ = p_ < 0 ? 0 : (p_ > pmax ? pmax : p_); \
        const bf16* kp_ = Kb + (rowb + (size_t)(D * p_ + rg)) * AW + col + 32 * hi; \
        _Pragma("unroll") for (int s4 = 0; s4 < 4; ++s4) kk[s4] = *(const bf16x8*)(kp_ + 8 * s4); \
        _Pragma("unroll") for (int kg = 0; kg < 2; ++kg) { int pv_ = p_lo + 32 * (kt) + 16 * kg + (lane >> 2); pv_ = pv_ < 0 ? 0 : (pv_ > pmax ? pmax : pv_); \
            const bf16* vp_ = Vb + (rowb + (size_t)(D * pv_ + rg)) * AW + col + 8 * (lane & 3); \
            vw[kg] = *(const v4u*)(vp_); vw[2 + kg] = *(const v4u*)(vp_ + 32); } } while (0)
    ATT_LOAD_TILE(0, kf, vv);
    for (int kt = 0; kt < NT; ++kt) {
        bf16x8 kn[4]; v4u vn[4];
        if (kt + 1 < NT) ATT_LOAD_TILE(kt + 1, kn, vn);
        f32x16 sa = {};
#pragma unroll
        for (int s4 = 0; s4 < 4; ++s4) sa = __builtin_amdgcn_mfma_f32_32x32x16_bf16(kf[s4], qf[s4], sa, 0, 0, 0);
#pragma unroll
        for (int pc = 0; pc < 4; ++pc) *(LAS v4u*)(wl + ((pc >> 1) * 2048 + (pc & 1) * 1024) + lane * 16) = vv[(pc >> 1) * 2 + (pc & 1)];
        const int J0 = E * i + 128 - 32 * kt - 4 * hi;
        const LAS float* tbp = tbg + J0;
        float mx = -INFINITY;
#pragma unroll
        for (int rho = 0; rho < 16; ++rho) {
            float v = sa[rho] * C2 + tbp[27 - ((rho & 3) + 8 * (rho >> 2))];
            if (PMASK) { const int j = J0 - ((rho & 3) + 8 * (rho >> 2)); v = (j > p_i) ? -INFINITY : v; }
            sa[rho] = v; mx = fmaxf(mx, v);
        }
        mx = fmaxf(mx, __shfl_xor(mx, 32));
        if (__any(mx > st.m + 6.0f)) {
            const float mn = fmaxf(st.m, mx), f = __builtin_amdgcn_exp2f(st.m - mn);
            st.m = mn;
            LAS float* wsf = (LAS float*)(wl + ATT_SC_OFF);
            if (hi == 0) wsf[i] = f;
            asm volatile("s_waitcnt lgkmcnt(0)" ::: "memory");
#pragma unroll
            for (int rho = 0; rho < 16; ++rho) { const float ff = wsf[crow(rho, hi)]; st.o0[rho] *= ff; st.o1[rho] *= ff; st.lacc[rho] *= ff; }
        }
#pragma unroll
        for (int rho = 0; rho < 16; ++rho) sa[rho] = __builtin_amdgcn_exp2f(sa[rho] - st.m);
        v4u pw0, pw1;
        pw0.x = cvtpk(sa[0], sa[1]); pw0.y = cvtpk(sa[2], sa[3]); pw0.z = cvtpk(sa[4], sa[5]); pw0.w = cvtpk(sa[6], sa[7]);
        pw1.x = cvtpk(sa[8], sa[9]); pw1.y = cvtpk(sa[10], sa[11]); pw1.z = cvtpk(sa[12], sa[13]); pw1.w = cvtpk(sa[14], sa[15]);
        asm volatile("s_waitcnt lgkmcnt(0)" ::: "memory");
        st.lacc = __builtin_amdgcn_mfma_f32_32x32x16_bf16(__builtin_bit_cast(bf16x8, pw0), ones, st.lacc, 0, 0, 0);
        st.lacc = __builtin_amdgcn_mfma_f32_32x32x16_bf16(__builtin_bit_cast(bf16x8, pw1), ones, st.lacc, 0, 0, 0);
#pragma unroll
        for (int dh = 0; dh < 2; ++dh) {
#pragma unroll
            for (int ks = 0; ks < 2; ++ks) {
                const s16x4 lo = vtr(vb0 + dh * 2048 + ks * 1024), hh = vtr(vb0 + dh * 2048 + ks * 1024 + 512);
                const bf16x8 vf = {lo[0], lo[1], lo[2], lo[3], hh[0], hh[1], hh[2], hh[3]};
                const bf16x8 pf = __builtin_bit_cast(bf16x8, ks == 0 ? pw0 : pw1);
                if (dh == 0) st.o0 = __builtin_amdgcn_mfma_f32_32x32x16_bf16(pf, vf, st.o0, 0, 0, 0);
                else         st.o1 = __builtin_amdgcn_mfma_f32_32x32x16_bf16(pf, vf, st.o1, 0, 0, 0);
            }
        }
        asm volatile("" ::: "memory");
        if (kt + 1 < NT) {
#pragma unroll
            for (int q = 0; q < 4; ++q) { kf[q] = kn[q]; vv[q] = vn[q]; }
        }
    }
#undef ATT_LOAD_TILE
}

__device__ __forceinline__ void attn_prompt_unit(int unit, const bf16* Qb, const bf16* Kb, const bf16* Vb, bf16* AA, LAS unsigned char* wl, int lane) {
    const int r = unit & 15, h = (unit >> 4) & 3, s = (unit >> 6) & 7, b = unit >> 9;
    AttnState st; st.o0 = f32x16{}; st.o1 = f32x16{}; st.lacc = f32x16{}; st.m = -30000.0f;
    if (s < 4) attn_group<2, true>(st, Qb, Kb, Vb, b, s, h, r, wl, lane); else attn_group<2, false>(st, Qb, Kb, Vb, b, s, h, r, wl, lane);
    if (s == 0) { attn_group<1, true>(st, Qb, Kb, Vb, b, s, h, r, wl, lane); attn_group<0, true>(st, Qb, Kb, Vb, b, s, h, r, wl, lane); }
    else        { attn_group<1, false>(st, Qb, Kb, Vb, b, s, h, r, wl, lane); attn_group<0, false>(st, Qb, Kb, Vb, b, s, h, r, wl, lane); }
    const int i = lane & 31, hi = lane >> 5;
#pragma unroll
    for (int rho = 0; rho < 16; ++rho) {
        const int qi = crow(rho, hi); const float ff = __builtin_amdgcn_rcpf(st.lacc[rho]);
        bf16* op = AA + ((size_t)b * SEQ + 512 * s + 16 * qi + r) * AOW + h * 64 + i;
        op[0] = (bf16)f2bf(st.o0[rho] * ff); op[32] = (bf16)f2bf(st.o1[rho] * ff);
    }
}

__device__ __forceinline__ float red16(float x) {
    x += __int_as_float(__builtin_amdgcn_update_dpp(0, __float_as_int(x), 0xB1, 0xf, 0xf, true));
    x += __int_as_float(__builtin_amdgcn_update_dpp(0, __float_as_int(x), 0x4E, 0xf, 0xf, true));
    x += __int_as_float(__builtin_amdgcn_update_dpp(0, __float_as_int(x), 0x141, 0xf, 0xf, true));
    x += __int_as_float(__builtin_amdgcn_update_dpp(0, __float_as_int(x), 0x140, 0xf, 0xf, true));
    return x;
}
struct SampleState { float m, l; f32x4 o; };
template <int G> __device__ __forceinline__ void attn_sample_group(SampleState& st, const float* cache, const float* outw, const LAS float* qs, const float* biasg, int b, int h, int t, int lane) {
    constexpr int D = 1 << (2 * G), WIN = 128 << (2 * G);
    const int kq = lane >> 4, d4 = (lane & 15) * 4;
    const f32x4 qv = *(const LAS f32x4*)(qs + G * 64 + d4);
    const unsigned long long cb = (unsigned long long)(cache + ((size_t)b * WIN * 512 + h * 64 + d4));
    const unsigned long long ob = (unsigned long long)(outw + ((size_t)b * WIN * 512 + h * 64 + d4)) - 8ull * 2048ull;
#pragma unroll 1
    for (int bt = 0; bt < 3; ++bt) {
        f32x4 kv[11], vv[11];
#pragma unroll
        for (int q = 0; q < 11; ++q) { int j = 44 * bt + 4 * q + kq; j = j > 128 ? 128 : j; const int idx = WIN + t - D * j;
            const unsigned long long a = ((idx >= WIN) ? ob : cb) + (unsigned long long)idx * 2048ull;
            kv[q] = *(const f32x4*)a; vv[q] = *(const f32x4*)(a + 1024ull); }
        float sv[11]; float bm = -INFINITY;
#pragma unroll
        for (int q = 0; q < 11; ++q) { const int j0 = 44 * bt + 4 * q + kq; const int j = j0 > 128 ? 128 : j0;
            float dt = (kv[q][0] * qv[0] + kv[q][1] * qv[1]) + (kv[q][2] * qv[2] + kv[q][3] * qv[3]);
            dt = red16(dt) + biasg[j];
            sv[q] = (j0 <= 128) ? dt : -INFINITY; bm = fmaxf(bm, sv[q]); }
        bm = fmaxf(bm, __shfl_xor(bm, 16)); bm = fmaxf(bm, __shfl_xor(bm, 32));
        const float mn = fmaxf(st.m, bm), f = __builtin_amdgcn_exp2f(st.m - mn);
        st.m = mn; st.l *= f; st.o = st.o * f;
#pragma unroll
        for (int q = 0; q < 11; ++q) { const float p = __builtin_amdgcn_exp2f(sv[q] - st.m); st.l += p; st.o += vv[q] * p; }
    }
}
__device__ __forceinline__ void attn_sample_unit(int su, const Ptrs& P, const bf16* Qb, bf16* AA, const float* biasG, LAS unsigned char* wl, int lane) {
    const int t = su & 7, h = (su >> 3) & 3, b = su >> 5;
    LAS float* qs = (LAS float*)(wl + ATT_SC_OFF);
    const size_t qrow = (size_t)(MP + b * 8 + t) * AW;
#pragma unroll
    for (int g = 0; g < 3; ++g) qs[g * 64 + lane] = __uint_as_float((unsigned)Qb[qrow + (4 * g + h) * 64 + lane] << 16) * (0.125f * 1.4426950408889634f);
    asm volatile("s_waitcnt lgkmcnt(0)" ::: "memory");
    SampleState st; st.m = -30000.0f; st.l = 0.f; st.o = (f32x4){0.f, 0.f, 0.f, 0.f};
    attn_sample_group<2>(st, P.c2048, P.out + O_KV2048S, qs, biasG + (8 + h) * 132, b, h, t, lane);
    attn_sample_group<1>(st, P.c512, P.out + O_KV512S, qs, biasG + (4 + h) * 132, b, h, t, lane);
    attn_sample_group<0>(st, P.c128, P.out + O_KV128S, qs, biasG + (0 + h) * 132, b, h, t, lane);
    float l = st.l; f32x4 o = st.o;
    l += __shfl_xor(l, 16); l += __shfl_xor(l, 32);
#pragma unroll
    for (int e = 0; e < 4; ++e) { o[e] += __shfl_xor(o[e], 16); o[e] += __shfl_xor(o[e], 32); }
    const int d4 = (lane & 15) * 4;
    if (lane < 16) { const float inv = 1.0f / l;
        *(GAS unsigned long long*)(AA + (size_t)(MP + b * 8 + t) * AOW + h * 64 + d4) = (unsigned long long)pk2(o[0] * inv, o[1] * inv) | ((unsigned long long)pk2(o[2] * inv, o[3] * inv) << 32); }
    asm volatile("s_waitcnt lgkmcnt(0)" ::: "memory");
}

struct CopyLoc { const f32x4* s; f32x4* d; };
constexpr int CC_B2 = 510, CC_B1 = 126, CC_B0 = 30, CC_N2 = 32 * CC_B2, CC_N1 = 32 * CC_B1, CC_N0 = 32 * CC_B0, CC_N = CC_N2 + CC_N1 + CC_N0;
__device__ __forceinline__ CopyLoc copy_locate(const Ptrs& P, int id) {
    CopyLoc L;
    if (id < CC_N2) { const int b = id / CC_B2, k = id - b * CC_B2; L.s = (const f32x4*)(P.c2048 + ((size_t)b * 2048 + 8) * 512) + k * 512; L.d = (f32x4*)(P.out + O_KV2048S + (size_t)b * 2048 * 512) + k * 512; return L; }
    id -= CC_N2;
    if (id < CC_N1) { const int b = id / CC_B1, k = id - b * CC_B1; L.s = (const f32x4*)(P.c512 + ((size_t)b * 512 + 8) * 512) + k * 512; L.d = (f32x4*)(P.out + O_KV512S + (size_t)b * 512 * 512) + k * 512; return L; }
    id -= CC_N1;
    { const int b = id / CC_B0, k = id - b * CC_B0; L.s = (const f32x4*)(P.c128 + ((size_t)b * 128 + 8) * 512) + k * 512; L.d = (f32x4*)(P.out + O_KV128S + (size_t)b * 128 * 512) + k * 512; return L; }
}
__device__ __forceinline__ void copy_chunks(const Ptrs& P, int mw, int NMW, int lane) {
    f32x4 va[8], vb[8];
    int id = mw;
    if (id < CC_N) { const CopyLoc L = copy_locate(P, id);
#pragma unroll
        for (int q = 0; q < 8; ++q) va[q] = __builtin_nontemporal_load(L.s + q * 64 + lane); }
    for (; id < CC_N; id += 2 * NMW) {
        const int id2 = id + NMW, id3 = id + 2 * NMW;
        if (id2 < CC_N) { const CopyLoc L = copy_locate(P, id2);
#pragma unroll
            for (int q = 0; q < 8; ++q) vb[q] = __builtin_nontemporal_load(L.s + q * 64 + lane); }
        { const CopyLoc L = copy_locate(P, id);
#pragma unroll
            for (int q = 0; q < 8; ++q) __builtin_nontemporal_store(va[q], L.d + q * 64 + lane); }
        if (id3 < CC_N) { const CopyLoc L = copy_locate(P, id3);
#pragma unroll
            for (int q = 0; q < 8; ++q) va[q] = __builtin_nontemporal_load(L.s + q * 64 + lane); }
        if (id2 < CC_N) { const CopyLoc L = copy_locate(P, id2);
#pragma unroll
            for (int q = 0; q < 8; ++q) __builtin_nontemporal_store(vb[q], L.d + q * 64 + lane); }
    }
}

template <int W> __device__ __forceinline__ void pool_block(const float* __restrict__ U, bf16* __restrict__ DD, int rb, int gi, int lane) {
    const int r0 = 16 * rb + 8 * (lane >> 5), c4 = gi * 128 + (lane & 31) * 4, t0 = r0 & (SEQ - 1);
    f32x4 v[W + 7];
#pragma unroll
    for (int i = 0; i < W + 7; ++i) { const int dt = i - (W - 1); const int ri = (t0 + dt >= 0) ? r0 + dt : r0; v[i] = *(const f32x4*)(U + (size_t)ri * PW + c4); }
#pragma unroll
    for (int i = 0; i < W - 1; ++i) { if (t0 + i - (W - 1) < 0) v[i] = (f32x4){0.f, 0.f, 0.f, 0.f}; }
    f32x4 s = v[0];
#pragma unroll
    for (int i = 1; i < W; ++i) s += v[i];
#pragma unroll
    for (int o = 0; o < 8; ++o) {
        if (o > 0) s += v[W - 1 + o] - v[o - 1];
        const int t = t0 + o; const float inv = 1.0f / (float)((t + 1 < W) ? t + 1 : W); const f32x4 dd = s * inv - v[W - 1 + o];
        *(GAS unsigned long long*)(DD + (size_t)(r0 + o) * PW + c4) = (unsigned long long)pk2(dd[0], dd[1]) | ((unsigned long long)pk2(dd[2], dd[3]) << 32);
    }
}
__device__ __forceinline__ void pool_items(const Ptrs& P, const float* U, bf16* DD, int mw, int NMW, int lane) {
    for (int it = mw; it < (MP / 16) * 4; it += NMW) {
        const int gi = it & 3, rb = it >> 2;
        if (gi == 0) pool_block<2>(U, DD, rb, 0, lane); else if (gi == 1) pool_block<4>(U, DD, rb, 1, lane); else if (gi == 2) pool_block<8>(U, DD, rb, 2, lane); else pool_block<16>(U, DD, rb, 3, lane);
    }
    for (int it = mw * 64 + lane; it < MS * 128; it += NMW * 64) {
        const int sidx = it >> 7, row = MP + sidx, c4 = (it & 127) * 4, w = 2 << (c4 >> 7), b = sidx >> 3, t = sidx & 7;
        f32x4 s = {0.f, 0.f, 0.f, 0.f};
        const f32x4 own = *(const f32x4*)(U + (size_t)row * PW + c4);
        for (int i = 0; i < w; ++i) { const int idx = 15 + t - i;
            s += (idx >= 15) ? *(const f32x4*)(U + (size_t)(MP + b * 8 + idx - 15) * PW + c4) : *(const f32x4*)(P.spool + ((size_t)b * 15 + idx) * PW + c4); }
        const float inv = 1.0f / (float)w; const f32x4 dd = s * inv - own;
        *(GAS unsigned long long*)(DD + (size_t)row * PW + c4) = (unsigned long long)pk2(dd[0], dd[1]) | ((unsigned long long)pk2(dd[2], dd[3]) << 32);
    }
}

__device__ __forceinline__ void micro_partial(const pg8::bf16_t* A, int lda, const pg8::bf16_t* Bt, int K, int row0, int col0, int wave, int lane, f32x4 (&acc)[4]) {
    const int fr = lane & 15, fq = lane >> 4, ks = K >> 3;
    const pg8::bf16_t* ap = A + (size_t)(row0 + fr) * lda + wave * ks + 8 * fq;
    const pg8::bf16_t* bp = Bt + (size_t)(col0 + fr) * K + wave * ks + 8 * fq;
    for (int k = 0; k < ks; k += 32) {
        const bf16x8 af = *(const bf16x8*)(ap + k);
#pragma unroll
        for (int nb = 0; nb < 4; ++nb) { const bf16x8 bf = *(const bf16x8*)(bp + (size_t)(16 * nb) * K + k); acc[nb] = __builtin_amdgcn_mfma_f32_16x16x32_bf16(bf, af, acc[nb], 0, 0, 0); }
    }
}
typedef float f32x2 __attribute__((ext_vector_type(2)));
__device__ __forceinline__ f32x2 micro_reduce(LAS unsigned char* red, const f32x4 (&acc)[4], int wave, int lane, int tid) {
    const int fr = lane & 15, fq = lane >> 4;
    LAS float* pw = (LAS float*)red + wave * 1024 + fr * 64 + 4 * fq;
#pragma unroll
    for (int nb = 0; nb < 4; ++nb) *(LAS f32x4*)(pw + 16 * nb) = acc[nb];
    __syncthreads();
    const LAS float* pr = (const LAS float*)red + (tid >> 5) * 64 + 2 * (tid & 31);
    f32x2 s = {0.f, 0.f};
#pragma unroll
    for (int w = 0; w < 8; ++w) s += *(const LAS f32x2*)(pr + w * 1024);
    __syncthreads();
    return s;
}
template <int MODE> __device__ __forceinline__ void micro_resid(LAS unsigned char* red, int blk, const pg8::bf16_t* A, const pg8::bf16_t* Bt, int K,
                                                               const float* xs, float* X1, pg8::bf16_t* XB, float* ssp, float* out) {
    int tid_ = threadIdx.x; asm volatile("" : "+v"(tid_));
    const int tid = tid_, lane = tid & 63, wave = __builtin_amdgcn_readfirstlane(tid >> 6);
    const int row0 = MP + 16 * (blk >> 4), col0 = 64 * (blk & 15);
    f32x4 acc[4] = {};
    micro_partial(A, K, Bt, K, row0, col0, wave, lane, acc);
    const f32x2 s = micro_reduce(red, acc, wave, lane, tid);
    const int row = row0 + (tid >> 5), col = col0 + 2 * (tid & 31);
    const float alpha = (MODE == 1) ? 1.0f : 0.5f;
    const float* bp = (MODE == 0) ? xs + (size_t)(row - MP) * DM + col : X1 + (size_t)row * DM + col;
    const f32x2 v = *(const f32x2*)bp + s * alpha;
    if (MODE == 2) { *(f32x2*)(out + (size_t)row * DM + col) = v; }
    else {
        *(f32x2*)(X1 + (size_t)row * DM + col) = v;
        *(unsigned*)(XB + (size_t)row * DM + col) = pk2(v[0], v[1]);
        float ss = v[0] * v[0] + v[1] * v[1];
#pragma unroll
        for (int o = 1; o < 32; o <<= 1) ss += __shfl_xor(ss, o);
        if ((tid & 31) == 0) ssp[(size_t)row * 16 + (blk & 15)] = ss;
    }
}
__device__ __forceinline__ void micro_merge(LAS unsigned char* red, int blk, const pg8::bf16_t* AA, const pg8::bf16_t* WAB, const pg8::bf16_t* DD, const pg8::bf16_t* WEFF,
                                            const pg8::bf16_t* GA, const pg8::bf16_t* GB, pg8::bf16_t* MG) {
    int tid_ = threadIdx.x; asm volatile("" : "+v"(tid_));
    const int tid = tid_, lane = tid & 63, wave = __builtin_amdgcn_readfirstlane(tid >> 6);
    const int row0 = MP + 16 * (blk >> 4), col0 = 64 * (blk & 15);
    f32x4 acc[4] = {};
    micro_partial(AA, AOW, WAB, AOW, row0, col0, wave, lane, acc);
    const f32x2 s1 = micro_reduce(red, acc, wave, lane, tid);
#pragma unroll
    for (int nb = 0; nb < 4; ++nb) acc[nb] = (f32x4){0.f, 0.f, 0.f, 0.f};
    micro_partial(DD, PW, WEFF, PW, row0, col0, wave, lane, acc);
    const f32x2 s2 = micro_reduce(red, acc, wave, lane, tid);
    const int row = row0 + (tid >> 5), col = col0 + 2 * (tid & 31);
    const unsigned ga = *(const unsigned*)(GA + (size_t)row * DM + col), gb = *(const unsigned*)(GB + (size_t)row * DM + col);
    const float m0 = __uint_as_float(ga << 16) * s1[0] + __uint_as_float(gb << 16) * s2[0];
    const float m1 = __uint_as_float(ga & 0xffff0000u) * s1[1] + __uint_as_float(gb & 0xffff0000u) * s2[1];
    *(unsigned*)(MG + (size_t)row * DM + col) = pk2(m0, m1);
}

#ifndef PROBE_AMP
#define PROBE_AMP -1
#endif
struct Args { Ptrs p; };
__global__ void __launch_bounds__(NWAVES * 64, 2) hybrid_fwd(Args args) {
    extern __shared__ __attribute__((aligned(16))) unsigned char lds[];
    Frame F;
    F.lds = (LAS unsigned char*)lds;
    F.MISC = (volatile LAS unsigned*)(F.lds + MISC_OFF);
    F.tid = threadIdx.x; F.lane = F.tid & 63; F.wave = __builtin_amdgcn_readfirstlane(F.tid >> 6);
    F.G = gridDim.x; { const int bx = blockIdx.x; F.vcu = (F.G % 8 == 0) ? (bx % 8) * (F.G / 8) + bx / 8 : bx; }
    const Ptrs& P = args.p;
    unsigned char* ws = P.ws;
    F.ctl = (gu32*)(ws + WS_CTL);
    for (int u = F.tid; u < (LDS_BYTES - LDSCTL_OFF) / 4; u += NWAVES * 64) ((LAS unsigned*)(F.lds + LDSCTL_OFF))[u] = 0u;
    __syncthreads();
    XcdBarrier bar = xcd_barrier_post((unsigned*)(F.ctl + CW_BAR), F.MISC + 8);
#define GRID_BAR() xcd_barrier(bar)
    unsigned long long tph_ = 0;
#define PH_BEGIN() do { if (PROBE_AMP >= 0) tph_ = __builtin_amdgcn_s_memrealtime(); } while (0)
#define PH_END(k) do { if (PROBE_AMP >= 0) { const unsigned long long tn_ = __builtin_amdgcn_s_memrealtime(); if (PROBE_AMP == (k)) { while (__builtin_amdgcn_s_memrealtime() < tn_ + 2 * (tn_ - tph_)) __builtin_amdgcn_s_sleep(8); } tph_ = __builtin_amdgcn_s_memrealtime(); } } while (0)
#define WSP(T, off) ((T*)(ws + (off)))
    typedef pg8::bf16_t b16;
    const int c = (int)blockIdx.x;

    PH_BEGIN();
    p0_prologue(F, P);
    GRID_BAR();
    PH_END(0);
    {   pg8::Gemm g{WSP(b16, WS_XB), WSP(b16, WS_WUP1), M, FF2, DM}; pg8::StaticOrder S; S.init(M, FF2, F.G, c);
        pg8::EpiSwiglu<false> E{WSP(b16, WS_R), WSP(float, WS_RSTD0)};
        pg8::gemm_phase<pg8::EpiSwiglu<false>, pg8::StaticOrder, true, true>(F.lds + RING_OFF, g, S, E);
        {   const int nwg = (M / 256) * (FF2 / 256), R = (nwg + F.G - 1) / F.G, nfull = nwg - (R - 1) * F.G, nh = F.G - nfull;
            int th_ = threadIdx.x; asm volatile("" : "+v"(th_)); const int laneh = th_ & 63, waveh = __builtin_amdgcn_readfirstlane(th_ >> 6);
            LAS float* scr = (LAS float*)(F.lds + RING_OFF + waveh * 16384);
            if (nh == 0) convert_items(P, WI_WDN1, WI_WAB, c * NWAVES + waveh, F.G * NWAVES, scr, laneh);
            else if (c >= nfull) convert_items(P, WI_WDN1, WI_WAB, (c - nfull) * NWAVES + waveh, nh * NWAVES, scr, laneh); } }
    GRID_BAR();
    PH_END(1);
    {   pg8::Gemm g{WSP(b16, WS_R), WSP(b16, WS_WDN1), MP, DM, FF}; pg8::StaticOrder S; S.init(MP, DM, F.G, c);
        pg8::EpiResid<0> E{P.xp, P.xs, WSP(float, WS_X1), WSP(b16, WS_XB), WSP(float, WS_SSP1), nullptr};
        pg8::gemm_phase<pg8::EpiResid<0>, pg8::StaticOrder, true, true>(F.lds + RING_OFF, g, S, E);
        for (int blk = c; blk < 256; blk += F.G) micro_resid<0>(F.lds + RING_OFF, blk, WSP(b16, WS_R), WSP(b16, WS_WDN1), FF, P.xs, WSP(float, WS_X1), WSP(b16, WS_XB), WSP(float, WS_SSP1), nullptr); }
    GRID_BAR();
    PH_END(2);
    {   pg8::Gemm g{WSP(b16, WS_XB), WSP(b16, WS_WIN), M, INW, DM}; pg8::StaticOrder S; S.init(M, INW, F.G, c);
        pg8::EpiIn E{WSP(float, WS_SSP1), WSP(b16, WS_Q), WSP(b16, WS_K), WSP(b16, WS_V), WSP(float, WS_U), WSP(b16, WS_GA), WSP(b16, WS_GB), P.qn, P.kn, P.out};
        pg8::gemm_phase<pg8::EpiIn, pg8::StaticOrder, true, true>(F.lds + RING_OFF, g, S, E); }
    GRID_BAR();
    PH_END(3);
    {   int tid_ = threadIdx.x; asm volatile("" : "+v"(tid_));
        const int lane = tid_ & 63, wave = __builtin_amdgcn_readfirstlane(tid_ >> 6);
        const unsigned long long tq0_ = (PROBE_AMP >= 40) ? __builtin_amdgcn_s_memrealtime() : 0ull;
#define SUBAMP(k) do { if (PROBE_AMP == (k)) { const unsigned long long tq1_ = __builtin_amdgcn_s_memrealtime(); while (__builtin_amdgcn_s_memrealtime() < tq1_ + 2 * (tq1_ - tq0_)) __builtin_amdgcn_s_sleep(8); } } while (0)
        if (wave < 4) {
            const int cw = F.vcu * 4 + wave, NCW = F.G * 4;
            LAS unsigned char* wl = F.lds + RING_OFF + wave * ATT_WLDS;
            const bf16* Qb = WSP(const bf16, WS_Q); const bf16* Kb = WSP(const bf16, WS_K); const bf16* Vb = WSP(const bf16, WS_V); bf16* AA = WSP(bf16, WS_AA);
            const float* BIAS = WSP(const float, WS_BIAS);
            for (int su = cw; su < DBATCH * 4 * DSEQ; su += NCW) attn_sample_unit(su, P, Qb, AA, BIAS, wl, lane);
            SUBAMP(42);
            for (int up = cw; up < NBATCH * 8 * 4 * 8; up += NCW) {
                const int unit0 = ((up >> 3) << 4) + (up & 7);
                attn_build_tables(BIAS, (unit0 >> 4) & 3, (LAS float*)(wl + ATT_TB_OFF), lane);
#pragma unroll 1
                for (int k2 = 0; k2 < 2; ++k2) attn_prompt_unit(unit0 + 8 * k2, Qb, Kb, Vb, AA, wl, lane);
            }
            SUBAMP(40);
        } else {
            const int mw = F.vcu * 4 + (wave - 4), NMW = F.G * 4;
            copy_chunks(P, mw, NMW, lane);
            SUBAMP(43);
            pool_items(P, WSP(const float, WS_U), WSP(bf16, WS_DD), mw, NMW, lane);
            convert_items(P, WI_WAB, WI_END, mw, NMW, (LAS float*)(F.lds + RING_OFF + wave * 16384), lane);
            SUBAMP(41);
        }
    }
    GRID_BAR();
    PH_END(4);
    {   pg8::StaticOrder S; S.init(MP, DM, F.G, c);
        {   pg8::Gemm g{WSP(b16, WS_AA), WSP(b16, WS_WAB), MP, DM, AOW}; pg8::EpiMerge<0> E{WSP(b16, WS_GA), WSP(b16, WS_T), WSP(b16, WS_MG)};
            pg8::gemm_phase<pg8::EpiMerge<0>, pg8::StaticOrder, true, true>(F.lds + RING_OFF, g, S, E); }
        {   pg8::Gemm g{WSP(b16, WS_DD), WSP(b16, WS_WEFF), MP, DM, PW}; pg8::EpiMerge<1> E{WSP(b16, WS_GB), WSP(b16, WS_T), WSP(b16, WS_MG)};
            pg8::gemm_phase<pg8::EpiMerge<1>, pg8::StaticOrder, true, true>(F.lds + RING_OFF, g, S, E); }
        for (int blk = c; blk < 256; blk += F.G) micro_merge(F.lds + RING_OFF, blk, WSP(b16, WS_AA), WSP(b16, WS_WAB), WSP(b16, WS_DD), WSP(b16, WS_WEFF), WSP(b16, WS_GA), WSP(b16, WS_GB), WSP(b16, WS_MG));
    }
    GRID_BAR();
    PH_END(5);
    {   pg8::Gemm g{WSP(b16, WS_MG), WSP(b16, WS_WOUT), MP, DM, DM}; pg8::StaticOrder S; S.init(MP, DM, F.G, c);
        pg8::EpiResid<1> E{nullptr, nullptr, WSP(float, WS_X1), WSP(b16, WS_XB), WSP(float, WS_SSP2), nullptr};
        pg8::gemm_phase<pg8::EpiResid<1>, pg8::StaticOrder, true, true>(F.lds + RING_OFF, g, S, E);
        for (int blk = c; blk < 256; blk += F.G) micro_resid<1>(F.lds + RING_OFF, blk, WSP(b16, WS_MG), WSP(b16, WS_WOUT), DM, nullptr, WSP(float, WS_X1), WSP(b16, WS_XB), WSP(float, WS_SSP2), nullptr); }
    GRID_BAR();
    PH_END(6);
    {   pg8::Gemm g{WSP(b16, WS_XB), WSP(b16, WS_WUP2), M, FF2, DM}; pg8::StaticOrder S; S.init(M, FF2, F.G, c);
        pg8::EpiSwiglu<true> E{WSP(b16, WS_R), WSP(float, WS_SSP2)};
        pg8::gemm_phase<pg8::EpiSwiglu<true>, pg8::StaticOrder, true, true>(F.lds + RING_OFF, g, S, E); }
    GRID_BAR();
    PH_END(7);
    {   pg8::Gemm g{WSP(b16, WS_R), WSP(b16, WS_WDN2), MP, DM, FF}; pg8::StaticOrder S; S.init(MP, DM, F.G, c);
        pg8::EpiResid<2> E{nullptr, nullptr, WSP(float, WS_X1), nullptr, nullptr, P.out};
        pg8::gemm_phase<pg8::EpiResid<2>, pg8::StaticOrder, true, true>(F.lds + RING_OFF, g, S, E);
        for (int blk = c; blk < 256; blk += F.G) micro_resid<2>(F.lds + RING_OFF, blk, WSP(b16, WS_R), WSP(b16, WS_WDN2), FF, nullptr, WSP(float, WS_X1), nullptr, nullptr, P.out); }
    PH_END(8);
}

extern "C" void kernel_launch(void* const* d_in, const int* in_sizes, int n_in, void* d_out, int out_size, void* d_ws, size_t ws_size, hipStream_t stream) {
    static int grid = 0;
    if (grid == 0) {
        if (n_in != 22 || (size_t)out_size != O_END || ws_size < WS_END) { fprintf(stderr, "kernel_launch: unexpected shapes (n_in %d, out %d, ws %zu); nothing launched\n", n_in, out_size, ws_size); grid = -1; return; }
        int dev = 0, cus = 0;
        if (hipGetDevice(&dev) != hipSuccess || hipDeviceGetAttribute(&cus, hipDeviceAttributeMultiprocessorCount, dev) != hipSuccess) { grid = -1; return; }
        if (hipFuncSetAttribute((const void*)hybrid_fwd, hipFuncAttributeMaxDynamicSharedMemorySize, LDS_BYTES) != hipSuccess) { fprintf(stderr, "kernel_launch: hipFuncSetAttribute failed\n"); grid = -1; return; }
        (void)hipGetLastError();
        grid = cus;
    }
    if (grid < 0) return;
    if (hipMemsetAsync((char*)d_ws + WS_CTL, 0, CTL_ZERO_BYTES, stream) != hipSuccess) return;
    Args a{};
    const float** pp = (const float**)&a.p;
    for (int i = 0; i < 22; ++i) pp[i] = (const float*)d_in[i];
    a.p.out = (float*)d_out; a.p.ws = (unsigned char*)d_ws;
    hipLaunchKernelGGL(hybrid_fwd, dim3(grid), dim3(NWAVES * 64), LDS_BYTES, stream, a);
}
```

```cpp
#include <hip/hip_runtime.h>
#include <cstdio>
#include <cstdint>

namespace pg8 {
#define PG8_LAS __attribute__((address_space(3)))
typedef unsigned short bf16_t;
typedef short bf16x8 __attribute__((ext_vector_type(8)));
typedef float f32x4 __attribute__((ext_vector_type(4)));
typedef unsigned u32x4 __attribute__((ext_vector_type(4)));
constexpr int BM = 256, BK = 64, HALF = 128, HTB = HALF * BK * 2  , STAGE_BYTES = 8 * HTB, NXCD = 8, WGM = 8;

__host__ __device__ __forceinline__ int lds_byte(int r, int c) { const int st = (r >> 4) * 2 + (c >> 5), rr = r & 15, cc = c & 31, ob = rr * 64 + cc * 2; return st * 1024 + (ob ^ (((ob >> 9) & 1) << 5)); }
__host__ __device__ __forceinline__ void stage_rc(int b, int& R, int& C) { const int st = b / 1024, sb = b % 1024, swz = sb ^ (((sb >> 9) & 1) << 5); R = (st >> 1) * 16 + swz / 64; C = (st & 1) * 32 + (swz % 64) / 2; }
__host__ __device__ __forceinline__ int perm32(int rho) { const int n = rho >> 4, i = rho & 15; return 8 * (i >> 2) + 4 * n + (i & 3); }

struct Unit { int pm, pn; };
struct Gemm { const bf16_t* A; const bf16_t* Bt; int M, N, K; };

struct StaticOrder {
    int nM, nN, nwg, G, c;
    __host__ __device__ void init(int M, int N, int G_, int c_) { nM = M / BM; nN = N / BM; nwg = nM * nN; G = G_; c = c_; }
    __host__ __device__ bool next(int i, Unit& u) const {
        const long L = (long)i * G + c; if (L >= nwg) return false;
        int wgid = (int)L; { const int q = nwg / NXCD, r = nwg % NXCD, xcd = wgid % NXCD, off = wgid / NXCD; wgid = (xcd < r ? xcd * (q + 1) : r * (q + 1) + (xcd - r) * q) + off; }
        const int nig = WGM * nN, gid = wgid / nig, fm = gid * WGM, gsz = (nM - fm) < WGM ? (nM - fm) : WGM;
        u.pm = fm + ((wgid % nig) % gsz); u.pn = (wgid % nig) / gsz; return true;
    }
    __device__ __forceinline__ void a_ready(const Unit&) const {}
    __device__ __forceinline__ void done(const Unit&) const {}
};


typedef float f32x2 __attribute__((ext_vector_type(2)));
typedef __bf16 bf16x2_t __attribute__((ext_vector_type(2)));
__device__ __forceinline__ unsigned cvt_pk_bf16(float lo, float hi) { f32x2 v = {lo, hi}; bf16x2_t b = __builtin_convertvector(v, bf16x2_t); return __builtin_bit_cast(unsigned, b); }
__device__ __forceinline__ u32x4 pack8(const f32x4 a, const f32x4 b) { u32x4 w; w.x = cvt_pk_bf16(a[0], a[1]); w.y = cvt_pk_bf16(a[2], a[3]); w.z = cvt_pk_bf16(b[0], b[1]); w.w = cvt_pk_bf16(b[2], b[3]); return w; }
__device__ __forceinline__ float bf2f(unsigned short h) { return __uint_as_float((unsigned)h << 16); }
constexpr float RMS_EPS = 1e-6f;
constexpr float LOG2E = 1.4426950408889634f;
__device__ __forceinline__ float rstd_from_partials(const float* ssp, int row) {
    const f32x4* p = (const f32x4*)(ssp + (size_t)row * 16);
    const f32x4 a = p[0], b = p[1], c = p[2], d = p[3];
    const float s = (((a[0] + a[1]) + (a[2] + a[3])) + ((b[0] + b[1]) + (b[2] + b[3]))) + (((c[0] + c[1]) + (c[2] + c[3])) + ((d[0] + d[1]) + (d[2] + d[3])));
    return __builtin_amdgcn_rsqf(s * (1.0f / 1024.0f) + RMS_EPS);
}
__device__ __forceinline__ void rstd8_from_partials(const float* ssp, int row0, int fq, float (&rs)[8]) {
    f32x4 q[8];
#pragma unroll
    for (int i = 0; i < 8; ++i) q[i] = *(const f32x4*)(ssp + (size_t)(row0 + (i >> 2) * HALF + (i & 3) * 16) * 16 + 4 * fq);
#pragma unroll
    for (int i = 0; i < 8; ++i) { float s = (q[i][0] + q[i][1]) + (q[i][2] + q[i][3]); s += __shfl_xor(s, 16); s += __shfl_xor(s, 32); rs[i] = __builtin_amdgcn_rsqf(s * (1.0f / 1024.0f) + RMS_EPS); }
    asm volatile("" ::: "memory");
}
__device__ __forceinline__ float sigmoidf_fast(float x) { return __builtin_amdgcn_rcpf(1.0f + __builtin_amdgcn_exp2f(-x * LOG2E)); }

template <bool PARTIAL> struct EpiSwiglu {
    static constexpr bool PERM = true, AFTER_DRAIN = false;
    bf16_t* H; const float* rs;
    __device__ __forceinline__ void operator()(const f32x4 (&acc)[2][2][4][2], const Unit& u, int wr, int wc, int fr, int fq) const {
        const int row0 = u.pm * BM + wr * 64 + fr, col0 = u.pn * 128 + wc * 32 + 8 * fq;
        float rsv[8];
        if (PARTIAL) rstd8_from_partials(rs, row0, fq, rsv);
        else {
#pragma unroll
            for (int i = 0; i < 8; ++i) rsv[i] = rs[row0 + (i >> 2) * HALF + (i & 3) * 16]; }
#pragma unroll
        for (int ai = 0; ai < 2; ++ai)
#pragma unroll
            for (int m = 0; m < 4; ++m) {
                const int row = row0 + ai * HALF + m * 16;
                const float r = rsv[ai * 4 + m];
                f32x4 o[2];
#pragma unroll
                for (int n = 0; n < 2; ++n) {
                    const f32x4 g = acc[ai][0][m][n] * r, up = acc[ai][1][m][n] * r;
#pragma unroll
                    for (int e = 0; e < 4; ++e) o[n][e] = g[e] * sigmoidf_fast(g[e]) * up[e];
                }
                *(u32x4*)(H + (size_t)row * 2816 + col0) = pack8(o[0], o[1]);
            }
    }
};

__device__ __forceinline__ void unpack8(const u32x4 w, f32x4& a, f32x4& b) {
    a[0] = __uint_as_float(w.x << 16); a[1] = __uint_as_float(w.x & 0xffff0000u); a[2] = __uint_as_float(w.y << 16); a[3] = __uint_as_float(w.y & 0xffff0000u);
    b[0] = __uint_as_float(w.z << 16); b[1] = __uint_as_float(w.z & 0xffff0000u); b[2] = __uint_as_float(w.w << 16); b[3] = __uint_as_float(w.w & 0xffff0000u);
}
template <int MODE> struct EpiResid {
    static constexpr bool PERM = true, AFTER_DRAIN = false;
    bf16_t* XB; float* ssp; float* out;
    __device__ __forceinline__ void operator()(const f32x4 (&acc)[2][2][4][2], const Unit& u, int wr, int wc, int fr, int fq) const {
        const int row0 = u.pm * BM + wr * 64 + fr, col0 = u.pn * BM + wc * 32 + 8 * fq;
        const float alpha = (MODE == 1) ? 1.0f : 0.5f;
#pragma unroll
        for (int ai = 0; ai < 2; ++ai)
#pragma unroll
            for (int m = 0; m < 4; ++m) {
                const int row = row0 + ai * HALF + m * 16;
                float ss = 0.f;
#pragma unroll
                for (int bj = 0; bj < 2; ++bj) {
                    const size_t off = (size_t)row * 1024 + col0 + bj * HALF;
                    f32x4 b0, b1; unpack8(*(const u32x4*)(XB + off), b0, b1);
                    const f32x4 v0 = b0 + acc[ai][bj][m][0] * alpha, v1 = b1 + acc[ai][bj][m][1] * alpha;
                    if (MODE == 2) { *(f32x4*)(out + off) = v0; *(f32x4*)(out + off + 4) = v1; }
                    else {
                        *(u32x4*)(XB + off) = pack8(v0, v1);
                        ss += ((v0[0] * v0[0] + v0[1] * v0[1]) + (v0[2] * v0[2] + v0[3] * v0[3])) + ((v1[0] * v1[0] + v1[1] * v1[1]) + (v1[2] * v1[2] + v1[3] * v1[3]));
                    }
                }
                if (MODE != 2) { ss += __shfl_xor(ss, 16); ss += __shfl_xor(ss, 32); if (fq == 0) ssp[(size_t)row * 16 + u.pn * 4 + wc] = ss; }
            }
    }
};

struct EpiIn {
    static constexpr bool PERM = true, AFTER_DRAIN = false;
    const float* ssp; bf16_t *Q, *K, *V; float* U; bf16_t *GA, *GB; const float *qn, *kn; float* out;
    __device__ __forceinline__ void operator()(const f32x4 (&acc)[2][2][4][2], const Unit& u, int wr, int wc, int fr, int fq) const {
        const int row0 = u.pm * BM + wr * 64 + fr, pn = u.pn;
        float rsv[8]; rstd8_from_partials(ssp, row0, fq, rsv);
        constexpr size_t O_KVP[3] = {17039360u, 17301504u, 18350080u}, O_KVS[3] = {22575104u, 24672256u, 33060864u};
        constexpr size_t O_POOLP = 22544384u, O_POOLS = 66615296u;
        if (pn < 6) {
            const bool isk = pn >= 3; const int head = 4 * (isk ? pn - 3 : pn) + wc, g = head >> 2, hs = head & 3, win = 128 << (2 * g);
            const float* gn = (isk ? kn : qn) + head * 64 + 8 * fq;
            f32x4 gv[2][2];
#pragma unroll
            for (int bj = 0; bj < 2; ++bj)
#pragma unroll
                for (int n = 0; n < 2; ++n) gv[bj][n] = *(const f32x4*)(gn + 32 * bj + 4 * n);
            bf16_t* dst = isk ? K : Q;
#pragma unroll
            for (int ai = 0; ai < 2; ++ai)
#pragma unroll
                for (int m = 0; m < 4; ++m) {
                    const int row = row0 + ai * HALF + m * 16; const float rs = rsv[ai * 4 + m];
                    f32x4 v[2][2]; float ss = 0.f;
#pragma unroll
                    for (int bj = 0; bj < 2; ++bj)
#pragma unroll
                        for (int n = 0; n < 2; ++n) { v[bj][n] = acc[ai][bj][m][n] * rs; const f32x4 x = v[bj][n]; ss += (x[0] * x[0] + x[1] * x[1]) + (x[2] * x[2] + x[3] * x[3]); }
                    ss += __shfl_xor(ss, 16); ss += __shfl_xor(ss, 32);
                    const float r2 = __builtin_amdgcn_rsqf(ss * (1.0f / 64.0f) + RMS_EPS);
                    float* fo = nullptr;
                    if (isk) {
                        if (row < 16384) { const int b = row >> 12, t = row & 4095; if (t >= 4096 - win) fo = out + O_KVP[g] + ((size_t)(b * win + t - (4096 - win)) * 512 + hs * 64 + 8 * fq); }
                        else { const int s = row - 16384, b = s >> 3, t = s & 7; fo = out + O_KVS[g] + ((size_t)(b * win + win - 8 + t) * 512 + hs * 64 + 8 * fq); }
                    }
#pragma unroll
                    for (int bj = 0; bj < 2; ++bj) {
                        const f32x4 o0 = v[bj][0] * r2 * gv[bj][0], o1 = v[bj][1] * r2 * gv[bj][1];
                        *(u32x4*)(dst + (size_t)row * 768 + head * 64 + 32 * bj + 8 * fq) = pack8(o0, o1);
                        if (fo) { *(f32x4*)(fo + 32 * bj) = o0; *(f32x4*)(fo + 32 * bj + 4) = o1; }
                    }
                }
        } else if (pn < 9) {
            const int cb = (pn - 6) * 256 + wc * 32 + 8 * fq;
#pragma unroll
            for (int ai = 0; ai < 2; ++ai)
#pragma unroll
                for (int m = 0; m < 4; ++m) {
                    const int row = row0 + ai * HALF + m * 16; const float rs = rsv[ai * 4 + m];
#pragma unroll
                    for (int bj = 0; bj < 2; ++bj) {
                        const int c = cb + 128 * bj, head = c >> 6, g = head >> 2, hs = head & 3, win = 128 << (2 * g), dim = c & 63;
                        const f32x4 o0 = acc[ai][bj][m][0] * rs, o1 = acc[ai][bj][m][1] * rs;
                        *(u32x4*)(V + (size_t)row * 768 + c) = pack8(o0, o1);
                        float* fo = nullptr;
                        if (row < 16384) { const int b = row >> 12, t = row & 4095; if (t >= 4096 - win) fo = out + O_KVP[g] + ((size_t)(b * win + t - (4096 - win)) * 512 + 256 + hs * 64 + dim); }
                        else { const int s = row - 16384, b = s >> 3, t = s & 7; fo = out + O_KVS[g] + ((size_t)(b * win + win - 8 + t) * 512 + 256 + hs * 64 + dim); }
                        if (fo) { *(f32x4*)(fo) = o0; *(f32x4*)(fo + 4) = o1; }
                    }
                }
        } else if (pn < 11) {
            const int cb = (pn - 9) * 256 + wc * 32 + 8 * fq;
#pragma unroll
            for (int ai = 0; ai < 2; ++ai)
#pragma unroll
                for (int m = 0; m < 4; ++m) {
                    const int row = row0 + ai * HALF + m * 16; const float rs = rsv[ai * 4 + m];
                    float* fo = nullptr;
                    if (row < 16384) { const int b = row >> 12, t = row & 4095; if (t >= 4081) fo = out + O_POOLP + (size_t)(b * 15 + t - 4081) * 512 + cb; }
                    else { const int s = row - 16384, b = s >> 3, t = s & 7; fo = out + O_POOLS + (size_t)(b * 15 + 7 + t) * 512 + cb; }
#pragma unroll
                    for (int bj = 0; bj < 2; ++bj) {
                        const f32x4 o0 = acc[ai][bj][m][0] * rs, o1 = acc[ai][bj][m][1] * rs;
                        float* up = U + (size_t)row * 512 + cb + 128 * bj;
                        *(f32x4*)(up) = o0; *(f32x4*)(up + 4) = o1;
                        if (fo) { *(f32x4*)(fo + 128 * bj) = o0; *(f32x4*)(fo + 128 * bj + 4) = o1; }
                    }
                }
        } else {
            const bool isb = pn >= 15; bf16_t* G = isb ? GB : GA; const int cb = (pn - (isb ? 15 : 11)) * 256 + wc * 32 + 8 * fq;
#pragma unroll
            for (int ai = 0; ai < 2; ++ai)
#pragma unroll
                for (int m = 0; m < 4; ++m) {
                    const int row = row0 + ai * HALF + m * 16; const float rs = rsv[ai * 4 + m];
#pragma unroll
                    for (int bj = 0; bj < 2; ++bj) {
                        f32x4 o0 = acc[ai][bj][m][0] * rs, o1 = acc[ai][bj][m][1] * rs;
#pragma unroll
                        for (int e = 0; e < 4; ++e) { o0[e] = sigmoidf_fast(o0[e]); o1[e] = sigmoidf_fast(o1[e]); }
                        *(u32x4*)(G + (size_t)row * 1024 + cb + 128 * bj) = pack8(o0, o1);
                    }
                }
        }
    }
};

template <int PART> struct EpiMerge {
    static constexpr bool PERM = true, AFTER_DRAIN = false;
    const bf16_t* G; bf16_t* T; bf16_t* MG;
    __device__ __forceinline__ void operator()(const f32x4 (&acc)[2][2][4][2], const Unit& u, int wr, int wc, int fr, int fq) const {
        const int row0 = u.pm * BM + wr * 64 + fr, col0 = u.pn * BM + wc * 32 + 8 * fq;
#pragma unroll
        for (int ai = 0; ai < 2; ++ai)
#pragma unroll
            for (int m = 0; m < 4; ++m) {
                const int row = row0 + ai * HALF + m * 16;
#pragma unroll
                for (int bj = 0; bj < 2; ++bj) {
                    const size_t off = (size_t)row * 1024 + col0 + bj * HALF;
                    const u32x4 gw = *(const u32x4*)(G + off);
                    f32x4 o0, o1;
                    o0[0] = __uint_as_float(gw.x << 16) * acc[ai][bj][m][0][0]; o0[1] = __uint_as_float(gw.x & 0xffff0000u) * acc[ai][bj][m][0][1];
                    o0[2] = __uint_as_float(gw.y << 16) * acc[ai][bj][m][0][2]; o0[3] = __uint_as_float(gw.y & 0xffff0000u) * acc[ai][bj][m][0][3];
                    o1[0] = __uint_as_float(gw.z << 16) * acc[ai][bj][m][1][0]; o1[1] = __uint_as_float(gw.z & 0xffff0000u) * acc[ai][bj][m][1][1];
                    o1[2] = __uint_as_float(gw.w << 16) * acc[ai][bj][m][1][2]; o1[3] = __uint_as_float(gw.w & 0xffff0000u) * acc[ai][bj][m][1][3];
                    if (PART == 1) {
                        const u32x4 tw = *(const u32x4*)(T + off);
                        o0[0] += __uint_as_float(tw.x << 16); o0[1] += __uint_as_float(tw.x & 0xffff0000u); o0[2] += __uint_as_float(tw.y << 16); o0[3] += __uint_as_float(tw.y & 0xffff0000u);
                        o1[0] += __uint_as_float(tw.z << 16); o1[1] += __uint_as_float(tw.z & 0xffff0000u); o1[2] += __uint_as_float(tw.w << 16); o1[3] += __uint_as_float(tw.w & 0xffff0000u);
                        *(u32x4*)(MG + off) = pack8(o0, o1);
                    } else {
                        *(u32x4*)(T + off) = pack8(o0, o1);
                    }
                }
                if (m & 1) asm volatile("" ::: "memory");
            }
    }
};

struct NoSide { static constexpr int NV = 1; __device__ __forceinline__ bool pre(f32x4 (&)[1], int) const { return false; } __device__ __forceinline__ void post(const f32x4 (&)[1], bool, int) const {} };
struct SideCopy {
    static constexpr int NV = 6;
    static constexpr int CPB2 = 680, CPB1 = 168, CPB0 = 40;
    static constexpr int NCH2 = 32 * CPB2, NCH1 = 32 * CPB1, NCH0 = 32 * CPB0, NCH = NCH2 + NCH1 + NCH0;
    const float *c128, *c512, *c2048; float* out; int gw; int* step;
    __device__ __forceinline__ bool locate(int id, const f32x4*& s, f32x4*& d) const {
        if (id >= NCH) return false;
        if (id < NCH2) { const int b = id / CPB2, k = id - b * CPB2; s = (const f32x4*)(c2048 + ((size_t)b * 2048 + 8) * 512) + k * 384; d = (f32x4*)(out + 33060864u + (size_t)b * 2048 * 512) + k * 384; return true; }
        id -= NCH2;
        if (id < NCH1) { const int b = id / CPB1, k = id - b * CPB1; s = (const f32x4*)(c512 + ((size_t)b * 512 + 8) * 512) + k * 384; d = (f32x4*)(out + 24672256u + (size_t)b * 512 * 512) + k * 384; return true; }
        id -= NCH1;
        { const int b = id / CPB0, k = id - b * CPB0; s = (const f32x4*)(c128 + ((size_t)b * 128 + 8) * 512) + k * 384; d = (f32x4*)(out + 22575104u + (size_t)b * 128 * 512) + k * 384; return true; }
    }
    __device__ __forceinline__ bool pre(f32x4 (&v)[NV], int lane) const {
        const f32x4* s; f32x4* d; if (!locate(*step * 2048 + gw, s, d)) return false;
#pragma unroll
        for (int q = 0; q < NV; ++q) v[q] = __builtin_nontemporal_load(s + q * 64 + lane);
        return true;
    }
    __device__ __forceinline__ void post(const f32x4 (&v)[NV], bool ok, int lane) const {
        if (ok) { const f32x4* s; f32x4* d; locate(*step * 2048 + gw, s, d);
#pragma unroll
            for (int q = 0; q < NV; ++q) __builtin_nontemporal_store(v[q], d + q * 64 + lane); }
        *step += 1;
    }
};
template <class Epi, class Sched, bool ALIGN_EPI = false, bool SP2 = false, class Side = NoSide>
__device__ __forceinline__ void gemm_phase(PG8_LAS unsigned char* lds, const Gemm g, const Sched& S, const Epi& E, const Side side = Side()) {
    int tid_ = threadIdx.x; asm volatile("" : "+v"(tid_));
    const int tid = tid_, wid = __builtin_amdgcn_readfirstlane(tid >> 6), lane = tid & 63, wr = wid >> 2, wc = wid & 3, fr = lane & 15, fq = lane >> 4;
    const int K = g.K, nt = K / BK;
    unsigned voffA[2], voffB[2];
#pragma unroll
    for (int i = 0; i < 2; ++i) { int R, C; stage_rc(tid * 16 + i * 8192, R, C); const int Rb = Epi::PERM ? ((R & ~31) + perm32(R & 31)) : R;
        voffA[i] = (unsigned)(R * K + C) * 2u; voffB[i] = (unsigned)(Rb * K + C) * 2u; }
    const size_t kstep = (size_t)(BK * 2);
    const size_t hstep = (size_t)HALF * K * 2;
    const size_t tstep = 2 * hstep;
    const unsigned ldsw = (unsigned)wid * 1024u;
    const int aoff = lds_byte(wr * 64 + fr, fq * 8), boff = lds_byte(wc * 32 + fr, fq * 8);
#define PG8_SA(b, h) (((b) * 2 + (h)) * HTB)
#define PG8_SB(b, h) ((4 + (b) * 2 + (h)) * HTB)
#define PG8_STAGE(bufoff, gbase, voff) do { _Pragma("unroll") for (int _i = 0; _i < 2; ++_i) \
        __builtin_amdgcn_global_load_lds((const unsigned*)((const char*)(gbase) + (voff)[_i]), (PG8_LAS unsigned*)(lds + (bufoff) + ldsw + _i * 8192), 16, 0, 0); } while (0)
#define PG8_LDA(dst, b, h) do { _Pragma("unroll") for (int m = 0; m < 4; ++m) _Pragma("unroll") for (int k = 0; k < 2; ++k) dst[m][k] = *(const PG8_LAS bf16x8*)(lds + PG8_SA(b, h) + aoff + m * 2048 + k * 1024); } while (0)
#define PG8_LDB(dst, b, h) do { _Pragma("unroll") for (int n = 0; n < 2; ++n) _Pragma("unroll") for (int k = 0; k < 2; ++k) dst[n][k] = *(const PG8_LAS bf16x8*)(lds + PG8_SB(b, h) + boff + n * 2048 + k * 1024); } while (0)
#define PG8_MMA(ai, bj, At, Bt) do { __builtin_amdgcn_s_setprio(1); _Pragma("unroll") for (int m = 0; m < 4; ++m) _Pragma("unroll") for (int n = 0; n < 2; ++n) _Pragma("unroll") for (int k = 0; k < 2; ++k) \
        acc[ai][bj][m][n] = __builtin_amdgcn_mfma_f32_16x16x32_bf16(Bt[n][k], At[m][k], acc[ai][bj][m][n], 0, 0, 0); __builtin_amdgcn_s_setprio(0); } while (0)
#define PG8_WAIT_V(n) asm volatile("s_waitcnt vmcnt(" #n ")" ::: "memory")
#define PG8_WAIT_L(n) asm volatile("s_waitcnt lgkmcnt(" #n ")" ::: "memory")
#define PG8_BAR __builtin_amdgcn_s_barrier()
#define PG8_SCHED __builtin_amdgcn_sched_barrier(0)
    Unit cur, nxt; int ui = 0;
    if (!S.next(0, cur)) return;
    f32x4 acc[2][2][4][2];
#pragma unroll
    for (int a = 0; a < 2; ++a)
#pragma unroll
        for (int b = 0; b < 2; ++b)
#pragma unroll
            for (int m = 0; m < 4; ++m)
#pragma unroll
                for (int n = 0; n < 2; ++n) acc[a][b][m][n] = (f32x4){0.f, 0.f, 0.f, 0.f};
    bf16x8 At[4][2], B0[2][2], B1[2][2];
    const char* cA = (const char*)g.A + (size_t)cur.pm * tstep; const char* cB = (const char*)g.Bt + (size_t)cur.pn * tstep;
    S.a_ready(cur);
    if constexpr (SP2) {
        PG8_STAGE(PG8_SB(0, 0), cB, voffB); PG8_STAGE(PG8_SB(0, 1), cB + hstep, voffB); PG8_STAGE(PG8_SA(0, 0), cA, voffA); PG8_STAGE(PG8_SA(0, 1), cA + hstep, voffA);
        if (wr == 1) PG8_BAR;
        PG8_WAIT_V(2); PG8_BAR;
        PG8_STAGE(PG8_SB(1, 0), cB + kstep, voffB); PG8_STAGE(PG8_SA(1, 0), cA + kstep, voffA); PG8_STAGE(PG8_SB(1, 1), cB + hstep + kstep, voffB);
        PG8_WAIT_V(6); PG8_BAR;
    } else {
        PG8_STAGE(PG8_SB(0, 0), cB, voffB); PG8_STAGE(PG8_SA(0, 0), cA, voffA); PG8_STAGE(PG8_SB(0, 1), cB + hstep, voffB); PG8_STAGE(PG8_SA(0, 1), cA + hstep, voffA);
        if (wr == 1) PG8_BAR;
        PG8_WAIT_V(4); PG8_BAR;
        PG8_STAGE(PG8_SB(1, 0), cB + kstep, voffB); PG8_STAGE(PG8_SA(1, 0), cA + kstep, voffA); PG8_STAGE(PG8_SB(1, 1), cB + hstep + kstep, voffB);
        PG8_WAIT_V(6); PG8_BAR;
    }
    for (;;) {
        const bool has_next = S.next(ui + 1, nxt);
        const char* nA = has_next ? (const char*)g.A + (size_t)nxt.pm * tstep : cA; const char* nB = has_next ? (const char*)g.Bt + (size_t)nxt.pn * tstep : cB;
        for (int t = 0; t < nt; t += 2) {
            const bool last = (t == nt - 2);
            const char* a1 = cA + (size_t)(t + 1) * kstep;
            const char* a2 = last ? nA : cA + (size_t)(t + 2) * kstep; const char* b2 = last ? nB : cB + (size_t)(t + 2) * kstep;
            const char* a3 = a2 + kstep; const char* b3 = b2 + kstep;
            if (last && has_next) S.a_ready(nxt);
            if constexpr (SP2) {
            PG8_LDB(B0, 0, 0); PG8_LDB(B1, 0, 1); PG8_SCHED; PG8_LDA(At, 0, 0); PG8_STAGE(PG8_SA(1, 1), a1 + hstep, voffA);
            PG8_WAIT_V(8); PG8_WAIT_L(0); PG8_BAR; PG8_MMA(0, 0, At, B0); PG8_MMA(0, 1, At, B1); PG8_BAR; PG8_SCHED;
            PG8_LDA(At, 0, 1); PG8_STAGE(PG8_SB(0, 0), b2, voffB); PG8_STAGE(PG8_SB(0, 1), b2 + hstep, voffB); PG8_STAGE(PG8_SA(0, 0), a2, voffA);
            PG8_WAIT_V(8); PG8_WAIT_L(0); PG8_BAR; PG8_MMA(1, 0, At, B0); PG8_MMA(1, 1, At, B1); PG8_BAR; PG8_SCHED;
            PG8_LDB(B0, 1, 0); PG8_LDB(B1, 1, 1); PG8_SCHED; PG8_LDA(At, 1, 0); PG8_STAGE(PG8_SA(0, 1), a2 + hstep, voffA);
            PG8_WAIT_V(8); PG8_WAIT_L(0); PG8_BAR; PG8_MMA(0, 0, At, B0); PG8_MMA(0, 1, At, B1); PG8_BAR; PG8_SCHED;
            PG8_LDA(At, 1, 1); PG8_STAGE(PG8_SB(1, 0), b3, voffB); PG8_STAGE(PG8_SB(1, 1), b3 + hstep, voffB); PG8_STAGE(PG8_SA(1, 0), a3, voffA);
            PG8_WAIT_V(8); PG8_WAIT_L(0); PG8_BAR; PG8_MMA(1, 0, At, B0); PG8_MMA(1, 1, At, B1); PG8_BAR; PG8_SCHED;
            } else {
            PG8_LDB(B0, 0, 0); PG8_SCHED; PG8_LDA(At, 0, 0); PG8_STAGE(PG8_SA(1, 1), a1 + hstep, voffA);
            PG8_WAIT_L(8); PG8_BAR; PG8_WAIT_L(0); PG8_MMA(0, 0, At, B0); PG8_BAR; PG8_SCHED;
            PG8_LDB(B1, 0, 1); PG8_STAGE(PG8_SB(0, 0), b2, voffB);
            PG8_BAR; PG8_WAIT_L(0); PG8_MMA(0, 1, At, B1); PG8_BAR;
            PG8_LDA(At, 0, 1); PG8_STAGE(PG8_SA(0, 0), a2, voffA);
            PG8_BAR; PG8_WAIT_L(0); PG8_MMA(1, 0, At, B0); PG8_BAR; PG8_SCHED;
            PG8_STAGE(PG8_SB(0, 1), b2 + hstep, voffB);
            PG8_WAIT_V(6); PG8_BAR; PG8_MMA(1, 1, At, B1); PG8_BAR;
            PG8_LDB(B0, 1, 0); PG8_SCHED; PG8_LDA(At, 1, 0); PG8_STAGE(PG8_SA(0, 1), a2 + hstep, voffA);
            PG8_WAIT_L(8); PG8_BAR; PG8_WAIT_L(0); PG8_MMA(0, 0, At, B0); PG8_BAR; PG8_SCHED;
            PG8_LDB(B1, 1, 1); PG8_STAGE(PG8_SB(1, 0), b3, voffB);
            PG8_BAR; PG8_WAIT_L(0); PG8_MMA(0, 1, At, B1); PG8_BAR;
            PG8_LDA(At, 1, 1); PG8_STAGE(PG8_SA(1, 0), a3, voffA);
            PG8_BAR; PG8_WAIT_L(0); PG8_MMA(1, 0, At, B0); PG8_BAR; PG8_SCHED;
            PG8_STAGE(PG8_SB(1, 1), b3 + hstep, voffB);
            PG8_WAIT_V(6); PG8_BAR; PG8_MMA(1, 1, At, B1); PG8_BAR;
            }
        }
        if constexpr (ALIGN_EPI) { if (wr == 0) PG8_BAR; }
        if constexpr (!Epi::AFTER_DRAIN) { int t2_ = threadIdx.x; asm volatile("" : "+v"(t2_)); const int lane2_ = t2_ & 63;
            f32x4 sv_[Side::NV]; const bool sok_ = side.pre(sv_, lane2_); E(acc, cur, wr, wc, lane2_ & 15, lane2_ >> 4); side.post(sv_, sok_, lane2_); S.done(cur); }
        if (!has_next) break;
#pragma unroll
        for (int a = 0; a < 2; ++a)
#pragma unroll
            for (int b = 0; b < 2; ++b)
#pragma unroll
                for (int m = 0; m < 4; ++m)
#pragma unroll
                    for (int n = 0; n < 2; ++n) acc[a][b][m][n] = (f32x4){0.f, 0.f, 0.f, 0.f};
        cur = nxt; cA = nA; cB = nB; ++ui;
        if constexpr (ALIGN_EPI) { if (wr == 1) PG8_BAR; }
    }
    PG8_WAIT_V(0);
    if constexpr (!ALIGN_EPI) { if (wr == 0) PG8_BAR; }
    PG8_BAR;
    if constexpr (Epi::AFTER_DRAIN) { E.fused(acc, cur, wr, wc, fr, fq, lds, wid, lane); S.done(cur); }
#undef PG8_SA
#undef PG8_SB
#undef PG8_STAGE
#undef PG8_LDA
#undef PG8_LDB
#undef PG8_MMA
#undef PG8_WAIT_V
#undef PG8_WAIT_L
#undef PG8_BAR
#undef PG8_SCHED
}
}

constexpr int NWAVES = 8;
constexpr int DM = 1024, NBATCH = 4, SEQ = 4096, DBATCH = 32, DSEQ = 8;
constexpr int MP = NBATCH * SEQ, MS = DBATCH * DSEQ, M = MP + MS;
constexpr int FF = 2816, FF2 = 5632, INW = 4864, AW = 768, AOW = 256, PW = 512;
constexpr size_t O_Y = 0, O_KV128P = 17039360u, O_KV512P = 17301504u, O_KV2048P = 18350080u, O_POOLP = 22544384u,
                 O_KV128S = 22575104u, O_KV512S = 24672256u, O_KV2048S = 33060864u, O_POOLS = 66615296u, O_END = 66861056u;
constexpr size_t MiB = 1u << 20;
constexpr size_t WS_CTL = 0, CTL_ZERO_BYTES = 1 * MiB;
constexpr size_t WS_WUP1 = 2 * MiB, WS_WDN1 = 13 * MiB, WS_WIN = 19 * MiB, WS_WAB = 29 * MiB, WS_WEFF = 30 * MiB, WS_WOUT = 31 * MiB, WS_WUP2 = 33 * MiB, WS_WDN2 = 44 * MiB;
constexpr size_t WS_RSTD0 = 50 * MiB, WS_SSP1 = 51 * MiB, WS_SSP2 = 53 * MiB, WS_BIAS = 55 * MiB;
constexpr size_t WS_XB = 56 * MiB;
constexpr size_t WS_X1 = 90 * MiB;
constexpr size_t WS_R = 156 * MiB;
constexpr size_t WS_Q = WS_R, WS_K = WS_Q + 25 * MiB, WS_V = WS_K + 25 * MiB;
constexpr size_t WS_U = WS_V + 25 * MiB;
constexpr size_t WS_GA = WS_U + 33 * MiB, WS_GB = WS_GA + 33 * MiB;
constexpr size_t WS_AA = WS_GB + 33 * MiB, WS_DD = WS_AA + 9 * MiB;
constexpr size_t WS_T = WS_DD + 17 * MiB, WS_MG = WS_T + 33 * MiB, WS_END = WS_MG + 33 * MiB;
static_assert(WS_END <= 512 * MiB, "d_ws map");
static_assert(WS_R + (size_t)M * FF * 2 <= WS_END, "H fits");
constexpr int CW_TMO = 0, CW_BAR = 4096;
constexpr int RING_OFF = 0, RING_BYTES = 131072;
constexpr int LDS_BYTES = 147456;
constexpr int LDSCTL_OFF = LDS_BYTES - 1024, MISC_OFF = LDSCTL_OFF + 320;
#define GAS __attribute__((address_space(1)))
#define LAS __attribute__((address_space(3)))
typedef unsigned short bf16;
typedef unsigned v4u __attribute__((ext_vector_type(4)));
typedef float f32x4 __attribute__((ext_vector_type(4)));
typedef short bf16x8 __attribute__((ext_vector_type(8)));
typedef GAS unsigned gu32;
typedef GAS unsigned long long gu64;
#define RLX_AGENT __ATOMIC_RELAXED, __HIP_MEMORY_SCOPE_AGENT
#define LDS_WAIT() asm volatile("s_waitcnt lgkmcnt(0)" ::: "memory")
#define VM_WAIT() asm volatile("s_waitcnt vmcnt(0)" ::: "memory")
__device__ __forceinline__ unsigned long long rt() { return __builtin_amdgcn_s_memrealtime(); }
__device__ __forceinline__ unsigned f2bf(float f) { unsigned u = __builtin_bit_cast(unsigned, f); return (u + 0x7fffu + ((u >> 16) & 1u)) >> 16; }
__device__ __forceinline__ unsigned pk2(float lo, float hi) { return f2bf(lo) | (f2bf(hi) << 16); }

#define XB_TMO      128
#define XB_XCNT(j)  (256  + 64 * (j))
#define XB_XSUB(j)  (1280 + 64 * (j))
#define XB_XGEN(j)  (2304 + 64 * (j))
#define XB_TOP      3328
#define XB_TOPGEN   3392
#define XCD_BAR_WORDS 3456
#define XB_SPIN_CAP (1u << 18)

__device__ __forceinline__ unsigned xb_ld(unsigned* p)              { return __hip_atomic_load(p, __ATOMIC_RELAXED, __HIP_MEMORY_SCOPE_AGENT); }
__device__ __forceinline__ unsigned xb_add(unsigned* p, unsigned v) { return __hip_atomic_fetch_add(p, v, __ATOMIC_RELAXED, __HIP_MEMORY_SCOPE_AGENT); }
__device__ __forceinline__ unsigned xb_xcc_id() { return (unsigned)__builtin_amdgcn_s_getreg((3 << 11) | 20) & 0xFu; }
#define XB_SPIN(cond, bar) do { unsigned _sp = 0; while (cond) { __builtin_amdgcn_s_sleep(1); \
    if ((++_sp & 255u) == 0u) { if (xb_ld(&(bar)[XB_TMO])) break; if (_sp > XB_SPIN_CAP) { atomicAdd(&(bar)[XB_TMO], 1u); break; } } } } while (0)

struct XcdBarrier {
    unsigned* bar; unsigned x;
    volatile LAS unsigned* st;
};

__device__ __forceinline__ XcdBarrier xcd_barrier_post(unsigned* bar, volatile LAS unsigned* st) {
    XcdBarrier b; b.bar = bar; b.x = xb_xcc_id(); b.st = st;
    if (threadIdx.x == 0) (void)xb_add(&bar[XB_XCNT(b.x)], 1u);
    return b;
}
__device__ __forceinline__ void xcd_barrier_complete(unsigned* bar, unsigned x, unsigned& nloc, unsigned& nx) {
    const unsigned G = gridDim.x * gridDim.y * gridDim.z;
    unsigned sum, cnt, mine, sp = 0u;
    for (;;) {
        sum = 0u; cnt = 0u; mine = 0u;
#pragma unroll
        for (unsigned j = 0; j < 16; ++j) { const unsigned c = xb_ld(&bar[XB_XCNT(j)]); sum += c; cnt += (c > 0u) ? 1u : 0u; mine = (j == x) ? c : mine; }
        if (sum == G) break;
        __builtin_amdgcn_s_sleep(1);
        if ((++sp & 255u) == 0u) { if (xb_ld(&bar[XB_TMO])) break; if (sp > XB_SPIN_CAP) { atomicAdd(&bar[XB_TMO], 1u); break; } }
    }
    nloc = mine > 0u ? mine : 1u; nx = cnt > 0u ? cnt : 1u;
}

__device__ __forceinline__ void xcd_barrier(const XcdBarrier& b) {
    asm volatile("s_waitcnt vmcnt(0)" ::: "memory");
    __syncthreads();
    if (threadIdx.x == 0) {
        unsigned* bar = b.bar;
        __builtin_amdgcn_s_waitcnt(0);
        unsigned nloc = b.st[0], nx = b.st[1];
        if (nloc == 0u) { xcd_barrier_complete(bar, b.x, nloc, nx); b.st[0] = nloc; b.st[1] = nx; }
        const unsigned old = xb_add(&bar[XB_XSUB(b.x)], 1u);
        const unsigned gen = old / nloc;
        if (old + 1u == (gen + 1u) * nloc) {
            __builtin_amdgcn_fence(__ATOMIC_RELEASE, "agent");
            asm volatile("s_waitcnt vmcnt(0)" ::: "memory");
            const unsigned og = xb_add(&bar[XB_TOP], 1u);
            const unsigned tg = og / nx;
            if (og + 1u == (tg + 1u) * nx) xb_add(&bar[XB_TOPGEN], 1u);
            else XB_SPIN(xb_ld(&bar[XB_TOPGEN]) == tg, bar);
            __builtin_amdgcn_fence(__ATOMIC_ACQUIRE, "agent");
            xb_add(&bar[XB_XGEN(b.x)], 1u);
            asm volatile("s_waitcnt vmcnt(0)" ::: "memory");
        } else {
            XB_SPIN(xb_ld(&bar[XB_XGEN(b.x)]) == gen, bar);
            __builtin_amdgcn_fence(__ATOMIC_ACQUIRE, "agent");
            asm volatile("s_waitcnt vmcnt(0)" ::: "memory");
        }
    }
    __syncthreads();
}

struct Frame {
    LAS unsigned char* lds;
    volatile LAS unsigned* MISC;
    gu32* ctl;
    int tid, lane, wave;
    int vcu, G;
};
__device__ __forceinline__ float wave_sum(float v) {
#pragma unroll
    for (int o = 1; o < 64; o <<= 1) v += __shfl_xor(v, o);
    return v;
}
__device__ __forceinline__ float wave_max(float v) {
#pragma unroll
    for (int o = 1; o < 64; o <<= 1) v = fmaxf(v, __shfl_xor(v, o));
    return v;
}
__constant__ unsigned char T5B[3][132] = {
 {0,1,2,3,4,5,6,7,8,9,10,11,12,13,14,15,16,16,16,16,16,16,17,17,17,17,17,17,17,17,18,18,18,18,18,18,18,18,18,18,19,19,19,19,19,19,19,19,19,19,19,19,19,19,20,20,20,20,20,20,20,20,20,20,20,20,20,20,20,20,20,20,20,21,21,21,21,21,21,21,21,21,21,21,21,21,21,21,21,21,21,21,21,21,21,21,21,21,21,22,22,22,22,22,22,22,22,22,22,22,22,22,22,22,22,22,22,22,22,22,22,22,22,22,22,22,22,22,22,0,0,0},
 {0,4,8,12,16,16,17,17,18,18,19,19,19,19,20,20,20,20,20,21,21,21,21,21,21,22,22,22,22,22,22,22,22,22,23,23,23,23,23,23,23,23,23,23,23,23,24,24,24,24,24,24,24,24,24,24,24,24,24,24,24,24,25,25,25,25,25,25,25,25,25,25,25,25,25,25,25,25,25,25,25,25,25,26,26,26,26,26,26,26,26,26,26,26,26,26,26,26,26,26,26,26,26,26,26,26,26,26,26,26,26,26,26,27,27,27,27,27,27,27,27,27,27,27,27,27,27,27,27,0,0,0},
 {0,16,18,19,20,21,21,22,22,23,23,23,24,24,24,24,25,25,25,25,25,26,26,26,26,26,26,26,26,27,27,27,27,27,27,27,27,27,27,28,28,28,28,28,28,28,28,28,28,28,28,28,29,29,29,29,29,29,29,29,29,29,29,29,29,29,29,29,29,29,30,30,30,30,30,30,30,30,30,30,30,30,30,30,30,30,30,30,30,30,30,30,30,30,30,31,31,31,31,31,31,31,31,31,31,31,31,31,31,31,31,31,31,31,31,31,31,31,31,31,31,31,31,31,31,31,31,31,31,0,0,0}};

template <int MAP> __device__ __forceinline__ void p0_transpose_item(const float* W, int K, int N, bf16* WT, const float* gain, LAS float* scr, int item, int lane) {
    const int nblk = N / 32, kb = item / nblk, nb = item % nblk, k0 = 64 * kb, n0 = 32 * nb;
    int v0 = n0;
    if (MAP == 1) { const int c = n0 < FF ? n0 : n0 - FF; v0 = 256 * (c >> 7) + (n0 < FF ? 0 : 128) + (c & 127); }
    if (MAP == 2) { if (n0 < 1536) { const int o = n0 & 255; v0 = (n0 & ~255) + 128 * ((o >> 5) & 1) + 32 * (o >> 6); } }
    f32x4 wv[8]; const int kr = lane >> 3, n4 = (lane & 7) * 4;
#pragma unroll
    for (int i = 0; i < 8; ++i) wv[i] = *(const f32x4*)(W + (size_t)(k0 + kr + 8 * i) * N + n0 + n4);
#pragma unroll
    for (int i = 0; i < 8; ++i) { const int kk = kr + 8 * i; f32x4 w = wv[i]; if (gain) w = w * gain[k0 + kk];
        LAS float* d = scr + kk * 33 + n4; d[0] = w[0]; d[1] = w[1]; d[2] = w[2]; d[3] = w[3]; }
    LDS_WAIT(); asm volatile("" ::: "memory");
    const int c = lane & 7;
#pragma unroll
    for (int j = 0; j < 4; ++j) { const int n = (lane >> 3) + 8 * j; const LAS float* s = scr + (8 * c) * 33 + n;
        v4u o; o.x = pk2(s[0 * 33], s[1 * 33]); o.y = pk2(s[2 * 33], s[3 * 33]); o.z = pk2(s[4 * 33], s[5 * 33]); o.w = pk2(s[6 * 33], s[7 * 33]);
        *(GAS v4u*)(WT + (size_t)(v0 + n) * K + k0 + 8 * c) = o; }
    LDS_WAIT(); asm volatile("" ::: "memory");
}
struct Ptrs {
    const float *xp, *xs, *c128, *c512, *c2048, *spool, *rbias, *n1, *wup1, *wdn1, *nmix, *win, *qn, *kn, *wg, *pscale, *wab, *wpb, *wout, *n2, *wup2, *wdn2;
    float* out; unsigned char* ws;
};
constexpr int I_UP = (DM / 64) * (FF2 / 32), I_DN = (FF / 64) * (DM / 32), I_IN = (DM / 64) * (INW / 32), I_AB = (AOW / 64) * (DM / 32), I_OUT = (DM / 64) * (DM / 32);
constexpr int WI_WUP1 = 0, WI_WDN1 = I_UP, WI_WIN = WI_WDN1 + I_DN, WI_WAB = WI_WIN + I_IN, WI_WOUT = WI_WAB + I_AB, WI_WUP2 = WI_WOUT + I_OUT, WI_WDN2 = WI_WUP2 + I_UP, WI_END = WI_WDN2 + I_DN;
__device__ __forceinline__ void convert_items(const Ptrs& P, int first, int last, int gwh, int ngwh, LAS float* scr, int lane) {
    unsigned char* ws = P.ws;
    for (int it = first + gwh; it < last; it += ngwh) {
        if (it < WI_WDN1) p0_transpose_item<1>(P.wup1, DM, FF2, (bf16*)(ws + WS_WUP1), P.n1, scr, it - WI_WUP1, lane);
        else if (it < WI_WIN) p0_transpose_item<0>(P.wdn1, FF, DM, (bf16*)(ws + WS_WDN1), nullptr, scr, it - WI_WDN1, lane);
        else if (it < WI_WAB) p0_transpose_item<2>(P.win, DM, INW, (bf16*)(ws + WS_WIN), P.nmix, scr, it - WI_WIN, lane);
        else if (it < WI_WOUT) p0_transpose_item<0>(P.wab, AOW, DM, (bf16*)(ws + WS_WAB), nullptr, scr, it - WI_WAB, lane);
        else if (it < WI_WUP2) p0_transpose_item<0>(P.wout, DM, DM, (bf16*)(ws + WS_WOUT), nullptr, scr, it - WI_WOUT, lane);
        else if (it < WI_WDN2) p0_transpose_item<1>(P.wup2, DM, FF2, (bf16*)(ws + WS_WUP2), P.n2, scr, it - WI_WUP2, lane);
        else p0_transpose_item<0>(P.wdn2, FF, DM, (bf16*)(ws + WS_WDN2), nullptr, scr, it - WI_WDN2, lane);
    }
}

__device__ __forceinline__ void p0_prologue(Frame& F, const Ptrs& P) {
    LAS float* scr = (LAS float*)(F.lds + RING_OFF + F.wave * 16384);
    const int gw = F.vcu * NWAVES + F.wave, NGW = F.G * NWAVES;
    unsigned char* ws = P.ws;
    for (int m0 = gw; m0 < M; m0 += 2 * NGW) {
        f32x4 v[2][4];
#pragma unroll
        for (int q = 0; q < 2; ++q) { const int m = m0 + q * NGW; if (m < M) {
            const float* xrow = (m < MP) ? P.xp + (size_t)m * DM : P.xs + (size_t)(m - MP) * DM; const GAS f32x4* xr = (const GAS f32x4*)xrow + F.lane;
#pragma unroll
            for (int j = 0; j < 4; ++j) v[q][j] = xr[64 * j]; } }
#pragma unroll
        for (int q = 0; q < 2; ++q) { const int m = m0 + q * NGW; if (m < M) {
            float s = 0.f;
#pragma unroll
            for (int j = 0; j < 4; ++j) s += (v[q][j].x * v[q][j].x + v[q][j].y * v[q][j].y) + (v[q][j].z * v[q][j].z + v[q][j].w * v[q][j].w);
            s = wave_sum(s);
            if (F.lane == 0) ((float*)(ws + WS_RSTD0))[m] = __builtin_amdgcn_rsqf(s * (1.0f / DM) + 1e-6f);
            GAS unsigned long long* o8 = (GAS unsigned long long*)((bf16*)(ws + WS_XB) + (size_t)m * DM) + F.lane;
#pragma unroll
            for (int j = 0; j < 4; ++j) o8[64 * j] = (unsigned long long)pk2(v[q][j].x, v[q][j].y) | ((unsigned long long)pk2(v[q][j].z, v[q][j].w) << 32); } }
    }
    convert_items(P, WI_WUP1, WI_WDN1, gw, NGW, scr, F.lane);
    for (int it = gw; it < 128 * 16; it += NGW) {
        const int kq = it >> 4, nb = it & 15, k = 4 * kq, g = k >> 7, kp = k & 127, n = nb * 64 + F.lane;
        const float* wgr = P.wg + ((size_t)g * 128 + kp) * 128; const float* sc = P.pscale + 128 * g; const float* wp = P.wpb + (size_t)(128 * g) * DM + n;
        float cf[4][2];
        { const float s0 = sc[F.lane], s1 = sc[F.lane + 64];
#pragma unroll
          for (int q = 0; q < 4; ++q) { cf[q][0] = wgr[q * 128 + F.lane] * s0; cf[q][1] = wgr[q * 128 + F.lane + 64] * s1; } }
        float a0 = 0.f, a1 = 0.f, a2 = 0.f, a3 = 0.f;
#pragma unroll
        for (int cb = 0; cb < 128; cb += 32) {
            float w[32];
#pragma unroll
            for (int c = 0; c < 32; ++c) w[c] = wp[(size_t)(cb + c) * DM];
#pragma unroll
            for (int c = 0; c < 32; ++c) { const int cc = cb + c, hh = cc >> 6, ln = cc & 63;
                a0 += __int_as_float(__builtin_amdgcn_readlane(__float_as_int(cf[0][hh]), ln)) * w[c]; a1 += __int_as_float(__builtin_amdgcn_readlane(__float_as_int(cf[1][hh]), ln)) * w[c];
                a2 += __int_as_float(__builtin_amdgcn_readlane(__float_as_int(cf[2][hh]), ln)) * w[c]; a3 += __int_as_float(__builtin_amdgcn_readlane(__float_as_int(cf[3][hh]), ln)) * w[c];
            }
        }
        *(GAS unsigned long long*)((bf16*)(ws + WS_WEFF) + (size_t)n * PW + k) = (unsigned long long)pk2(a0, a1) | ((unsigned long long)pk2(a2, a3) << 32);
    }
    if (blockIdx.x == 0) {
        for (int i = F.tid; i < 3 * 4 * 132; i += NWAVES * 64) { const int g = i / (4 * 132), h = (i / 132) & 3, j = i % 132;
            ((float*)(ws + WS_BIAS))[i] = (j <= 128) ? P.rbias[(int)T5B[g][j] * 12 + 4 * g + h] * 1.4426950408889634f : 0.f; }
    }
    for (long i = (long)F.vcu * (NWAVES * 64) + F.tid; i < (long)DBATCH * 7 * 128; i += (long)F.G * (NWAVES * 64)) {
        const long b = i / (7 * 128), r = i - b * (7 * 128);
        ((f32x4*)(P.out + O_POOLS + (size_t)b * 15 * 512))[r] = ((const f32x4*)(P.spool + ((size_t)b * 15 + 8) * 512))[r];
    }
}

typedef float f32x16 __attribute__((ext_vector_type(16)));
typedef short s16x4 __attribute__((ext_vector_type(4)));
typedef short v4i16_t __attribute__((ext_vector_type(4)));
__device__ __forceinline__ int crow(int r, int hi) { return (r & 3) + 8 * (r >> 2) + 4 * hi; }
__device__ __forceinline__ s16x4 vtr(const LAS unsigned char* p) { return __builtin_bit_cast(s16x4, __builtin_amdgcn_ds_read_tr16_b64_v4i16((LAS v4i16_t*)p)); }
__device__ __forceinline__ unsigned cvtpk(float lo, float hi) { typedef float f2 __attribute__((ext_vector_type(2))); typedef __bf16 b2 __attribute__((ext_vector_type(2))); f2 v = {lo, hi}; b2 b = __builtin_convertvector(v, b2); return __builtin_bit_cast(unsigned, b); }

constexpr int ATT_WLDS = 16384;
constexpr int TB_JMIN0 = -512, TB_N0 = 1140, TB_JMIN1 = -128, TB_N1 = 384, TB_JMIN2 = -32, TB_N2 = 192;
constexpr int TB_OFF0 = 0, TB_OFF1 = TB_N0, TB_OFF2 = TB_N0 + TB_N1, TB_TOTAL = TB_N0 + TB_N1 + TB_N2;
constexpr int ATT_TB_OFF = 4096, ATT_SC_OFF = 4096 + 7168;

struct AttnState { f32x16 o0, o1, lacc; float m; };

__device__ __forceinline__ void attn_build_tables(const float* BIAS, int h, LAS float* tb, int lane) {
#pragma unroll 1
    for (int i = lane; i < TB_TOTAL; i += 64) {
        int g, j;
        if (i < TB_OFF1) { g = 0; j = i + TB_JMIN0; } else if (i < TB_OFF2) { g = 1; j = i - TB_OFF1 + TB_JMIN1; } else { g = 2; j = i - TB_OFF2 + TB_JMIN2; }
        tb[i] = ((unsigned)j <= 128u) ? BIAS[(g * 4 + h) * 132 + j] : -INFINITY;
    }
    asm volatile("s_waitcnt lgkmcnt(0)" ::: "memory");
}

template <int G, bool PMASK> __device__ __forceinline__ void attn_group(AttnState& st, const bf16* __restrict__ Qb, const bf16* __restrict__ Kb, const bf16* __restrict__ Vb,
                                                            int b, int s, int h, int r, LAS unsigned char* wl, int lane_in) {
    int lane = lane_in;
    constexpr int D = 1 << (2 * G), E = 16 / D, NT = (G == 0) ? 20 : (G == 1) ? 8 : 5;
    constexpr int TOFF = (G == 0) ? TB_OFF0 : (G == 1) ? TB_OFF1 : TB_OFF2, TJMIN = (G == 0) ? TB_JMIN0 : (G == 1) ? TB_JMIN1 : TB_JMIN2;
    asm volatile("" : "+v"(lane));
    const int i = lane & 31, hi = lane >> 5;
    const int rg = r & (D - 1), cg = r >> (2 * G), P0 = (512 * s) >> (2 * G);
    const int p_i = P0 + E * i + cg, p_lo = P0 + cg - 128;
    const int pmax = (SEQ >> (2 * G)) - 1;
    const int col = (4 * G + h) * 64;
    const size_t rowb = (size_t)b * SEQ;
    bf16x8 qf[4];
    { const bf16* qp = Qb + (rowb + 512 * s + 16 * i + r) * AW + col + 32 * hi;
#pragma unroll
      for (int s4 = 0; s4 < 4; ++s4) qf[s4] = *(const bf16x8*)(qp + 8 * s4); }
    const LAS unsigned char* vb0 = wl + ((lane >> 4) & 1) * 32 + (lane & 3) * 8 + (4 * hi + ((lane & 15) >> 2)) * 64;
    const LAS float* tbg = (const LAS float*)(wl + ATT_TB_OFF) + TOFF - TJMIN - 27;
    constexpr float C2 = 0.125f * 1.4426950408889634f;
    const bf16x8 ones = {(short)0x3f80, (short)0x3f80, (short)0x3f80, (short)0x3f80, (short)0x3f80, (short)0x3f80, (short)0x3f80, (short)0x3f80};
    bf16x8 kf[4]; v4u vv[4];
#define ATT_LOAD_TILE(kt, kk, vw) do { \
        int p_ = p_lo + 32 * (kt) + i; p_ = p_ < 0 ? 0 : (p_ > pmax ? pmax : p_); \
        const bf16* kp_ = Kb + (rowb + (size_t)(D * p_ + rg)) * AW + col + 32 * hi; \
        _Pragma("unroll") for (int s4 = 0; s4 < 4; ++s4) kk[s4] = *(const bf16x8*)(kp_ + 8 * s4); \
        _Pragma("unroll") for (int kg = 0; kg < 2; ++kg) { int pv_ = p_lo + 32 * (kt) + 16 * kg + (lane >> 2); pv_ = pv_ < 0 ? 0 : (pv_ > pmax ? pmax : pv_); \
            const bf16* vp_ = Vb + (rowb + (size_t)(D * pv_ + rg)) * AW + col + 8 * (lane & 3); \
            vw[kg] = *(const v4u*)(vp_); vw[2 + kg] = *(const v4u*)(vp_ + 32); } } while (0)
    ATT_LOAD_TILE(0, kf, vv);
    for (int kt = 0; kt < NT; ++kt) {
        bf16x8 kn[4]; v4u vn[4];
        if (kt + 1 < NT) ATT_LOAD_TILE(kt + 1, kn, vn);
        f32x16 sa = {};
#pragma unroll
        for (int s4 = 0; s4 < 4; ++s4) sa = __builtin_amdgcn_mfma_f32_32x32x16_bf16(kf[s4], qf[s4], sa, 0, 0, 0);
#pragma unroll
        for (int pc = 0; pc < 4; ++pc) *(LAS v4u*)(wl + ((pc >> 1) * 2048 + (pc & 1) * 1024) + lane * 16) = vv[(pc >> 1) * 2 + (pc & 1)];
        const int J0 = E * i + 128 - 32 * kt - 4 * hi;
        const LAS float* tbp = tbg + J0;
        float mx = -INFINITY;
#pragma unroll
        for (int rho = 0; rho < 16; ++rho) {
            float v = sa[rho] * C2 + tbp[27 - ((rho & 3) + 8 * (rho >> 2))];
            if (PMASK) { const int j = J0 - ((rho & 3) + 8 * (rho >> 2)); v = (j > p_i) ? -INFINITY : v; }
            sa[rho] = v; mx = fmaxf(mx, v);
        }
        mx = fmaxf(mx, __shfl_xor(mx, 32));
        if (__any(mx > st.m + 6.0f)) {
            const float mn = fmaxf(st.m, mx), f = __builtin_amdgcn_exp2f(st.m - mn);
            st.m = mn;
            LAS float* wsf = (LAS float*)(wl + ATT_SC_OFF);
            if (hi == 0) wsf[i] = f;
            asm volatile("s_waitcnt lgkmcnt(0)" ::: "memory");
#pragma unroll
            for (int rho = 0; rho < 16; ++rho) { const float ff = wsf[crow(rho, hi)]; st.o0[rho] *= ff; st.o1[rho] *= ff; st.lacc[rho] *= ff; }
        }
#pragma unroll
        for (int rho = 0; rho < 16; ++rho) sa[rho] = __builtin_amdgcn_exp2f(sa[rho] - st.m);
        v4u pw0, pw1;
        pw0.x = cvtpk(sa[0], sa[1]); pw0.y = cvtpk(sa[2], sa[3]); pw0.z = cvtpk(sa[4], sa[5]); pw0.w = cvtpk(sa[6], sa[7]);
        pw1.x = cvtpk(sa[8], sa[9]); pw1.y = cvtpk(sa[10], sa[11]); pw1.z = cvtpk(sa[12], sa[13]); pw1.w = cvtpk(sa[14], sa[15]);
        asm volatile("s_waitcnt lgkmcnt(0)" ::: "memory");
        st.lacc = __builtin_amdgcn_mfma_f32_32x32x16_bf16(__builtin_bit_cast(bf16x8, pw0), ones, st.lacc, 0, 0, 0);
        st.lacc = __builtin_amdgcn_mfma_f32_32x32x16_bf16(__builtin_bit_cast(bf16x8, pw1), ones, st.lacc, 0, 0, 0);
#pragma unroll
        for (int dh = 0; dh < 2; ++dh) {
#pragma unroll
            for (int ks = 0; ks < 2; ++ks) {
                const s16x4 lo = vtr(vb0 + dh * 2048 + ks * 1024), hh = vtr(vb0 + dh * 2048 + ks * 1024 + 512);
                const bf16x8 vf = {lo[0], lo[1], lo[2], lo[3], hh[0], hh[1], hh[2], hh[3]};
                const bf16x8 pf = __builtin_bit_cast(bf16x8, ks == 0 ? pw0 : pw1);
                if (dh == 0) st.o0 = __builtin_amdgcn_mfma_f32_32x32x16_bf16(pf, vf, st.o0, 0, 0, 0);
                else         st.o1 = __builtin_amdgcn_mfma_f32_32x32x16_bf16(pf, vf, st.o1, 0, 0, 0);
            }
        }
        asm volatile("" ::: "memory");
        if (kt + 1 < NT) {
#pragma unroll
            for (int q = 0; q < 4; ++q) { kf[q] = kn[q]; vv[q] = vn[q]; }
        }
    }
#undef ATT_LOAD_TILE
}

__device__ __forceinline__ void attn_prompt_unit(int unit, const bf16* Qb, const bf16* Kb, const bf16* Vb, bf16* AA, LAS unsigned char* wl, int lane) {
    const int r = unit & 15, h = (unit >> 4) & 3, s = (unit >> 6) & 7, b = unit >> 9;
    AttnState st; st.o0 = f32x16{}; st.o1 = f32x16{}; st.lacc = f32x16{}; st.m = -30000.0f;
    if (s < 4) attn_group<2, true>(st, Qb, Kb, Vb, b, s, h, r, wl, lane); else attn_group<2, false>(st, Qb, Kb, Vb, b, s, h, r, wl, lane);
    if (s == 0) { attn_group<1, true>(st, Qb, Kb, Vb, b, s, h, r, wl, lane); attn_group<0, true>(st, Qb, Kb, Vb, b, s, h, r, wl, lane); }
    else        { attn_group<1, false>(st, Qb, Kb, Vb, b, s, h, r, wl, lane); attn_group<0, false>(st, Qb, Kb, Vb, b, s, h, r, wl, lane); }
    const int i = lane & 31, hi = lane >> 5;
#pragma unroll
    for (int rho = 0; rho < 16; ++rho) {
        const int qi = crow(rho, hi); const float ff = __builtin_amdgcn_rcpf(st.lacc[rho]);
        bf16* op = AA + ((size_t)b * SEQ + 512 * s + 16 * qi + r) * AOW + h * 64 + i;
        op[0] = (bf16)f2bf(st.o0[rho] * ff); op[32] = (bf16)f2bf(st.o1[rho] * ff);
    }
}

__device__ __forceinline__ float red16(float x) {
    x += __int_as_float(__builtin_amdgcn_update_dpp(0, __float_as_int(x), 0xB1, 0xf, 0xf, true));
    x += __int_as_float(__builtin_amdgcn_update_dpp(0, __float_as_int(x), 0x4E, 0xf, 0xf, true));
    x += __int_as_float(__builtin_amdgcn_update_dpp(0, __float_as_int(x), 0x141, 0xf, 0xf, true));
    x += __int_as_float(__builtin_amdgcn_update_dpp(0, __float_as_int(x), 0x140, 0xf, 0xf, true));
    return x;
}
struct SampleState { float m, l; f32x4 o; };
template <int G> __device__ __forceinline__ void attn_sample_group(SampleState& st, const float* cache, const float* outw, const LAS float* qs, const float* biasg, int b, int h, int t, int lane) {
    constexpr int D = 1 << (2 * G), WIN = 128 << (2 * G);
    const int kq = lane >> 4, d4 = (lane & 15) * 4;
    const f32x4 qv = *(const LAS f32x4*)(qs + G * 64 + d4);
    const unsigned long long cb = (unsigned long long)(cache + ((size_t)b * WIN * 512 + h * 64 + d4));
    const unsigned long long ob = (unsigned long long)(outw + ((size_t)b * WIN * 512 + h * 64 + d4)) - 8ull * 2048ull;
#define SMP_LOAD(bt_, kv_, vv_) do { _Pragma("unroll") for (int q = 0; q < 11; ++q) { int j_ = 44 * (bt_) + 4 * q + kq; j_ = j_ > 128 ? 128 : j_; const int idx_ = WIN + t - D * j_; \
            const unsigned long long a_ = ((idx_ >= WIN) ? ob : cb) + (unsigned long long)idx_ * 2048ull; kv_[q] = *(const f32x4*)a_; vv_[q] = *(const f32x4*)(a_ + 1024ull); } } while (0)
#define SMP_CONSUME(bt_, kv_, vv_) do { float sv[11]; float bm = -INFINITY; \
        _Pragma("unroll") for (int q = 0; q < 11; ++q) { const int j0 = 44 * (bt_) + 4 * q + kq; const int j = j0 > 128 ? 128 : j0; \
            float dt = (kv_[q][0] * qv[0] + kv_[q][1] * qv[1]) + (kv_[q][2] * qv[2] + kv_[q][3] * qv[3]); dt = red16(dt) + biasg[j]; \
            sv[q] = (j0 <= 128) ? dt : -INFINITY; bm = fmaxf(bm, sv[q]); } \
        bm = fmaxf(bm, __shfl_xor(bm, 16)); bm = fmaxf(bm, __shfl_xor(bm, 32)); \
        const float mn = fmaxf(st.m, bm), f = __builtin_amdgcn_exp2f(st.m - mn); st.m = mn; st.l *= f; st.o = st.o * f; \
        _Pragma("unroll") for (int q = 0; q < 11; ++q) { const float p = __builtin_amdgcn_exp2f(sv[q] - st.m); st.l += p; st.o += vv_[q] * p; } } while (0)
    f32x4 ka[11], va[11], kb[11], vb[11];
    SMP_LOAD(0, ka, va); SMP_LOAD(1, kb, vb);
    SMP_CONSUME(0, ka, va); SMP_LOAD(2, ka, va);
    SMP_CONSUME(1, kb, vb);
    SMP_CONSUME(2, ka, va);
#undef SMP_LOAD
#undef SMP_CONSUME
}
__device__ __forceinline__ void attn_sample_unit(int su, const Ptrs& P, const bf16* Qb, bf16* AA, const float* biasG, LAS unsigned char* wl, int lane) {
    const int t = su & 7, h = (su >> 3) & 3, b = su >> 5;
    LAS float* qs = (LAS float*)(wl + ATT_SC_OFF);
    const size_t qrow = (size_t)(MP + b * 8 + t) * AW;
#pragma unroll
    for (int g = 0; g < 3; ++g) qs[g * 64 + lane] = __uint_as_float((unsigned)Qb[qrow + (4 * g + h) * 64 + lane] << 16) * (0.125f * 1.4426950408889634f);
    asm volatile("s_waitcnt lgkmcnt(0)" ::: "memory");
    SampleState st; st.m = -30000.0f; st.l = 0.f; st.o = (f32x4){0.f, 0.f, 0.f, 0.f};
    attn_sample_group<2>(st, P.c2048, P.out + O_KV2048S, qs, biasG + (8 + h) * 132, b, h, t, lane);
    attn_sample_group<1>(st, P.c512, P.out + O_KV512S, qs, biasG + (4 + h) * 132, b, h, t, lane);
    attn_sample_group<0>(st, P.c128, P.out + O_KV128S, qs, biasG + (0 + h) * 132, b, h, t, lane);
    float l = st.l; f32x4 o = st.o;
    l += __shfl_xor(l, 16); l += __shfl_xor(l, 32);
#pragma unroll
    for (int e = 0; e < 4; ++e) { o[e] += __shfl_xor(o[e], 16); o[e] += __shfl_xor(o[e], 32); }
    const int d4 = (lane & 15) * 4;
    if (lane < 16) { const float inv = 1.0f / l;
        *(GAS unsigned long long*)(AA + (size_t)(MP + b * 8 + t) * AOW + h * 64 + d4) = (unsigned long long)pk2(o[0] * inv, o[1] * inv) | ((unsigned long long)pk2(o[2] * inv, o[3] * inv) << 32); }
    asm volatile("s_waitcnt lgkmcnt(0)" ::: "memory");
}

struct CopyLoc { const f32x4* s; f32x4* d; };
constexpr int CC_B2 = 510, CC_B1 = 126, CC_B0 = 30, CC_N2 = 32 * CC_B2, CC_N1 = 32 * CC_B1, CC_N0 = 32 * CC_B0, CC_N = CC_N2 + CC_N1 + CC_N0;
__device__ __forceinline__ CopyLoc copy_locate(const Ptrs& P, int id) {
    CopyLoc L;
    if (id < CC_N2) { const int b = id / CC_B2, k = id - b * CC_B2; L.s = (const f32x4*)(P.c2048 + ((size_t)b * 2048 + 8) * 512) + k * 512; L.d = (f32x4*)(P.out + O_KV2048S + (size_t)b * 2048 * 512) + k * 512; return L; }
    id -= CC_N2;
    if (id < CC_N1) { const int b = id / CC_B1, k = id - b * CC_B1; L.s = (const f32x4*)(P.c512 + ((size_t)b * 512 + 8) * 512) + k * 512; L.d = (f32x4*)(P.out + O_KV512S + (size_t)b * 512 * 512) + k * 512; return L; }
    id -= CC_N1;
    { const int b = id / CC_B0, k = id - b * CC_B0; L.s = (const f32x4*)(P.c128 + ((size_t)b * 128 + 8) * 512) + k * 512; L.d = (f32x4*)(P.out + O_KV128S + (size_t)b * 128 * 512) + k * 512; return L; }
}
__device__ __forceinline__ void copy_chunks(const Ptrs& P, int mw, int NMW, int lane) {
    f32x4 va[8], vb[8];
    int id = mw;
    if (id < CC_N) { const CopyLoc L = copy_locate(P, id);
#pragma unroll
        for (int q = 0; q < 8; ++q) va[q] = __builtin_nontemporal_load(L.s + q * 64 + lane); }
    for (; id < CC_N; id += 2 * NMW) {
        const int id2 = id + NMW, id3 = id + 2 * NMW;
        if (id2 < CC_N) { const CopyLoc L = copy_locate(P, id2);
#pragma unroll
            for (int q = 0; q < 8; ++q) vb[q] = __builtin_nontemporal_load(L.s + q * 64 + lane); }
        { const CopyLoc L = copy_locate(P, id);
#pragma unroll
            for (int q = 0; q < 8; ++q) __builtin_nontemporal_store(va[q], L.d + q * 64 + lane); }
        if (id3 < CC_N) { const CopyLoc L = copy_locate(P, id3);
#pragma unroll
            for (int q = 0; q < 8; ++q) va[q] = __builtin_nontemporal_load(L.s + q * 64 + lane); }
        if (id2 < CC_N) { const CopyLoc L = copy_locate(P, id2);
#pragma unroll
            for (int q = 0; q < 8; ++q) __builtin_nontemporal_store(vb[q], L.d + q * 64 + lane); }
    }
}

template <int W> __device__ __forceinline__ void pool_block(const float* __restrict__ U, bf16* __restrict__ DD, int rb, int gi, int lane) {
    const int r0 = 16 * rb + 8 * (lane >> 5), c4 = gi * 128 + (lane & 31) * 4, t0 = r0 & (SEQ - 1);
    f32x4 v[W + 7];
#pragma unroll
    for (int i = 0; i < W + 7; ++i) { const int dt = i - (W - 1); const int ri = (t0 + dt >= 0) ? r0 + dt : r0; v[i] = *(const f32x4*)(U + (size_t)ri * PW + c4); }
#pragma unroll
    for (int i = 0; i < W - 1; ++i) { if (t0 + i - (W - 1) < 0) v[i] = (f32x4){0.f, 0.f, 0.f, 0.f}; }
    f32x4 s = v[0];
#pragma unroll
    for (int i = 1; i < W; ++i) s += v[i];
#pragma unroll
    for (int o = 0; o < 8; ++o) {
        if (o > 0) s += v[W - 1 + o] - v[o - 1];
        const int t = t0 + o; const float inv = 1.0f / (float)((t + 1 < W) ? t + 1 : W); const f32x4 dd = s * inv - v[W - 1 + o];
        *(GAS unsigned long long*)(DD + (size_t)(r0 + o) * PW + c4) = (unsigned long long)pk2(dd[0], dd[1]) | ((unsigned long long)pk2(dd[2], dd[3]) << 32);
    }
}
__device__ __forceinline__ void pool_items(const Ptrs& P, const float* U, bf16* DD, int mw, int NMW, int lane) {
    for (int it = mw; it < (MP / 16) * 4; it += NMW) {
        const int gi = it & 3, rb = it >> 2;
        if (gi == 0) pool_block<2>(U, DD, rb, 0, lane); else if (gi == 1) pool_block<4>(U, DD, rb, 1, lane); else if (gi == 2) pool_block<8>(U, DD, rb, 2, lane); else pool_block<16>(U, DD, rb, 3, lane);
    }
    for (int it = mw * 64 + lane; it < MS * 128; it += NMW * 64) {
        const int sidx = it >> 7, row = MP + sidx, c4 = (it & 127) * 4, w = 2 << (c4 >> 7), b = sidx >> 3, t = sidx & 7;
        f32x4 s = {0.f, 0.f, 0.f, 0.f};
        const f32x4 own = *(const f32x4*)(U + (size_t)row * PW + c4);
        for (int i = 0; i < w; ++i) { const int idx = 15 + t - i;
            s += (idx >= 15) ? *(const f32x4*)(U + (size_t)(MP + b * 8 + idx - 15) * PW + c4) : *(const f32x4*)(P.spool + ((size_t)b * 15 + idx) * PW + c4); }
        const float inv = 1.0f / (float)w; const f32x4 dd = s * inv - own;
        *(GAS unsigned long long*)(DD + (size_t)row * PW + c4) = (unsigned long long)pk2(dd[0], dd[1]) | ((unsigned long long)pk2(dd[2], dd[3]) << 32);
    }
}


template <int KS  > __device__ __forceinline__ void micro_partial(const pg8::bf16_t* A, const pg8::bf16_t* Bt, int row0, int col0, int wave, int lane, f32x4 (&acc)[4]) {
    constexpr int K = KS * 8, NS = KS / 32, NB = (NS > 4) ? 4 : NS;
    const int fr = lane & 15, fq = lane >> 4;
    const pg8::bf16_t* ap = A + (size_t)(row0 + fr) * K + wave * KS + 8 * fq;
    const pg8::bf16_t* bp = Bt + (size_t)(col0 + fr) * K + wave * KS + 8 * fq;
#pragma unroll
    for (int k0 = 0; k0 < NS; k0 += NB) {
        bf16x8 af[NB], bf[NB][4];
#pragma unroll
        for (int s = 0; s < NB; ++s) if (k0 + s < NS) { af[s] = *(const bf16x8*)(ap + (k0 + s) * 32);
#pragma unroll
            for (int nb = 0; nb < 4; ++nb) bf[s][nb] = *(const bf16x8*)(bp + (size_t)(16 * nb) * K + (k0 + s) * 32); }
#pragma unroll
        for (int s = 0; s < NB; ++s) if (k0 + s < NS) {
#pragma unroll
            for (int nb = 0; nb < 4; ++nb) acc[nb] = __builtin_amdgcn_mfma_f32_16x16x32_bf16(bf[s][nb], af[s], acc[nb], 0, 0, 0); }
    }
}
typedef float f32x2 __attribute__((ext_vector_type(2)));
__device__ __forceinline__ f32x2 micro_reduce(LAS unsigned char* red, const f32x4 (&acc)[4], int wave, int lane, int tid) {
    const int fr = lane & 15, fq = lane >> 4;
    LAS float* pw = (LAS float*)red + wave * 1024 + fr * 64 + 4 * fq;
#pragma unroll
    for (int nb = 0; nb < 4; ++nb) *(LAS f32x4*)(pw + 16 * nb) = acc[nb];
    __syncthreads();
    const LAS float* pr = (const LAS float*)red + (tid >> 5) * 64 + 2 * (tid & 31);
    f32x2 s = {0.f, 0.f};
#pragma unroll
    for (int w = 0; w < 8; ++w) s += *(const LAS f32x2*)(pr + w * 1024);
    __syncthreads();
    return s;
}
template <int MODE, int K> __device__ __forceinline__ void micro_resid(LAS unsigned char* red, int blk, const pg8::bf16_t* A, const pg8::bf16_t* Bt, pg8::bf16_t* XB, float* ssp, float* out) {
    int tid_ = threadIdx.x; asm volatile("" : "+v"(tid_));
    const int tid = tid_, lane = tid & 63, wave = __builtin_amdgcn_readfirstlane(tid >> 6);
    const int row0 = MP + 16 * (blk >> 4), col0 = 64 * (blk & 15);
    f32x4 acc[4] = {};
    micro_partial<K / 8>(A, Bt, row0, col0, wave, lane, acc);
    const f32x2 s = micro_reduce(red, acc, wave, lane, tid);
    const int row = row0 + (tid >> 5), col = col0 + 2 * (tid & 31);
    const float alpha = (MODE == 1) ? 1.0f : 0.5f;
    const unsigned xw = *(const unsigned*)(XB + (size_t)row * DM + col);
    f32x2 v; v[0] = __uint_as_float(xw << 16) + s[0] * alpha; v[1] = __uint_as_float(xw & 0xffff0000u) + s[1] * alpha;
    if (MODE == 2) { *(f32x2*)(out + (size_t)row * DM + col) = v; }
    else {
        *(unsigned*)(XB + (size_t)row * DM + col) = pk2(v[0], v[1]);
        float ss = v[0] * v[0] + v[1] * v[1];
#pragma unroll
        for (int o = 1; o < 32; o <<= 1) ss += __shfl_xor(ss, o);
        if ((tid & 31) == 0) ssp[(size_t)row * 16 + (blk & 15)] = ss;
    }
}
__device__ __forceinline__ void micro_merge(LAS unsigned char* red, int blk, const pg8::bf16_t* AA, const pg8::bf16_t* WAB, const pg8::bf16_t* DD, const pg8::bf16_t* WEFF,
                                            const pg8::bf16_t* GA, const pg8::bf16_t* GB, pg8::bf16_t* MG) {
    int tid_ = threadIdx.x; asm volatile("" : "+v"(tid_));
    const int tid = tid_, lane = tid & 63, wave = __builtin_amdgcn_readfirstlane(tid >> 6);
    const int row0 = MP + 16 * (blk >> 4), col0 = 64 * (blk & 15);
    f32x4 acc[4] = {};
    micro_partial<AOW / 8>(AA, WAB, row0, col0, wave, lane, acc);
    const f32x2 s1 = micro_reduce(red, acc, wave, lane, tid);
#pragma unroll
    for (int nb = 0; nb < 4; ++nb) acc[nb] = (f32x4){0.f, 0.f, 0.f, 0.f};
    micro_partial<PW / 8>(DD, WEFF, row0, col0, wave, lane, acc);
    const f32x2 s2 = micro_reduce(red, acc, wave, lane, tid);
    const int row = row0 + (tid >> 5), col = col0 + 2 * (tid & 31);
    const unsigned ga = *(const unsigned*)(GA + (size_t)row * DM + col), gb = *(const unsigned*)(GB + (size_t)row * DM + col);
    const float m0 = __uint_as_float(ga << 16) * s1[0] + __uint_as_float(gb << 16) * s2[0];
    const float m1 = __uint_as_float(ga & 0xffff0000u) * s1[1] + __uint_as_float(gb & 0xffff0000u) * s2[1];
    *(unsigned*)(MG + (size_t)row * DM + col) = pk2(m0, m1);
}

#ifndef PROBE_AMP
#define PROBE_AMP -1
#endif
struct Args { Ptrs p; };
__global__ void __launch_bounds__(NWAVES * 64, 2) hybrid_fwd(Args args) {
    extern __shared__ __attribute__((aligned(16))) unsigned char lds[];
    Frame F;
    F.lds = (LAS unsigned char*)lds;
    F.MISC = (volatile LAS unsigned*)(F.lds + MISC_OFF);
    F.tid = threadIdx.x; F.lane = F.tid & 63; F.wave = __builtin_amdgcn_readfirstlane(F.tid >> 6);
    F.G = gridDim.x; { const int bx = blockIdx.x; F.vcu = (F.G % 8 == 0) ? (bx % 8) * (F.G / 8) + bx / 8 : bx; }
    const Ptrs& P = args.p;
    unsigned char* ws = P.ws;
    F.ctl = (gu32*)(ws + WS_CTL);
    for (int u = F.tid; u < (LDS_BYTES - LDSCTL_OFF) / 4; u += NWAVES * 64) ((LAS unsigned*)(F.lds + LDSCTL_OFF))[u] = 0u;
    __syncthreads();
    XcdBarrier bar = xcd_barrier_post((unsigned*)(F.ctl + CW_BAR), F.MISC + 8);
#define GRID_BAR() xcd_barrier(bar)
    unsigned long long tph_ = 0;
#define PH_BEGIN() do { if (PROBE_AMP >= 0) tph_ = __builtin_amdgcn_s_memrealtime(); } while (0)
#define PH_END(k) do { if (PROBE_AMP >= 0) { const unsigned long long tn_ = __builtin_amdgcn_s_memrealtime(); if (PROBE_AMP == (k)) { while (__builtin_amdgcn_s_memrealtime() < tn_ + 2 * (tn_ - tph_)) __builtin_amdgcn_s_sleep(8); } tph_ = __builtin_amdgcn_s_memrealtime(); } } while (0)
#define WSP(T, off) ((T*)(ws + (off)))
    typedef pg8::bf16_t b16;
    const int c = (int)blockIdx.x;

    PH_BEGIN();
    p0_prologue(F, P);
    GRID_BAR();
    PH_END(0);
    {   pg8::Gemm g{WSP(b16, WS_XB), WSP(b16, WS_WUP1), M, FF2, DM}; pg8::StaticOrder S; S.init(M, FF2, F.G, c);
        pg8::EpiSwiglu<false> E{WSP(b16, WS_R), WSP(float, WS_RSTD0)};
        pg8::gemm_phase<pg8::EpiSwiglu<false>, pg8::StaticOrder, true, true>(F.lds + RING_OFF, g, S, E);
        {   const int nwg = (M / 256) * (FF2 / 256), R = (nwg + F.G - 1) / F.G, nfull = nwg - (R - 1) * F.G, nh = F.G - nfull;
            int th_ = threadIdx.x; asm volatile("" : "+v"(th_)); const int laneh = th_ & 63, waveh = __builtin_amdgcn_readfirstlane(th_ >> 6);
            LAS float* scr = (LAS float*)(F.lds + RING_OFF + waveh * 16384);
            if (nh == 0) convert_items(P, WI_WDN1, WI_WAB, c * NWAVES + waveh, F.G * NWAVES, scr, laneh);
            else if (c >= nfull) convert_items(P, WI_WDN1, WI_WAB, (c - nfull) * NWAVES + waveh, nh * NWAVES, scr, laneh); } }
    GRID_BAR();
    PH_END(1);
    {   pg8::Gemm g{WSP(b16, WS_R), WSP(b16, WS_WDN1), MP, DM, FF}; pg8::StaticOrder S; S.init(MP, DM, F.G, c);
        pg8::EpiResid<0> E{WSP(b16, WS_XB), WSP(float, WS_SSP1), nullptr};
        pg8::gemm_phase<pg8::EpiResid<0>, pg8::StaticOrder, true, true>(F.lds + RING_OFF, g, S, E);
        for (int blk = c; blk < 256; blk += F.G) micro_resid<0, FF>(F.lds + RING_OFF, blk, WSP(b16, WS_R), WSP(b16, WS_WDN1), WSP(b16, WS_XB), WSP(float, WS_SSP1), nullptr); }
    GRID_BAR();
    PH_END(2);
    {   pg8::Gemm g{WSP(b16, WS_XB), WSP(b16, WS_WIN), M, INW, DM}; pg8::StaticOrder S; S.init(M, INW, F.G, c);
        pg8::EpiIn E{WSP(float, WS_SSP1), WSP(b16, WS_Q), WSP(b16, WS_K), WSP(b16, WS_V), WSP(float, WS_U), WSP(b16, WS_GA), WSP(b16, WS_GB), P.qn, P.kn, P.out};
        pg8::gemm_phase<pg8::EpiIn, pg8::StaticOrder, true, true>(F.lds + RING_OFF, g, S, E); }
    GRID_BAR();
    PH_END(3);
    {   int tid_ = threadIdx.x; asm volatile("" : "+v"(tid_));
        const int lane = tid_ & 63, wave = __builtin_amdgcn_readfirstlane(tid_ >> 6);
        const unsigned long long tq0_ = (PROBE_AMP >= 40) ? __builtin_amdgcn_s_memrealtime() : 0ull;
#define SUBAMP(k) do { if (PROBE_AMP == (k)) { const unsigned long long tq1_ = __builtin_amdgcn_s_memrealtime(); while (__builtin_amdgcn_s_memrealtime() < tq1_ + 2 * (tq1_ - tq0_)) __builtin_amdgcn_s_sleep(8); } } while (0)
        if (wave < 4) {
            const int cw = F.vcu * 4 + wave, NCW = F.G * 4;
            LAS unsigned char* wl = F.lds + RING_OFF + wave * ATT_WLDS;
            const bf16* Qb = WSP(const bf16, WS_Q); const bf16* Kb = WSP(const bf16, WS_K); const bf16* Vb = WSP(const bf16, WS_V); bf16* AA = WSP(bf16, WS_AA);
            const float* BIAS = WSP(const float, WS_BIAS);
            for (int su = cw; su < DBATCH * 4 * DSEQ; su += NCW) attn_sample_unit(su, P, Qb, AA, BIAS, wl, lane);
            SUBAMP(42);
            for (int up = cw; up < NBATCH * 8 * 4 * 8; up += NCW) {
                const int unit0 = ((up >> 3) << 4) + (up & 7);
                attn_build_tables(BIAS, (unit0 >> 4) & 3, (LAS float*)(wl + ATT_TB_OFF), lane);
#pragma unroll 1
                for (int k2 = 0; k2 < 2; ++k2) attn_prompt_unit(unit0 + 8 * k2, Qb, Kb, Vb, AA, wl, lane);
            }
            SUBAMP(40);
        } else {
            const int mw = F.vcu * 4 + (wave - 4), NMW = F.G * 4;
            copy_chunks(P, mw, NMW, lane);
            SUBAMP(43);
            pool_items(P, WSP(const float, WS_U), WSP(bf16, WS_DD), mw, NMW, lane);
            convert_items(P, WI_WAB, WI_END, mw, NMW, (LAS float*)(F.lds + RING_OFF + wave * 16384), lane);
            SUBAMP(41);
        }
    }
    GRID_BAR();
    PH_END(4);
    {   pg8::StaticOrder S; S.init(MP, DM, F.G, c);
        {   pg8::Gemm g{WSP(b16, WS_AA), WSP(b16, WS_WAB), MP, DM, AOW}; pg8::EpiMerge<0> E{WSP(b16, WS_GA), WSP(b16, WS_T), WSP(b16, WS_MG)};
            pg8::gemm_phase<pg8::EpiMerge<0>, pg8::StaticOrder, true, true>(F.lds + RING_OFF, g, S, E); }
        {   pg8::Gemm g{WSP(b16, WS_DD), WSP(b16, WS_WEFF), MP, DM, PW}; pg8::EpiMerge<1> E{WSP(b16, WS_GB), WSP(b16, WS_T), WSP(b16, WS_MG)};
            pg8::gemm_phase<pg8::EpiMerge<1>, pg8::StaticOrder, true, true>(F.lds + RING_OFF, g, S, E); }
        for (int blk = c; blk < 256; blk += F.G) micro_merge(F.lds + RING_OFF, blk, WSP(b16, WS_AA), WSP(b16, WS_WAB), WSP(b16, WS_DD), WSP(b16, WS_WEFF), WSP(b16, WS_GA), WSP(b16, WS_GB), WSP(b16, WS_MG));
    }
    GRID_BAR();
    PH_END(5);
    {   pg8::Gemm g{WSP(b16, WS_MG), WSP(b16, WS_WOUT), MP, DM, DM}; pg8::StaticOrder S; S.init(MP, DM, F.G, c);
        pg8::EpiResid<1> E{WSP(b16, WS_XB), WSP(float, WS_SSP2), nullptr};
        pg8::gemm_phase<pg8::EpiResid<1>, pg8::StaticOrder, true, true>(F.lds + RING_OFF, g, S, E);
        for (int blk = c; blk < 256; blk += F.G) micro_resid<1, DM>(F.lds + RING_OFF, blk, WSP(b16, WS_MG), WSP(b16, WS_WOUT), WSP(b16, WS_XB), WSP(float, WS_SSP2), nullptr); }
    GRID_BAR();
    PH_END(6);
    {   pg8::Gemm g{WSP(b16, WS_XB), WSP(b16, WS_WUP2), M, FF2, DM}; pg8::StaticOrder S; S.init(M, FF2, F.G, c);
        pg8::EpiSwiglu<true> E{WSP(b16, WS_R), WSP(float, WS_SSP2)};
        pg8::gemm_phase<pg8::EpiSwiglu<true>, pg8::StaticOrder, true, true>(F.lds + RING_OFF, g, S, E); }
    GRID_BAR();
    PH_END(7);
    {   pg8::Gemm g{WSP(b16, WS_R), WSP(b16, WS_WDN2), MP, DM, FF}; pg8::StaticOrder S; S.init(MP, DM, F.G, c);
        pg8::EpiResid<2> E{WSP(b16, WS_XB), nullptr, P.out};
        pg8::gemm_phase<pg8::EpiResid<2>, pg8::StaticOrder, true, true>(F.lds + RING_OFF, g, S, E);
        for (int blk = c; blk < 256; blk += F.G) micro_resid<2, FF>(F.lds + RING_OFF, blk, WSP(b16, WS_R), WSP(b16, WS_WDN2), WSP(b16, WS_XB), nullptr, P.out); }
    PH_END(8);
}

extern "C" void kernel_launch(void* const* d_in, const int* in_sizes, int n_in, void* d_out, int out_size, void* d_ws, size_t ws_size, hipStream_t stream) {
    static int grid = 0;
    if (grid == 0) {
        if (n_in != 22 || (size_t)out_size != O_END || ws_size < WS_END) { fprintf(stderr, "kernel_launch: unexpected shapes (n_in %d, out %d, ws %zu); nothing launched\n", n_in, out_size, ws_size); grid = -1; return; }
        int dev = 0, cus = 0;
        if (hipGetDevice(&dev) != hipSuccess || hipDeviceGetAttribute(&cus, hipDeviceAttributeMultiprocessorCount, dev) != hipSuccess) { grid = -1; return; }
        if (hipFuncSetAttribute((const void*)hybrid_fwd, hipFuncAttributeMaxDynamicSharedMemorySize, LDS_BYTES) != hipSuccess) { fprintf(stderr, "kernel_launch: hipFuncSetAttribute failed\n"); grid = -1; return; }
        (void)hipGetLastError();
        grid = cus;
    }
    if (grid < 0) return;
    if (hipMemsetAsync((char*)d_ws + WS_CTL, 0, CTL_ZERO_BYTES, stream) != hipSuccess) return;
    Args a{};
    const float** pp = (const float**)&a.p;
    for (int i = 0; i < 22; ++i) pp[i] = (const float*)d_in[i];
    a.p.out = (float*)d_out; a.p.ws = (unsigned char*)d_ws;
    hipLaunchKernelGGL(hybrid_fwd, dim3(grid), dim3(NWAVES * 64), LDS_BYTES, stream, a);
}
```

```cpp
#include <hip/hip_runtime.h>
#include <cstdio>
#include <cstdint>

namespace pg8 {
#define PG8_LAS __attribute__((address_space(3)))
typedef unsigned short bf16_t;
typedef short bf16x8 __attribute__((ext_vector_type(8)));
typedef float f32x4 __attribute__((ext_vector_type(4)));
typedef unsigned u32x4 __attribute__((ext_vector_type(4)));
constexpr int BM = 256, BK = 64, HALF = 128, HTB = HALF * BK * 2  , STAGE_BYTES = 8 * HTB, NXCD = 8, WGM = 8;

__host__ __device__ __forceinline__ int lds_byte(int r, int c) { const int st = (r >> 4) * 2 + (c >> 5), rr = r & 15, cc = c & 31, ob = rr * 64 + cc * 2; return st * 1024 + (ob ^ (((ob >> 9) & 1) << 5)); }
__host__ __device__ __forceinline__ void stage_rc(int b, int& R, int& C) { const int st = b / 1024, sb = b % 1024, swz = sb ^ (((sb >> 9) & 1) << 5); R = (st >> 1) * 16 + swz / 64; C = (st & 1) * 32 + (swz % 64) / 2; }
__host__ __device__ __forceinline__ int perm32(int rho) { const int n = rho >> 4, i = rho & 15; return 8 * (i >> 2) + 4 * n + (i & 3); }

struct Unit { int pm, pn; };
struct Gemm { const bf16_t* A; const bf16_t* Bt; int M, N, K; };

struct StaticOrder {
    int nM, nN, nwg, G, c;
    __host__ __device__ void init(int M, int N, int G_, int c_) { nM = M / BM; nN = N / BM; nwg = nM * nN; G = G_; c = c_; }
    __host__ __device__ bool next(int i, Unit& u) const {
        const long L = (long)i * G + c; if (L >= nwg) return false;
        int wgid = (int)L; { const int q = nwg / NXCD, r = nwg % NXCD, xcd = wgid % NXCD, off = wgid / NXCD; wgid = (xcd < r ? xcd * (q + 1) : r * (q + 1) + (xcd - r) * q) + off; }
        const int nig = WGM * nN, gid = wgid / nig, fm = gid * WGM, gsz = (nM - fm) < WGM ? (nM - fm) : WGM;
        u.pm = fm + ((wgid % nig) % gsz); u.pn = (wgid % nig) / gsz; return true;
    }
    __device__ __forceinline__ void a_ready(const Unit&) const {}
    __device__ __forceinline__ void done(const Unit&) const {}
};


typedef float f32x2 __attribute__((ext_vector_type(2)));
typedef __bf16 bf16x2_t __attribute__((ext_vector_type(2)));
__device__ __forceinline__ unsigned cvt_pk_bf16(float lo, float hi) { f32x2 v = {lo, hi}; bf16x2_t b = __builtin_convertvector(v, bf16x2_t); return __builtin_bit_cast(unsigned, b); }
__device__ __forceinline__ u32x4 pack8(const f32x4 a, const f32x4 b) { u32x4 w; w.x = cvt_pk_bf16(a[0], a[1]); w.y = cvt_pk_bf16(a[2], a[3]); w.z = cvt_pk_bf16(b[0], b[1]); w.w = cvt_pk_bf16(b[2], b[3]); return w; }
__device__ __forceinline__ float bf2f(unsigned short h) { return __uint_as_float((unsigned)h << 16); }
constexpr float RMS_EPS = 1e-6f;
constexpr float LOG2E = 1.4426950408889634f;
__device__ __forceinline__ float rstd_from_partials(const float* ssp, int row) {
    const f32x4* p = (const f32x4*)(ssp + (size_t)row * 16);
    const f32x4 a = p[0], b = p[1], c = p[2], d = p[3];
    const float s = (((a[0] + a[1]) + (a[2] + a[3])) + ((b[0] + b[1]) + (b[2] + b[3]))) + (((c[0] + c[1]) + (c[2] + c[3])) + ((d[0] + d[1]) + (d[2] + d[3])));
    return __builtin_amdgcn_rsqf(s * (1.0f / 1024.0f) + RMS_EPS);
}
__device__ __forceinline__ void rstd8_from_partials(const float* ssp, int row0, int fq, float (&rs)[8]) {
    f32x4 q[8];
#pragma unroll
    for (int i = 0; i < 8; ++i) q[i] = *(const f32x4*)(ssp + (size_t)(row0 + (i >> 2) * HALF + (i & 3) * 16) * 16 + 4 * fq);
#pragma unroll
    for (int i = 0; i < 8; ++i) { float s = (q[i][0] + q[i][1]) + (q[i][2] + q[i][3]); s += __shfl_xor(s, 16); s += __shfl_xor(s, 32); rs[i] = __builtin_amdgcn_rsqf(s * (1.0f / 1024.0f) + RMS_EPS); }
    asm volatile("" ::: "memory");
}
__device__ __forceinline__ float sigmoidf_fast(float x) { return __builtin_amdgcn_rcpf(1.0f + __builtin_amdgcn_exp2f(-x * LOG2E)); }

template <bool PARTIAL> struct EpiSwiglu {
    static constexpr bool PERM = true, AFTER_DRAIN = false;
    bf16_t* H; const float* rs;
    __device__ __forceinline__ void operator()(const f32x4 (&acc)[2][2][4][2], const Unit& u, int wr, int wc, int fr, int fq) const {
        const int row0 = u.pm * BM + wr * 64 + fr, col0 = u.pn * 128 + wc * 32 + 8 * fq;
        float rsv[8];
        if (PARTIAL) rstd8_from_partials(rs, row0, fq, rsv);
        else {
#pragma unroll
            for (int i = 0; i < 8; ++i) rsv[i] = rs[row0 + (i >> 2) * HALF + (i & 3) * 16]; }
#pragma unroll
        for (int ai = 0; ai < 2; ++ai)
#pragma unroll
            for (int m = 0; m < 4; ++m) {
                const int row = row0 + ai * HALF + m * 16;
                const float r = rsv[ai * 4 + m];
                f32x4 o[2];
#pragma unroll
                for (int n = 0; n < 2; ++n) {
                    const f32x4 g = acc[ai][0][m][n] * r, up = acc[ai][1][m][n] * r;
#pragma unroll
                    for (int e = 0; e < 4; ++e) o[n][e] = g[e] * sigmoidf_fast(g[e]) * up[e];
                }
                *(u32x4*)(H + (size_t)row * 2816 + col0) = pack8(o[0], o[1]);
            }
    }
};

__device__ __forceinline__ void unpack8(const u32x4 w, f32x4& a, f32x4& b) {
    a[0] = __uint_as_float(w.x << 16); a[1] = __uint_as_float(w.x & 0xffff0000u); a[2] = __uint_as_float(w.y << 16); a[3] = __uint_as_float(w.y & 0xffff0000u);
    b[0] = __uint_as_float(w.z << 16); b[1] = __uint_as_float(w.z & 0xffff0000u); b[2] = __uint_as_float(w.w << 16); b[3] = __uint_as_float(w.w & 0xffff0000u);
}
template <int MODE> struct EpiResid {
    static constexpr bool PERM = true, AFTER_DRAIN = false;
    bf16_t* XB; float* ssp; float* out;
    __device__ __forceinline__ void operator()(const f32x4 (&acc)[2][2][4][2], const Unit& u, int wr, int wc, int fr, int fq) const {
        const int row0 = u.pm * BM + wr * 64 + fr, col0 = u.pn * BM + wc * 32 + 8 * fq;
        const float alpha = (MODE == 1) ? 1.0f : 0.5f;
#pragma unroll
        for (int ai = 0; ai < 2; ++ai)
#pragma unroll
            for (int m = 0; m < 4; ++m) {
                const int row = row0 + ai * HALF + m * 16;
                float ss = 0.f;
#pragma unroll
                for (int bj = 0; bj < 2; ++bj) {
                    const size_t off = (size_t)row * 1024 + col0 + bj * HALF;
                    f32x4 b0, b1; unpack8(*(const u32x4*)(XB + off), b0, b1);
                    const f32x4 v0 = b0 + acc[ai][bj][m][0] * alpha, v1 = b1 + acc[ai][bj][m][1] * alpha;
                    if (MODE == 2) { *(f32x4*)(out + off) = v0; *(f32x4*)(out + off + 4) = v1; }
                    else {
                        *(u32x4*)(XB + off) = pack8(v0, v1);
                        ss += ((v0[0] * v0[0] + v0[1] * v0[1]) + (v0[2] * v0[2] + v0[3] * v0[3])) + ((v1[0] * v1[0] + v1[1] * v1[1]) + (v1[2] * v1[2] + v1[3] * v1[3]));
                    }
                }
                if (MODE != 2) { ss += __shfl_xor(ss, 16); ss += __shfl_xor(ss, 32); if (fq == 0) ssp[(size_t)row * 16 + u.pn * 4 + wc] = ss; }
            }
    }
};

struct EpiIn {
    static constexpr bool PERM = true, AFTER_DRAIN = false;
    const float* ssp; bf16_t *Q, *K, *V; float* U; bf16_t *GA, *GB; const float *qn, *kn; float* out;
    __device__ __forceinline__ void operator()(const f32x4 (&acc)[2][2][4][2], const Unit& u, int wr, int wc, int fr, int fq) const {
        const int row0 = u.pm * BM + wr * 64 + fr, pn = u.pn;
        float rsv[8]; rstd8_from_partials(ssp, row0, fq, rsv);
        constexpr size_t O_KVP[3] = {17039360u, 17301504u, 18350080u}, O_KVS[3] = {22575104u, 24672256u, 33060864u};
        constexpr size_t O_POOLP = 22544384u, O_POOLS = 66615296u;
        if (pn < 6) {
            const bool isk = pn >= 3; const int head = 4 * (isk ? pn - 3 : pn) + wc, g = head >> 2, hs = head & 3, win = 128 << (2 * g);
            const float* gn = (isk ? kn : qn) + head * 64 + 8 * fq;
            f32x4 gv[2][2];
#pragma unroll
            for (int bj = 0; bj < 2; ++bj)
#pragma unroll
                for (int n = 0; n < 2; ++n) gv[bj][n] = *(const f32x4*)(gn + 32 * bj + 4 * n);
            bf16_t* dst = isk ? K : Q;
#pragma unroll
            for (int ai = 0; ai < 2; ++ai)
#pragma unroll
                for (int m = 0; m < 4; ++m) {
                    const int row = row0 + ai * HALF + m * 16; const float rs = rsv[ai * 4 + m];
                    f32x4 v[2][2]; float ss = 0.f;
#pragma unroll
                    for (int bj = 0; bj < 2; ++bj)
#pragma unroll
                        for (int n = 0; n < 2; ++n) { v[bj][n] = acc[ai][bj][m][n] * rs; const f32x4 x = v[bj][n]; ss += (x[0] * x[0] + x[1] * x[1]) + (x[2] * x[2] + x[3] * x[3]); }
                    ss += __shfl_xor(ss, 16); ss += __shfl_xor(ss, 32);
                    const float r2 = __builtin_amdgcn_rsqf(ss * (1.0f / 64.0f) + RMS_EPS);
                    float* fo = nullptr;
                    if (isk) {
                        if (row < 16384) { const int b = row >> 12, t = row & 4095; if (t >= 4096 - win) fo = out + O_KVP[g] + ((size_t)(b * win + t - (4096 - win)) * 512 + hs * 64 + 8 * fq); }
                        else { const int s = row - 16384, b = s >> 3, t = s & 7; fo = out + O_KVS[g] + ((size_t)(b * win + win - 8 + t) * 512 + hs * 64 + 8 * fq); }
                    }
#pragma unroll
                    for (int bj = 0; bj < 2; ++bj) {
                        const f32x4 o0 = v[bj][0] * r2 * gv[bj][0], o1 = v[bj][1] * r2 * gv[bj][1];
                        *(u32x4*)(dst + (size_t)row * 768 + head * 64 + 32 * bj + 8 * fq) = pack8(o0, o1);
                        if (fo) { *(f32x4*)(fo + 32 * bj) = o0; *(f32x4*)(fo + 32 * bj + 4) = o1; }
                    }
                }
        } else if (pn < 9) {
            const int cb = (pn - 6) * 256 + wc * 32 + 8 * fq;
#pragma unroll
            for (int ai = 0; ai < 2; ++ai)
#pragma unroll
                for (int m = 0; m < 4; ++m) {
                    const int row = row0 + ai * HALF + m * 16; const float rs = rsv[ai * 4 + m];
#pragma unroll
                    for (int bj = 0; bj < 2; ++bj) {
                        const int c = cb + 128 * bj, head = c >> 6, g = head >> 2, hs = head & 3, win = 128 << (2 * g), dim = c & 63;
                        const f32x4 o0 = acc[ai][bj][m][0] * rs, o1 = acc[ai][bj][m][1] * rs;
                        *(u32x4*)(V + (size_t)row * 768 + c) = pack8(o0, o1);
                        float* fo = nullptr;
                        if (row < 16384) { const int b = row >> 12, t = row & 4095; if (t >= 4096 - win) fo = out + O_KVP[g] + ((size_t)(b * win + t - (4096 - win)) * 512 + 256 + hs * 64 + dim); }
                        else { const int s = row - 16384, b = s >> 3, t = s & 7; fo = out + O_KVS[g] + ((size_t)(b * win + win - 8 + t) * 512 + 256 + hs * 64 + dim); }
                        if (fo) { *(f32x4*)(fo) = o0; *(f32x4*)(fo + 4) = o1; }
                    }
                }
        } else if (pn < 11) {
            const int cb = (pn - 9) * 256 + wc * 32 + 8 * fq;
#pragma unroll
            for (int ai = 0; ai < 2; ++ai)
#pragma unroll
                for (int m = 0; m < 4; ++m) {
                    const int row = row0 + ai * HALF + m * 16; const float rs = rsv[ai * 4 + m];
                    float* fo = nullptr;
                    if (row < 16384) { const int b = row >> 12, t = row & 4095; if (t >= 4081) fo = out + O_POOLP + (size_t)(b * 15 + t - 4081) * 512 + cb; }
                    else { const int s = row - 16384, b = s >> 3, t = s & 7; fo = out + O_POOLS + (size_t)(b * 15 + 7 + t) * 512 + cb; }
#pragma unroll
                    for (int bj = 0; bj < 2; ++bj) {
                        const f32x4 o0 = acc[ai][bj][m][0] * rs, o1 = acc[ai][bj][m][1] * rs;
                        float* up = U + (size_t)row * 512 + cb + 128 * bj;
                        *(f32x4*)(up) = o0; *(f32x4*)(up + 4) = o1;
                        if (fo) { *(f32x4*)(fo + 128 * bj) = o0; *(f32x4*)(fo + 128 * bj + 4) = o1; }
                    }
                }
        } else {
            const bool isb = pn >= 15; bf16_t* G = isb ? GB : GA; const int cb = (pn - (isb ? 15 : 11)) * 256 + wc * 32 + 8 * fq;
#pragma unroll
            for (int ai = 0; ai < 2; ++ai)
#pragma unroll
                for (int m = 0; m < 4; ++m) {
                    const int row = row0 + ai * HALF + m * 16; const float rs = rsv[ai * 4 + m];
#pragma unroll
                    for (int bj = 0; bj < 2; ++bj) {
                        f32x4 o0 = acc[ai][bj][m][0] * rs, o1 = acc[ai][bj][m][1] * rs;
#pragma unroll
                        for (int e = 0; e < 4; ++e) { o0[e] = sigmoidf_fast(o0[e]); o1[e] = sigmoidf_fast(o1[e]); }
                        *(u32x4*)(G + (size_t)row * 1024 + cb + 128 * bj) = pack8(o0, o1);
                    }
                }
        }
    }
};

template <int PART> struct EpiMerge {
    static constexpr bool PERM = true, AFTER_DRAIN = false;
    const bf16_t* G; bf16_t* T; bf16_t* MG;
    __device__ __forceinline__ void operator()(const f32x4 (&acc)[2][2][4][2], const Unit& u, int wr, int wc, int fr, int fq) const {
        const int row0 = u.pm * BM + wr * 64 + fr, col0 = u.pn * BM + wc * 32 + 8 * fq;
#pragma unroll
        for (int ai = 0; ai < 2; ++ai)
#pragma unroll
            for (int m = 0; m < 4; ++m) {
                const int row = row0 + ai * HALF + m * 16;
#pragma unroll
                for (int bj = 0; bj < 2; ++bj) {
                    const size_t off = (size_t)row * 1024 + col0 + bj * HALF;
                    const u32x4 gw = *(const u32x4*)(G + off);
                    f32x4 o0, o1;
                    o0[0] = __uint_as_float(gw.x << 16) * acc[ai][bj][m][0][0]; o0[1] = __uint_as_float(gw.x & 0xffff0000u) * acc[ai][bj][m][0][1];
                    o0[2] = __uint_as_float(gw.y << 16) * acc[ai][bj][m][0][2]; o0[3] = __uint_as_float(gw.y & 0xffff0000u) * acc[ai][bj][m][0][3];
                    o1[0] = __uint_as_float(gw.z << 16) * acc[ai][bj][m][1][0]; o1[1] = __uint_as_float(gw.z & 0xffff0000u) * acc[ai][bj][m][1][1];
                    o1[2] = __uint_as_float(gw.w << 16) * acc[ai][bj][m][1][2]; o1[3] = __uint_as_float(gw.w & 0xffff0000u) * acc[ai][bj][m][1][3];
                    if (PART == 1) {
                        const u32x4 tw = *(const u32x4*)(T + off);
                        o0[0] += __uint_as_float(tw.x << 16); o0[1] += __uint_as_float(tw.x & 0xffff0000u); o0[2] += __uint_as_float(tw.y << 16); o0[3] += __uint_as_float(tw.y & 0xffff0000u);
                        o1[0] += __uint_as_float(tw.z << 16); o1[1] += __uint_as_float(tw.z & 0xffff0000u); o1[2] += __uint_as_float(tw.w << 16); o1[3] += __uint_as_float(tw.w & 0xffff0000u);
                        *(u32x4*)(MG + off) = pack8(o0, o1);
                    } else {
                        *(u32x4*)(T + off) = pack8(o0, o1);
                    }
                }
                if (m & 1) asm volatile("" ::: "memory");
            }
    }
};

struct NoSide { static constexpr int NV = 1; __device__ __forceinline__ bool pre(f32x4 (&)[1], int) const { return false; } __device__ __forceinline__ void post(const f32x4 (&)[1], bool, int) const {} };
struct SideCopy {
    static constexpr int NV = 6;
    static constexpr int CPB2 = 680, CPB1 = 168, CPB0 = 40;
    static constexpr int NCH2 = 32 * CPB2, NCH1 = 32 * CPB1, NCH0 = 32 * CPB0, NCH = NCH2 + NCH1 + NCH0;
    const float *c128, *c512, *c2048; float* out; int gw; int* step;
    __device__ __forceinline__ bool locate(int id, const f32x4*& s, f32x4*& d) const {
        if (id >= NCH) return false;
        if (id < NCH2) { const int b = id / CPB2, k = id - b * CPB2; s = (const f32x4*)(c2048 + ((size_t)b * 2048 + 8) * 512) + k * 384; d = (f32x4*)(out + 33060864u + (size_t)b * 2048 * 512) + k * 384; return true; }
        id -= NCH2;
        if (id < NCH1) { const int b = id / CPB1, k = id - b * CPB1; s = (const f32x4*)(c512 + ((size_t)b * 512 + 8) * 512) + k * 384; d = (f32x4*)(out + 24672256u + (size_t)b * 512 * 512) + k * 384; return true; }
        id -= NCH1;
        { const int b = id / CPB0, k = id - b * CPB0; s = (const f32x4*)(c128 + ((size_t)b * 128 + 8) * 512) + k * 384; d = (f32x4*)(out + 22575104u + (size_t)b * 128 * 512) + k * 384; return true; }
    }
    __device__ __forceinline__ bool pre(f32x4 (&v)[NV], int lane) const {
        const f32x4* s; f32x4* d; if (!locate(*step * 2048 + gw, s, d)) return false;
#pragma unroll
        for (int q = 0; q < NV; ++q) v[q] = __builtin_nontemporal_load(s + q * 64 + lane);
        return true;
    }
    __device__ __forceinline__ void post(const f32x4 (&v)[NV], bool ok, int lane) const {
        if (ok) { const f32x4* s; f32x4* d; locate(*step * 2048 + gw, s, d);
#pragma unroll
            for (int q = 0; q < NV; ++q) __builtin_nontemporal_store(v[q], d + q * 64 + lane); }
        *step += 1;
    }
};
template <class Epi, class Sched, bool ALIGN_EPI = false, bool SP2 = false, class Side = NoSide>
__device__ __forceinline__ void gemm_phase(PG8_LAS unsigned char* lds, const Gemm g, const Sched& S, const Epi& E, const Side side = Side()) {
    int tid_ = threadIdx.x; asm volatile("" : "+v"(tid_));
    const int tid = tid_, wid = __builtin_amdgcn_readfirstlane(tid >> 6), lane = tid & 63, wr = wid >> 2, wc = wid & 3, fr = lane & 15, fq = lane >> 4;
    const int K = g.K, nt = K / BK;
    unsigned voffA[2], voffB[2];
#pragma unroll
    for (int i = 0; i < 2; ++i) { int R, C; stage_rc(tid * 16 + i * 8192, R, C); const int Rb = Epi::PERM ? ((R & ~31) + perm32(R & 31)) : R;
        voffA[i] = (unsigned)(R * K + C) * 2u; voffB[i] = (unsigned)(Rb * K + C) * 2u; }
    const size_t kstep = (size_t)(BK * 2);
    const size_t hstep = (size_t)HALF * K * 2;
    const size_t tstep = 2 * hstep;
    const unsigned ldsw = (unsigned)wid * 1024u;
    const int aoff = lds_byte(wr * 64 + fr, fq * 8), boff = lds_byte(wc * 32 + fr, fq * 8);
#define PG8_SA(b, h) (((b) * 2 + (h)) * HTB)
#define PG8_SB(b, h) ((4 + (b) * 2 + (h)) * HTB)
#define PG8_STAGE(bufoff, gbase, voff) do { _Pragma("unroll") for (int _i = 0; _i < 2; ++_i) \
        __builtin_amdgcn_global_load_lds((const unsigned*)((const char*)(gbase) + (voff)[_i]), (PG8_LAS unsigned*)(lds + (bufoff) + ldsw + _i * 8192), 16, 0, 0); } while (0)
#define PG8_LDA(dst, b, h) do { _Pragma("unroll") for (int m = 0; m < 4; ++m) _Pragma("unroll") for (int k = 0; k < 2; ++k) dst[m][k] = *(const PG8_LAS bf16x8*)(lds + PG8_SA(b, h) + aoff + m * 2048 + k * 1024); } while (0)
#define PG8_LDB(dst, b, h) do { _Pragma("unroll") for (int n = 0; n < 2; ++n) _Pragma("unroll") for (int k = 0; k < 2; ++k) dst[n][k] = *(const PG8_LAS bf16x8*)(lds + PG8_SB(b, h) + boff + n * 2048 + k * 1024); } while (0)
#define PG8_MMA(ai, bj, At, Bt) do { __builtin_amdgcn_s_setprio(1); _Pragma("unroll") for (int m = 0; m < 4; ++m) _Pragma("unroll") for (int n = 0; n < 2; ++n) _Pragma("unroll") for (int k = 0; k < 2; ++k) \
        acc[ai][bj][m][n] = __builtin_amdgcn_mfma_f32_16x16x32_bf16(Bt[n][k], At[m][k], acc[ai][bj][m][n], 0, 0, 0); __builtin_amdgcn_s_setprio(0); } while (0)
#define PG8_WAIT_V(n) asm volatile("s_waitcnt vmcnt(" #n ")" ::: "memory")
#define PG8_WAIT_L(n) asm volatile("s_waitcnt lgkmcnt(" #n ")" ::: "memory")
#define PG8_BAR __builtin_amdgcn_s_barrier()
#define PG8_SCHED __builtin_amdgcn_sched_barrier(0)
    Unit cur, nxt; int ui = 0;
    if (!S.next(0, cur)) return;
    f32x4 acc[2][2][4][2];
#pragma unroll
    for (int a = 0; a < 2; ++a)
#pragma unroll
        for (int b = 0; b < 2; ++b)
#pragma unroll
            for (int m = 0; m < 4; ++m)
#pragma unroll
                for (int n = 0; n < 2; ++n) acc[a][b][m][n] = (f32x4){0.f, 0.f, 0.f, 0.f};
    bf16x8 At[4][2], B0[2][2], B1[2][2];
    const char* cA = (const char*)g.A + (size_t)cur.pm * tstep; const char* cB = (const char*)g.Bt + (size_t)cur.pn * tstep;
    S.a_ready(cur);
    if constexpr (SP2) {
        PG8_STAGE(PG8_SB(0, 0), cB, voffB); PG8_STAGE(PG8_SB(0, 1), cB + hstep, voffB); PG8_STAGE(PG8_SA(0, 0), cA, voffA); PG8_STAGE(PG8_SA(0, 1), cA + hstep, voffA);
        if (wr == 1) PG8_BAR;
        PG8_WAIT_V(2); PG8_BAR;
        PG8_STAGE(PG8_SB(1, 0), cB + kstep, voffB); PG8_STAGE(PG8_SA(1, 0), cA + kstep, voffA); PG8_STAGE(PG8_SB(1, 1), cB + hstep + kstep, voffB);
        PG8_WAIT_V(6); PG8_BAR;
    } else {
        PG8_STAGE(PG8_SB(0, 0), cB, voffB); PG8_STAGE(PG8_SA(0, 0), cA, voffA); PG8_STAGE(PG8_SB(0, 1), cB + hstep, voffB); PG8_STAGE(PG8_SA(0, 1), cA + hstep, voffA);
        if (wr == 1) PG8_BAR;
        PG8_WAIT_V(4); PG8_BAR;
        PG8_STAGE(PG8_SB(1, 0), cB + kstep, voffB); PG8_STAGE(PG8_SA(1, 0), cA + kstep, voffA); PG8_STAGE(PG8_SB(1, 1), cB + hstep + kstep, voffB);
        PG8_WAIT_V(6); PG8_BAR;
    }
    for (;;) {
        const bool has_next = S.next(ui + 1, nxt);
        const char* nA = has_next ? (const char*)g.A + (size_t)nxt.pm * tstep : cA; const char* nB = has_next ? (const char*)g.Bt + (size_t)nxt.pn * tstep : cB;
        for (int t = 0; t < nt; t += 2) {
            const bool last = (t == nt - 2);
            const char* a1 = cA + (size_t)(t + 1) * kstep;
            const char* a2 = last ? nA : cA + (size_t)(t + 2) * kstep; const char* b2 = last ? nB : cB + (size_t)(t + 2) * kstep;
            const char* a3 = a2 + kstep; const char* b3 = b2 + kstep;
            if (last && has_next) S.a_ready(nxt);
            if constexpr (SP2) {
            PG8_LDB(B0, 0, 0); PG8_LDB(B1, 0, 1); PG8_SCHED; PG8_LDA(At, 0, 0); PG8_STAGE(PG8_SA(1, 1), a1 + hstep, voffA);
            PG8_WAIT_V(8); PG8_WAIT_L(0); PG8_BAR; PG8_MMA(0, 0, At, B0); PG8_MMA(0, 1, At, B1); PG8_BAR; PG8_SCHED;
            PG8_LDA(At, 0, 1); PG8_STAGE(PG8_SB(0, 0), b2, voffB); PG8_STAGE(PG8_SB(0, 1), b2 + hstep, voffB); PG8_STAGE(PG8_SA(0, 0), a2, voffA);
            PG8_WAIT_V(8); PG8_WAIT_L(0); PG8_BAR; PG8_MMA(1, 0, At, B0); PG8_MMA(1, 1, At, B1); PG8_BAR; PG8_SCHED;
            PG8_LDB(B0, 1, 0); PG8_LDB(B1, 1, 1); PG8_SCHED; PG8_LDA(At, 1, 0); PG8_STAGE(PG8_SA(0, 1), a2 + hstep, voffA);
            PG8_WAIT_V(8); PG8_WAIT_L(0); PG8_BAR; PG8_MMA(0, 0, At, B0); PG8_MMA(0, 1, At, B1); PG8_BAR; PG8_SCHED;
            PG8_LDA(At, 1, 1); PG8_STAGE(PG8_SB(1, 0), b3, voffB); PG8_STAGE(PG8_SB(1, 1), b3 + hstep, voffB); PG8_STAGE(PG8_SA(1, 0), a3, voffA);
            PG8_WAIT_V(8); PG8_WAIT_L(0); PG8_BAR; PG8_MMA(1, 0, At, B0); PG8_MMA(1, 1, At, B1); PG8_BAR; PG8_SCHED;
            } else {
            PG8_LDB(B0, 0, 0); PG8_SCHED; PG8_LDA(At, 0, 0); PG8_STAGE(PG8_SA(1, 1), a1 + hstep, voffA);
            PG8_WAIT_L(8); PG8_BAR; PG8_WAIT_L(0); PG8_MMA(0, 0, At, B0); PG8_BAR; PG8_SCHED;
            PG8_LDB(B1, 0, 1); PG8_STAGE(PG8_SB(0, 0), b2, voffB);
            PG8_BAR; PG8_WAIT_L(0); PG8_MMA(0, 1, At, B1); PG8_BAR;
            PG8_LDA(At, 0, 1); PG8_STAGE(PG8_SA(0, 0), a2, voffA);
            PG8_BAR; PG8_WAIT_L(0); PG8_MMA(1, 0, At, B0); PG8_BAR; PG8_SCHED;
            PG8_STAGE(PG8_SB(0, 1), b2 + hstep, voffB);
            PG8_WAIT_V(6); PG8_BAR; PG8_MMA(1, 1, At, B1); PG8_BAR;
            PG8_LDB(B0, 1, 0); PG8_SCHED; PG8_LDA(At, 1, 0); PG8_STAGE(PG8_SA(0, 1), a2 + hstep, voffA);
            PG8_WAIT_L(8); PG8_BAR; PG8_WAIT_L(0); PG8_MMA(0, 0, At, B0); PG8_BAR; PG8_SCHED;
            PG8_LDB(B1, 1, 1); PG8_STAGE(PG8_SB(1, 0), b3, voffB);
            PG8_BAR; PG8_WAIT_L(0); PG8_MMA(0, 1, At, B1); PG8_BAR;
            PG8_LDA(At, 1, 1); PG8_STAGE(PG8_SA(1, 0), a3, voffA);
            PG8_BAR; PG8_WAIT_L(0); PG8_MMA(1, 0, At, B0); PG8_BAR; PG8_SCHED;
            PG8_STAGE(PG8_SB(1, 1), b3 + hstep, voffB);
            PG8_WAIT_V(6); PG8_BAR; PG8_MMA(1, 1, At, B1); PG8_BAR;
            }
        }
        if constexpr (ALIGN_EPI) { if (wr == 0) PG8_BAR; }
        if constexpr (!Epi::AFTER_DRAIN) { int t2_ = threadIdx.x; asm volatile("" : "+v"(t2_)); const int lane2_ = t2_ & 63;
            f32x4 sv_[Side::NV]; const bool sok_ = side.pre(sv_, lane2_); E(acc, cur, wr, wc, lane2_ & 15, lane2_ >> 4); side.post(sv_, sok_, lane2_); S.done(cur); }
        if (!has_next) break;
#pragma unroll
        for (int a = 0; a < 2; ++a)
#pragma unroll
            for (int b = 0; b < 2; ++b)
#pragma unroll
                for (int m = 0; m < 4; ++m)
#pragma unroll
                    for (int n = 0; n < 2; ++n) acc[a][b][m][n] = (f32x4){0.f, 0.f, 0.f, 0.f};
        cur = nxt; cA = nA; cB = nB; ++ui;
        if constexpr (ALIGN_EPI) { if (wr == 1) PG8_BAR; }
    }
    PG8_WAIT_V(0);
    if constexpr (!ALIGN_EPI) { if (wr == 0) PG8_BAR; }
    PG8_BAR;
    if constexpr (Epi::AFTER_DRAIN) { E.fused(acc, cur, wr, wc, fr, fq, lds, wid, lane); S.done(cur); }
#undef PG8_SA
#undef PG8_SB
#undef PG8_STAGE
#undef PG8_LDA
#undef PG8_LDB
#undef PG8_MMA
#undef PG8_WAIT_V
#undef PG8_WAIT_L
#undef PG8_BAR
#undef PG8_SCHED
}
}

constexpr int NWAVES = 8;
constexpr int DM = 1024, NBATCH = 4, SEQ = 4096, DBATCH = 32, DSEQ = 8;
constexpr int MP = NBATCH * SEQ, MS = DBATCH * DSEQ, M = MP + MS;
constexpr int FF = 2816, FF2 = 5632, INW = 4864, AW = 768, AOW = 256, PW = 512;
constexpr size_t O_Y = 0, O_KV128P = 17039360u, O_KV512P = 17301504u, O_KV2048P = 18350080u, O_POOLP = 22544384u,
                 O_KV128S = 22575104u, O_KV512S = 24672256u, O_KV2048S = 33060864u, O_POOLS = 66615296u, O_END = 66861056u;
constexpr size_t MiB = 1u << 20;
constexpr size_t WS_CTL = 0, CTL_ZERO_BYTES = 1 * MiB;
constexpr size_t WS_WUP1 = 2 * MiB, WS_WDN1 = 13 * MiB, WS_WIN = 19 * MiB, WS_WAB = 29 * MiB, WS_WEFF = 30 * MiB, WS_WOUT = 31 * MiB, WS_WUP2 = 33 * MiB, WS_WDN2 = 44 * MiB;
constexpr size_t WS_RSTD0 = 50 * MiB, WS_SSP1 = 51 * MiB, WS_SSP2 = 53 * MiB, WS_BIAS = 55 * MiB;
constexpr size_t WS_XB = 56 * MiB;
constexpr size_t WS_X1 = 90 * MiB;
constexpr size_t WS_R = 156 * MiB;
constexpr size_t WS_Q = WS_R, WS_K = WS_Q + 25 * MiB, WS_V = WS_K + 25 * MiB;
constexpr size_t WS_U = WS_V + 25 * MiB;
constexpr size_t WS_GA = WS_U + 33 * MiB, WS_GB = WS_GA + 33 * MiB;
constexpr size_t WS_AA = WS_GB + 33 * MiB, WS_DD = WS_AA + 9 * MiB;
constexpr size_t WS_T = WS_DD + 17 * MiB, WS_MG = WS_T + 33 * MiB, WS_END = WS_MG + 33 * MiB;
static_assert(WS_END <= 512 * MiB, "d_ws map");
static_assert(WS_R + (size_t)M * FF * 2 <= WS_END, "H fits");
constexpr int CW_TMO = 0, CW_BAR = 4096;
constexpr int RING_OFF = 0, RING_BYTES = 131072;
constexpr int LDS_BYTES = 147456;
constexpr int LDSCTL_OFF = LDS_BYTES - 1024, MISC_OFF = LDSCTL_OFF + 320;
#define GAS __attribute__((address_space(1)))
#define LAS __attribute__((address_space(3)))
typedef unsigned short bf16;
typedef unsigned v4u __attribute__((ext_vector_type(4)));
typedef float f32x4 __attribute__((ext_vector_type(4)));
typedef short bf16x8 __attribute__((ext_vector_type(8)));
typedef GAS unsigned gu32;
typedef GAS unsigned long long gu64;
#define RLX_AGENT __ATOMIC_RELAXED, __HIP_MEMORY_SCOPE_AGENT
#define LDS_WAIT() asm volatile("s_waitcnt lgkmcnt(0)" ::: "memory")
#define VM_WAIT() asm volatile("s_waitcnt vmcnt(0)" ::: "memory")
__device__ __forceinline__ unsigned long long rt() { return __builtin_amdgcn_s_memrealtime(); }
__device__ __forceinline__ unsigned f2bf(float f) { unsigned u = __builtin_bit_cast(unsigned, f); return (u + 0x7fffu + ((u >> 16) & 1u)) >> 16; }
__device__ __forceinline__ unsigned pk2(float lo, float hi) { return f2bf(lo) | (f2bf(hi) << 16); }

#define XB_TMO      128
#define XB_XCNT(j)  (256  + 64 * (j))
#define XB_XSUB(j)  (1280 + 64 * (j))
#define XB_XGEN(j)  (2304 + 64 * (j))
#define XB_TOP      3328
#define XB_TOPGEN   3392
#define XCD_BAR_WORDS 3456
#define XB_SPIN_CAP (1u << 18)

__device__ __forceinline__ unsigned xb_ld(unsigned* p)              { return __hip_atomic_load(p, __ATOMIC_RELAXED, __HIP_MEMORY_SCOPE_AGENT); }
__device__ __forceinline__ unsigned xb_add(unsigned* p, unsigned v) { return __hip_atomic_fetch_add(p, v, __ATOMIC_RELAXED, __HIP_MEMORY_SCOPE_AGENT); }
__device__ __forceinline__ unsigned xb_xcc_id() { return (unsigned)__builtin_amdgcn_s_getreg((3 << 11) | 20) & 0xFu; }
#define XB_SPIN(cond, bar) do { unsigned _sp = 0; while (cond) { __builtin_amdgcn_s_sleep(1); \
    if ((++_sp & 255u) == 0u) { if (xb_ld(&(bar)[XB_TMO])) break; if (_sp > XB_SPIN_CAP) { atomicAdd(&(bar)[XB_TMO], 1u); break; } } } } while (0)

struct XcdBarrier {
    unsigned* bar; unsigned x;
    volatile LAS unsigned* st;
};

__device__ __forceinline__ XcdBarrier xcd_barrier_post(unsigned* bar, volatile LAS unsigned* st) {
    XcdBarrier b; b.bar = bar; b.x = xb_xcc_id(); b.st = st;
    if (threadIdx.x == 0) (void)xb_add(&bar[XB_XCNT(b.x)], 1u);
    return b;
}
__device__ __forceinline__ void xcd_barrier_complete(unsigned* bar, unsigned x, unsigned& nloc, unsigned& nx) {
    const unsigned G = gridDim.x * gridDim.y * gridDim.z;
    unsigned sum, cnt, mine, sp = 0u;
    for (;;) {
        sum = 0u; cnt = 0u; mine = 0u;
#pragma unroll
        for (unsigned j = 0; j < 16; ++j) { const unsigned c = xb_ld(&bar[XB_XCNT(j)]); sum += c; cnt += (c > 0u) ? 1u : 0u; mine = (j == x) ? c : mine; }
        if (sum == G) break;
        __builtin_amdgcn_s_sleep(1);
        if ((++sp & 255u) == 0u) { if (xb_ld(&bar[XB_TMO])) break; if (sp > XB_SPIN_CAP) { atomicAdd(&bar[XB_TMO], 1u); break; } }
    }
    nloc = mine > 0u ? mine : 1u; nx = cnt > 0u ? cnt : 1u;
}

__device__ __forceinline__ void xcd_barrier(const XcdBarrier& b) {
    asm volatile("s_waitcnt vmcnt(0)" ::: "memory");
    __syncthreads();
    if (threadIdx.x == 0) {
        unsigned* bar = b.bar;
        __builtin_amdgcn_s_waitcnt(0);
        unsigned nloc = b.st[0], nx = b.st[1];
        if (nloc == 0u) { xcd_barrier_complete(bar, b.x, nloc, nx); b.st[0] = nloc; b.st[1] = nx; }
        const unsigned old = xb_add(&bar[XB_XSUB(b.x)], 1u);
        const unsigned gen = old / nloc;
        if (old + 1u == (gen + 1u) * nloc) {
            __builtin_amdgcn_fence(__ATOMIC_RELEASE, "agent");
            asm volatile("s_waitcnt vmcnt(0)" ::: "memory");
            const unsigned og = xb_add(&bar[XB_TOP], 1u);
            const unsigned tg = og / nx;
            if (og + 1u == (tg + 1u) * nx) xb_add(&bar[XB_TOPGEN], 1u);
            else XB_SPIN(xb_ld(&bar[XB_TOPGEN]) == tg, bar);
            __builtin_amdgcn_fence(__ATOMIC_ACQUIRE, "agent");
            xb_add(&bar[XB_XGEN(b.x)], 1u);
            asm volatile("s_waitcnt vmcnt(0)" ::: "memory");
        } else {
            XB_SPIN(xb_ld(&bar[XB_XGEN(b.x)]) == gen, bar);
            __builtin_amdgcn_fence(__ATOMIC_ACQUIRE, "agent");
            asm volatile("s_waitcnt vmcnt(0)" ::: "memory");
        }
    }
    __syncthreads();
}

struct Frame {
    LAS unsigned char* lds;
    volatile LAS unsigned* MISC;
    gu32* ctl;
    int tid, lane, wave;
    int vcu, G;
};
__device__ __forceinline__ float wave_sum(float v) {
#pragma unroll
    for (int o = 1; o < 64; o <<= 1) v += __shfl_xor(v, o);
    return v;
}
__device__ __forceinline__ float wave_max(float v) {
#pragma unroll
    for (int o = 1; o < 64; o <<= 1) v = fmaxf(v, __shfl_xor(v, o));
    return v;
}
__constant__ unsigned char T5B[3][132] = {
 {0,1,2,3,4,5,6,7,8,9,10,11,12,13,14,15,16,16,16,16,16,16,17,17,17,17,17,17,17,17,18,18,18,18,18,18,18,18,18,18,19,19,19,19,19,19,19,19,19,19,19,19,19,19,20,20,20,20,20,20,20,20,20,20,20,20,20,20,20,20,20,20,20,21,21,21,21,21,21,21,21,21,21,21,21,21,21,21,21,21,21,21,21,21,21,21,21,21,21,22,22,22,22,22,22,22,22,22,22,22,22,22,22,22,22,22,22,22,22,22,22,22,22,22,22,22,22,22,22,0,0,0},
 {0,4,8,12,16,16,17,17,18,18,19,19,19,19,20,20,20,20,20,21,21,21,21,21,21,22,22,22,22,22,22,22,22,22,23,23,23,23,23,23,23,23,23,23,23,23,24,24,24,24,24,24,24,24,24,24,24,24,24,24,24,24,25,25,25,25,25,25,25,25,25,25,25,25,25,25,25,25,25,25,25,25,25,26,26,26,26,26,26,26,26,26,26,26,26,26,26,26,26,26,26,26,26,26,26,26,26,26,26,26,26,26,26,27,27,27,27,27,27,27,27,27,27,27,27,27,27,27,27,0,0,0},
 {0,16,18,19,20,21,21,22,22,23,23,23,24,24,24,24,25,25,25,25,25,26,26,26,26,26,26,26,26,27,27,27,27,27,27,27,27,27,27,28,28,28,28,28,28,28,28,28,28,28,28,28,29,29,29,29,29,29,29,29,29,29,29,29,29,29,29,29,29,29,30,30,30,30,30,30,30,30,30,30,30,30,30,30,30,30,30,30,30,30,30,30,30,30,30,31,31,31,31,31,31,31,31,31,31,31,31,31,31,31,31,31,31,31,31,31,31,31,31,31,31,31,31,31,31,31,31,31,31,0,0,0}};

template <int MAP> __device__ __forceinline__ void p0_transpose_item(const float* W, int K, int N, bf16* WT, const float* gain, LAS float* scr, int item, int lane) {
    const int nblk = N / 32, kb = item / nblk, nb = item % nblk, k0 = 64 * kb, n0 = 32 * nb;
    int v0 = n0;
    if (MAP == 1) { const int c = n0 < FF ? n0 : n0 - FF; v0 = 256 * (c >> 7) + (n0 < FF ? 0 : 128) + (c & 127); }
    if (MAP == 2) { if (n0 < 1536) { const int o = n0 & 255; v0 = (n0 & ~255) + 128 * ((o >> 5) & 1) + 32 * (o >> 6); } }
    f32x4 wv[8]; const int kr = lane >> 3, n4 = (lane & 7) * 4;
#pragma unroll
    for (int i = 0; i < 8; ++i) wv[i] = *(const f32x4*)(W + (size_t)(k0 + kr + 8 * i) * N + n0 + n4);
#pragma unroll
    for (int i = 0; i < 8; ++i) { const int kk = kr + 8 * i; f32x4 w = wv[i]; if (gain) w = w * gain[k0 + kk];
        LAS float* d = scr + kk * 33 + n4; d[0] = w[0]; d[1] = w[1]; d[2] = w[2]; d[3] = w[3]; }
    LDS_WAIT(); asm volatile("" ::: "memory");
    const int c = lane & 7;
#pragma unroll
    for (int j = 0; j < 4; ++j) { const int n = (lane >> 3) + 8 * j; const LAS float* s = scr + (8 * c) * 33 + n;
        v4u o; o.x = pk2(s[0 * 33], s[1 * 33]); o.y = pk2(s[2 * 33], s[3 * 33]); o.z = pk2(s[4 * 33], s[5 * 33]); o.w = pk2(s[6 * 33], s[7 * 33]);
        *(GAS v4u*)(WT + (size_t)(v0 + n) * K + k0 + 8 * c) = o; }
    LDS_WAIT(); asm volatile("" ::: "memory");
}
struct Ptrs {
    const float *xp, *xs, *c128, *c512, *c2048, *spool, *rbias, *n1, *wup1, *wdn1, *nmix, *win, *qn, *kn, *wg, *pscale, *wab, *wpb, *wout, *n2, *wup2, *wdn2;
    float* out; unsigned char* ws;
};
constexpr int I_UP = (DM / 64) * (FF2 / 32), I_DN = (FF / 64) * (DM / 32), I_IN = (DM / 64) * (INW / 32), I_AB = (AOW / 64) * (DM / 32), I_OUT = (DM / 64) * (DM / 32);
constexpr int WI_WUP1 = 0, WI_WDN1 = I_UP, WI_WIN = WI_WDN1 + I_DN, WI_WAB = WI_WIN + I_IN, WI_WOUT = WI_WAB + I_AB, WI_WUP2 = WI_WOUT + I_OUT, WI_WDN2 = WI_WUP2 + I_UP, WI_END = WI_WDN2 + I_DN;
__device__ __forceinline__ void convert_items(const Ptrs& P, int first, int last, int gwh, int ngwh, LAS float* scr, int lane) {
    unsigned char* ws = P.ws;
    for (int it = first + gwh; it < last; it += ngwh) {
        if (it < WI_WDN1) p0_transpose_item<1>(P.wup1, DM, FF2, (bf16*)(ws + WS_WUP1), P.n1, scr, it - WI_WUP1, lane);
        else if (it < WI_WIN) p0_transpose_item<0>(P.wdn1, FF, DM, (bf16*)(ws + WS_WDN1), nullptr, scr, it - WI_WDN1, lane);
        else if (it < WI_WAB) p0_transpose_item<2>(P.win, DM, INW, (bf16*)(ws + WS_WIN), P.nmix, scr, it - WI_WIN, lane);
        else if (it < WI_WOUT) p0_transpose_item<0>(P.wab, AOW, DM, (bf16*)(ws + WS_WAB), nullptr, scr, it - WI_WAB, lane);
        else if (it < WI_WUP2) p0_transpose_item<0>(P.wout, DM, DM, (bf16*)(ws + WS_WOUT), nullptr, scr, it - WI_WOUT, lane);
        else if (it < WI_WDN2) p0_transpose_item<1>(P.wup2, DM, FF2, (bf16*)(ws + WS_WUP2), P.n2, scr, it - WI_WUP2, lane);
        else p0_transpose_item<0>(P.wdn2, FF, DM, (bf16*)(ws + WS_WDN2), nullptr, scr, it - WI_WDN2, lane);
    }
}

__device__ __forceinline__ void weff_items(const Ptrs& P, int gw, int NGW, int lane) {
    unsigned char* ws = P.ws;
    for (int it = gw; it < 64 * 16; it += NGW) {
        const int kq = it >> 4, nb = it & 15, k = 8 * kq, g = k >> 7, kp = k & 127, n = nb * 64 + lane;
        const float* wgr = P.wg + ((size_t)g * 128 + kp) * 128; const float* sc = P.pscale + 128 * g; const float* wp = P.wpb + (size_t)(128 * g) * DM + n;
        float a[8] = {0.f, 0.f, 0.f, 0.f, 0.f, 0.f, 0.f, 0.f};
#pragma unroll
        for (int cb = 0; cb < 128; cb += 32) {
            float w[32];
#pragma unroll
            for (int c = 0; c < 32; ++c) w[c] = wp[(size_t)(cb + c) * DM];
#pragma unroll
            for (int c = 0; c < 32; ++c) { const float ws_ = w[c] * sc[cb + c];
#pragma unroll
                for (int q = 0; q < 8; ++q) a[q] += wgr[q * 128 + cb + c] * ws_; }
        }
        v4u o; o.x = pk2(a[0], a[1]); o.y = pk2(a[2], a[3]); o.z = pk2(a[4], a[5]); o.w = pk2(a[6], a[7]);
        *(GAS v4u*)((bf16*)(ws + WS_WEFF) + (size_t)n * PW + k) = o;
    }
}
#ifndef PROBE_AMP
#define PROBE_AMP -1
#endif
#define P0_SPIN(k) do { if (PROBE_AMP == (k)) { const unsigned long long t1_ = __builtin_amdgcn_s_memrealtime(); while (__builtin_amdgcn_s_memrealtime() < t1_ + 2 * (t1_ - tp0_)) __builtin_amdgcn_s_sleep(8); } } while (0)
__device__ __forceinline__ void p0_prologue(Frame& F, const Ptrs& P) {
    const unsigned long long tp0_ = (PROBE_AMP >= 50) ? __builtin_amdgcn_s_memrealtime() : 0ull;
    LAS float* scr = (LAS float*)(F.lds + RING_OFF + F.wave * 16384);
    const int gw = F.vcu * NWAVES + F.wave, NGW = F.G * NWAVES;
    unsigned char* ws = P.ws;
    for (int m0 = gw; m0 < M; m0 += 2 * NGW) {
        f32x4 v[2][4];
#pragma unroll
        for (int q = 0; q < 2; ++q) { const int m = m0 + q * NGW; if (m < M) {
            const float* xrow = (m < MP) ? P.xp + (size_t)m * DM : P.xs + (size_t)(m - MP) * DM; const GAS f32x4* xr = (const GAS f32x4*)xrow + F.lane;
#pragma unroll
            for (int j = 0; j < 4; ++j) v[q][j] = xr[64 * j]; } }
#pragma unroll
        for (int q = 0; q < 2; ++q) { const int m = m0 + q * NGW; if (m < M) {
            float s = 0.f;
#pragma unroll
            for (int j = 0; j < 4; ++j) s += (v[q][j].x * v[q][j].x + v[q][j].y * v[q][j].y) + (v[q][j].z * v[q][j].z + v[q][j].w * v[q][j].w);
            s = wave_sum(s);
            if (F.lane == 0) ((float*)(ws + WS_RSTD0))[m] = __builtin_amdgcn_rsqf(s * (1.0f / DM) + 1e-6f);
            GAS unsigned long long* o8 = (GAS unsigned long long*)((bf16*)(ws + WS_XB) + (size_t)m * DM) + F.lane;
#pragma unroll
            for (int j = 0; j < 4; ++j) o8[64 * j] = (unsigned long long)pk2(v[q][j].x, v[q][j].y) | ((unsigned long long)pk2(v[q][j].z, v[q][j].w) << 32); } }
    }
    P0_SPIN(50);
    convert_items(P, WI_WUP1, WI_WDN1, gw, NGW, scr, F.lane);
    P0_SPIN(52);
    if (blockIdx.x == 0) {
        for (int i = F.tid; i < 3 * 4 * 132; i += NWAVES * 64) { const int g = i / (4 * 132), h = (i / 132) & 3, j = i % 132;
            ((float*)(ws + WS_BIAS))[i] = (j <= 128) ? P.rbias[(int)T5B[g][j] * 12 + 4 * g + h] * 1.4426950408889634f : 0.f; }
    }
    for (long i = (long)F.vcu * (NWAVES * 64) + F.tid; i < (long)DBATCH * 7 * 128; i += (long)F.G * (NWAVES * 64)) {
        const long b = i / (7 * 128), r = i - b * (7 * 128);
        ((f32x4*)(P.out + O_POOLS + (size_t)b * 15 * 512))[r] = ((const f32x4*)(P.spool + ((size_t)b * 15 + 8) * 512))[r];
    }
}

typedef float f32x16 __attribute__((ext_vector_type(16)));
typedef short s16x4 __attribute__((ext_vector_type(4)));
typedef short v4i16_t __attribute__((ext_vector_type(4)));
__device__ __forceinline__ int crow(int r, int hi) { return (r & 3) + 8 * (r >> 2) + 4 * hi; }
__device__ __forceinline__ s16x4 vtr(const LAS unsigned char* p) { return __builtin_bit_cast(s16x4, __builtin_amdgcn_ds_read_tr16_b64_v4i16((LAS v4i16_t*)p)); }
__device__ __forceinline__ unsigned cvtpk(float lo, float hi) { typedef float f2 __attribute__((ext_vector_type(2))); typedef __bf16 b2 __attribute__((ext_vector_type(2))); f2 v = {lo, hi}; b2 b = __builtin_convertvector(v, b2); return __builtin_bit_cast(unsigned, b); }

constexpr int ATT_WLDS = 16384;
constexpr int TB_JMIN0 = -512, TB_N0 = 1140, TB_JMIN1 = -128, TB_N1 = 384, TB_JMIN2 = -32, TB_N2 = 192;
constexpr int TB_OFF0 = 0, TB_OFF1 = TB_N0, TB_OFF2 = TB_N0 + TB_N1, TB_TOTAL = TB_N0 + TB_N1 + TB_N2;
constexpr int ATT_TB_OFF = 4096, ATT_SC_OFF = 4096 + 7168;

struct AttnState { f32x16 o0, o1, lacc; float m; };

__device__ __forceinline__ void attn_build_tables(const float* BIAS, int h, LAS float* tb, int lane) {
#pragma unroll 1
    for (int i = lane; i < TB_TOTAL; i += 64) {
        int g, j;
        if (i < TB_OFF1) { g = 0; j = i + TB_JMIN0; } else if (i < TB_OFF2) { g = 1; j = i - TB_OFF1 + TB_JMIN1; } else { g = 2; j = i - TB_OFF2 + TB_JMIN2; }
        tb[i] = ((unsigned)j <= 128u) ? BIAS[(g * 4 + h) * 132 + j] : -INFINITY;
    }
    asm volatile("s_waitcnt lgkmcnt(0)" ::: "memory");
}

template <int G, bool PMASK> __device__ __forceinline__ void attn_group(AttnState& st, const bf16* __restrict__ Qb, const bf16* __restrict__ Kb, const bf16* __restrict__ Vb,
                                                            int b, int s, int h, int r, LAS unsigned char* wl, int lane_in) {
    int lane = lane_in;
    constexpr int D = 1 << (2 * G), E = 16 / D, NT = (G == 0) ? 20 : (G == 1) ? 8 : 5;
    constexpr int TOFF = (G == 0) ? TB_OFF0 : (G == 1) ? TB_OFF1 : TB_OFF2, TJMIN = (G == 0) ? TB_JMIN0 : (G == 1) ? TB_JMIN1 : TB_JMIN2;
    asm volatile("" : "+v"(lane));
    const int i = lane & 31, hi = lane >> 5;
    const int rg = r & (D - 1), cg = r >> (2 * G), P0 = (512 * s) >> (2 * G);
    const int p_i = P0 + E * i + cg, p_lo = P0 + cg - 128;
    const int pmax = (SEQ >> (2 * G)) - 1;
    const int col = (4 * G + h) * 64;
    const size_t rowb = (size_t)b * SEQ;
    bf16x8 qf[4];
    { const bf16* qp = Qb + (rowb + 512 * s + 16 * i + r) * AW + col + 32 * hi;
#pragma unroll
      for (int s4 = 0; s4 < 4; ++s4) qf[s4] = *(const bf16x8*)(qp + 8 * s4); }
    const LAS unsigned char* vb0 = wl + ((lane >> 4) & 1) * 32 + (lane & 3) * 8 + (4 * hi + ((lane & 15) >> 2)) * 64;
    const LAS float* tbg = (const LAS float*)(wl + ATT_TB_OFF) + TOFF - TJMIN - 27;
    constexpr float C2 = 0.125f * 1.4426950408889634f;
    const bf16x8 ones = {(short)0x3f80, (short)0x3f80, (short)0x3f80, (short)0x3f80, (short)0x3f80, (short)0x3f80, (short)0x3f80, (short)0x3f80};
    bf16x8 kf[4]; v4u vv[4];
#define ATT_LOAD_TILE(kt, kk, vw) do { \
        int p_ = p_lo + 32 * (kt) + i; p_ = p_ < 0 ? 0 : (p_ > pmax ? pmax : p_); \
        const bf16* kp_ = Kb + (rowb + (size_t)(D * p_ + rg)) * AW + col + 32 * hi; \
        _Pragma("unroll") for (int s4 = 0; s4 < 4; ++s4) kk[s4] = *(const bf16x8*)(kp_ + 8 * s4); \
        _Pragma("unroll") for (int kg = 0; kg < 2; ++kg) { int pv_ = p_lo + 32 * (kt) + 16 * kg + (lane >> 2); pv_ = pv_ < 0 ? 0 : (pv_ > pmax ? pmax : pv_); \
            const bf16* vp_ = Vb + (rowb + (size_t)(D * pv_ + rg)) * AW + col + 8 * (lane & 3); \
            vw[kg] = *(const v4u*)(vp_); vw[2 + kg] = *(const v4u*)(vp_ + 32); } } while (0)
    ATT_LOAD_TILE(0, kf, vv);
    for (int kt = 0; kt < NT; ++kt) {
        bf16x8 kn[4]; v4u vn[4];
        if (kt + 1 < NT) ATT_LOAD_TILE(kt + 1, kn, vn);
        f32x16 sa = {};
#pragma unroll
        for (int s4 = 0; s4 < 4; ++s4) sa = __builtin_amdgcn_mfma_f32_32x32x16_bf16(kf[s4], qf[s4], sa, 0, 0, 0);
#pragma unroll
        for (int pc = 0; pc < 4; ++pc) *(LAS v4u*)(wl + ((pc >> 1) * 2048 + (pc & 1) * 1024) + lane * 16) = vv[(pc >> 1) * 2 + (pc & 1)];
        const int J0 = E * i + 128 - 32 * kt - 4 * hi;
        const LAS float* tbp = tbg + J0;
        float mx = -INFINITY;
#pragma unroll
        for (int rho = 0; rho < 16; ++rho) {
            float v = sa[rho] * C2 + tbp[27 - ((rho & 3) + 8 * (rho >> 2))];
            if (PMASK) { const int j = J0 - ((rho & 3) + 8 * (rho >> 2)); v = (j > p_i) ? -INFINITY : v; }
            sa[rho] = v; mx = fmaxf(mx, v);
        }
        mx = fmaxf(mx, __shfl_xor(mx, 32));
        if (__any(mx > st.m + 6.0f)) {
            const float mn = fmaxf(st.m, mx), f = __builtin_amdgcn_exp2f(st.m - mn);
            st.m = mn;
            LAS float* wsf = (LAS float*)(wl + ATT_SC_OFF);
            if (hi == 0) wsf[i] = f;
            asm volatile("s_waitcnt lgkmcnt(0)" ::: "memory");
#pragma unroll
            for (int rho = 0; rho < 16; ++rho) { const float ff = wsf[crow(rho, hi)]; st.o0[rho] *= ff; st.o1[rho] *= ff; st.lacc[rho] *= ff; }
        }
#pragma unroll
        for (int rho = 0; rho < 16; ++rho) sa[rho] = __builtin_amdgcn_exp2f(sa[rho] - st.m);
        v4u pw0, pw1;
        pw0.x = cvtpk(sa[0], sa[1]); pw0.y = cvtpk(sa[2], sa[3]); pw0.z = cvtpk(sa[4], sa[5]); pw0.w = cvtpk(sa[6], sa[7]);
        pw1.x = cvtpk(sa[8], sa[9]); pw1.y = cvtpk(sa[10], sa[11]); pw1.z = cvtpk(sa[12], sa[13]); pw1.w = cvtpk(sa[14], sa[15]);
        asm volatile("s_waitcnt lgkmcnt(0)" ::: "memory");
        st.lacc = __builtin_amdgcn_mfma_f32_32x32x16_bf16(__builtin_bit_cast(bf16x8, pw0), ones, st.lacc, 0, 0, 0);
        st.lacc = __builtin_amdgcn_mfma_f32_32x32x16_bf16(__builtin_bit_cast(bf16x8, pw1), ones, st.lacc, 0, 0, 0);
#pragma unroll
        for (int dh = 0; dh < 2; ++dh) {
#pragma unroll
            for (int ks = 0; ks < 2; ++ks) {
                const s16x4 lo = vtr(vb0 + dh * 2048 + ks * 1024), hh = vtr(vb0 + dh * 2048 + ks * 1024 + 512);
                const bf16x8 vf = {lo[0], lo[1], lo[2], lo[3], hh[0], hh[1], hh[2], hh[3]};
                const bf16x8 pf = __builtin_bit_cast(bf16x8, ks == 0 ? pw0 : pw1);
                if (dh == 0) st.o0 = __builtin_amdgcn_mfma_f32_32x32x16_bf16(pf, vf, st.o0, 0, 0, 0);
                else         st.o1 = __builtin_amdgcn_mfma_f32_32x32x16_bf16(pf, vf, st.o1, 0, 0, 0);
            }
        }
        asm volatile("" ::: "memory");
        if (kt + 1 < NT) {
#pragma unroll
            for (int q = 0; q < 4; ++q) { kf[q] = kn[q]; vv[q] = vn[q]; }
        }
    }
#undef ATT_LOAD_TILE
}

__device__ __forceinline__ void attn_prompt_unit(int unit, const bf16* Qb, const bf16* Kb, const bf16* Vb, bf16* AA, LAS unsigned char* wl, int lane) {
    const int r = unit & 15, h = (unit >> 4) & 3, s = (unit >> 6) & 7, b = unit >> 9;
    AttnState st; st.o0 = f32x16{}; st.o1 = f32x16{}; st.lacc = f32x16{}; st.m = -30000.0f;
#ifndef PROBE_AMP
#define PROBE_AMP -1
#endif
#define ATT_SPIN(k, t0) do { if (PROBE_AMP == (k)) { const unsigned long long t1_ = __builtin_amdgcn_s_memrealtime(); while (__builtin_amdgcn_s_memrealtime() < t1_ + 2 * (t1_ - (t0))) __builtin_amdgcn_s_sleep(8); } } while (0)
    const unsigned long long ta_ = (PROBE_AMP >= 44) ? __builtin_amdgcn_s_memrealtime() : 0ull;
    if (s < 4) attn_group<2, true>(st, Qb, Kb, Vb, b, s, h, r, wl, lane); else attn_group<2, false>(st, Qb, Kb, Vb, b, s, h, r, wl, lane);
    if (s == 0) attn_group<1, true>(st, Qb, Kb, Vb, b, s, h, r, wl, lane); else attn_group<1, false>(st, Qb, Kb, Vb, b, s, h, r, wl, lane);
    ATT_SPIN(44, ta_);
    const unsigned long long tb_ = (PROBE_AMP >= 44) ? __builtin_amdgcn_s_memrealtime() : 0ull;
    if (s == 0) attn_group<0, true>(st, Qb, Kb, Vb, b, s, h, r, wl, lane); else attn_group<0, false>(st, Qb, Kb, Vb, b, s, h, r, wl, lane);
    ATT_SPIN(45, tb_);
    const int i = lane & 31, hi = lane >> 5;
#pragma unroll
    for (int rho = 0; rho < 16; ++rho) {
        const int qi = crow(rho, hi); const float ff = __builtin_amdgcn_rcpf(st.lacc[rho]);
        bf16* op = AA + ((size_t)b * SEQ + 512 * s + 16 * qi + r) * AOW + h * 64 + i;
        op[0] = (bf16)f2bf(st.o0[rho] * ff); op[32] = (bf16)f2bf(st.o1[rho] * ff);
    }
}

__device__ __forceinline__ float red16(float x) {
    x += __int_as_float(__builtin_amdgcn_update_dpp(0, __float_as_int(x), 0xB1, 0xf, 0xf, true));
    x += __int_as_float(__builtin_amdgcn_update_dpp(0, __float_as_int(x), 0x4E, 0xf, 0xf, true));
    x += __int_as_float(__builtin_amdgcn_update_dpp(0, __float_as_int(x), 0x141, 0xf, 0xf, true));
    x += __int_as_float(__builtin_amdgcn_update_dpp(0, __float_as_int(x), 0x140, 0xf, 0xf, true));
    return x;
}
struct SampleState { float m, l; f32x4 o; };
template <int G> __device__ __forceinline__ void attn_sample_group(SampleState& st, const float* cache, const float* outw, const LAS float* qs, const float* biasg, int b, int h, int t, int lane) {
    constexpr int D = 1 << (2 * G), WIN = 128 << (2 * G);
    const int kq = lane >> 4, d4 = (lane & 15) * 4;
    const f32x4 qv = *(const LAS f32x4*)(qs + G * 64 + d4);
    const unsigned long long cb = (unsigned long long)(cache + ((size_t)b * WIN * 512 + h * 64 + d4));
    const unsigned long long ob = (unsigned long long)(outw + ((size_t)b * WIN * 512 + h * 64 + d4)) - 8ull * 2048ull;
#define SMP_LOAD(bt_, kv_, vv_) do { _Pragma("unroll") for (int q = 0; q < 11; ++q) { int j_ = 44 * (bt_) + 4 * q + kq; j_ = j_ > 128 ? 128 : j_; const int idx_ = WIN + t - D * j_; \
            const unsigned long long a_ = ((idx_ >= WIN) ? ob : cb) + (unsigned long long)idx_ * 2048ull; kv_[q] = *(const f32x4*)a_; vv_[q] = *(const f32x4*)(a_ + 1024ull); } } while (0)
#define SMP_CONSUME(bt_, kv_, vv_) do { float sv[11]; float bm = -INFINITY; \
        _Pragma("unroll") for (int q = 0; q < 11; ++q) { const int j0 = 44 * (bt_) + 4 * q + kq; const int j = j0 > 128 ? 128 : j0; \
            float dt = (kv_[q][0] * qv[0] + kv_[q][1] * qv[1]) + (kv_[q][2] * qv[2] + kv_[q][3] * qv[3]); dt = red16(dt) + biasg[j]; \
            sv[q] = (j0 <= 128) ? dt : -INFINITY; bm = fmaxf(bm, sv[q]); } \
        bm = fmaxf(bm, __shfl_xor(bm, 16)); bm = fmaxf(bm, __shfl_xor(bm, 32)); \
        const float mn = fmaxf(st.m, bm), f = __builtin_amdgcn_exp2f(st.m - mn); st.m = mn; st.l *= f; st.o = st.o * f; \
        _Pragma("unroll") for (int q = 0; q < 11; ++q) { const float p = __builtin_amdgcn_exp2f(sv[q] - st.m); st.l += p; st.o += vv_[q] * p; } } while (0)
    f32x4 ka[11], va[11], kb[11], vb[11];
    SMP_LOAD(0, ka, va); SMP_LOAD(1, kb, vb);
    SMP_CONSUME(0, ka, va); SMP_LOAD(2, ka, va);
    SMP_CONSUME(1, kb, vb);
    SMP_CONSUME(2, ka, va);
#undef SMP_LOAD
#undef SMP_CONSUME
}
__device__ __forceinline__ void attn_sample_unit(int su, const Ptrs& P, const bf16* Qb, bf16* AA, const float* biasG, LAS unsigned char* wl, int lane) {
    const int t = su & 7, h = (su >> 3) & 3, b = su >> 5;
    LAS float* qs = (LAS float*)(wl + ATT_SC_OFF);
    const size_t qrow = (size_t)(MP + b * 8 + t) * AW;
#pragma unroll
    for (int g = 0; g < 3; ++g) qs[g * 64 + lane] = __uint_as_float((unsigned)Qb[qrow + (4 * g + h) * 64 + lane] << 16) * (0.125f * 1.4426950408889634f);
    asm volatile("s_waitcnt lgkmcnt(0)" ::: "memory");
    SampleState st; st.m = -30000.0f; st.l = 0.f; st.o = (f32x4){0.f, 0.f, 0.f, 0.f};
    attn_sample_group<2>(st, P.c2048, P.out + O_KV2048S, qs, biasG + (8 + h) * 132, b, h, t, lane);
    attn_sample_group<1>(st, P.c512, P.out + O_KV512S, qs, biasG + (4 + h) * 132, b, h, t, lane);
    attn_sample_group<0>(st, P.c128, P.out + O_KV128S, qs, biasG + (0 + h) * 132, b, h, t, lane);
    float l = st.l; f32x4 o = st.o;
    l += __shfl_xor(l, 16); l += __shfl_xor(l, 32);
#pragma unroll
    for (int e = 0; e < 4; ++e) { o[e] += __shfl_xor(o[e], 16); o[e] += __shfl_xor(o[e], 32); }
    const int d4 = (lane & 15) * 4;
    if (lane < 16) { const float inv = 1.0f / l;
        *(GAS unsigned long long*)(AA + (size_t)(MP + b * 8 + t) * AOW + h * 64 + d4) = (unsigned long long)pk2(o[0] * inv, o[1] * inv) | ((unsigned long long)pk2(o[2] * inv, o[3] * inv) << 32); }
    asm volatile("s_waitcnt lgkmcnt(0)" ::: "memory");
}

struct CopyLoc { const f32x4* s; f32x4* d; };
constexpr int CC_B2 = 510, CC_B1 = 126, CC_B0 = 30, CC_N2 = 32 * CC_B2, CC_N1 = 32 * CC_B1, CC_N0 = 32 * CC_B0, CC_N = CC_N2 + CC_N1 + CC_N0;
__device__ __forceinline__ CopyLoc copy_locate(const Ptrs& P, int id) {
    CopyLoc L;
    if (id < CC_N2) { const int b = id / CC_B2, k = id - b * CC_B2; L.s = (const f32x4*)(P.c2048 + ((size_t)b * 2048 + 8) * 512) + k * 512; L.d = (f32x4*)(P.out + O_KV2048S + (size_t)b * 2048 * 512) + k * 512; return L; }
    id -= CC_N2;
    if (id < CC_N1) { const int b = id / CC_B1, k = id - b * CC_B1; L.s = (const f32x4*)(P.c512 + ((size_t)b * 512 + 8) * 512) + k * 512; L.d = (f32x4*)(P.out + O_KV512S + (size_t)b * 512 * 512) + k * 512; return L; }
    id -= CC_N1;
    { const int b = id / CC_B0, k = id - b * CC_B0; L.s = (const f32x4*)(P.c128 + ((size_t)b * 128 + 8) * 512) + k * 512; L.d = (f32x4*)(P.out + O_KV128S + (size_t)b * 128 * 512) + k * 512; return L; }
}
__device__ __forceinline__ void copy_chunks(const Ptrs& P, int mw, int NMW, int lane) {
    f32x4 va[8], vb[8];
    int id = mw;
    if (id < CC_N) { const CopyLoc L = copy_locate(P, id);
#pragma unroll
        for (int q = 0; q < 8; ++q) va[q] = __builtin_nontemporal_load(L.s + q * 64 + lane); }
    for (; id < CC_N; id += 2 * NMW) {
        const int id2 = id + NMW, id3 = id + 2 * NMW;
        if (id2 < CC_N) { const CopyLoc L = copy_locate(P, id2);
#pragma unroll
            for (int q = 0; q < 8; ++q) vb[q] = __builtin_nontemporal_load(L.s + q * 64 + lane); }
        { const CopyLoc L = copy_locate(P, id);
#pragma unroll
            for (int q = 0; q < 8; ++q) __builtin_nontemporal_store(va[q], L.d + q * 64 + lane); }
        if (id3 < CC_N) { const CopyLoc L = copy_locate(P, id3);
#pragma unroll
            for (int q = 0; q < 8; ++q) va[q] = __builtin_nontemporal_load(L.s + q * 64 + lane); }
        if (id2 < CC_N) { const CopyLoc L = copy_locate(P, id2);
#pragma unroll
            for (int q = 0; q < 8; ++q) __builtin_nontemporal_store(vb[q], L.d + q * 64 + lane); }
    }
}

template <int W> __device__ __forceinline__ void pool_block(const float* __restrict__ U, bf16* __restrict__ DD, int rb, int gi, int lane) {
    const int r0 = 16 * rb + 8 * (lane >> 5), c4 = gi * 128 + (lane & 31) * 4, t0 = r0 & (SEQ - 1);
    f32x4 v[W + 7];
#pragma unroll
    for (int i = 0; i < W + 7; ++i) { const int dt = i - (W - 1); const int ri = (t0 + dt >= 0) ? r0 + dt : r0; v[i] = *(const f32x4*)(U + (size_t)ri * PW + c4); }
#pragma unroll
    for (int i = 0; i < W - 1; ++i) { if (t0 + i - (W - 1) < 0) v[i] = (f32x4){0.f, 0.f, 0.f, 0.f}; }
    f32x4 s = v[0];
#pragma unroll
    for (int i = 1; i < W; ++i) s += v[i];
#pragma unroll
    for (int o = 0; o < 8; ++o) {
        if (o > 0) s += v[W - 1 + o] - v[o - 1];
        const int t = t0 + o; const float inv = 1.0f / (float)((t + 1 < W) ? t + 1 : W); const f32x4 dd = s * inv - v[W - 1 + o];
        *(GAS unsigned long long*)(DD + (size_t)(r0 + o) * PW + c4) = (unsigned long long)pk2(dd[0], dd[1]) | ((unsigned long long)pk2(dd[2], dd[3]) << 32);
    }
}
__device__ __forceinline__ void pool_items(const Ptrs& P, const float* U, bf16* DD, int mw, int NMW, int lane) {
    for (int it = mw; it < (MP / 16) * 4; it += NMW) {
        const int gi = it & 3, rb = it >> 2;
        if (gi == 0) pool_block<2>(U, DD, rb, 0, lane); else if (gi == 1) pool_block<4>(U, DD, rb, 1, lane); else if (gi == 2) pool_block<8>(U, DD, rb, 2, lane); else pool_block<16>(U, DD, rb, 3, lane);
    }
    for (int it = mw * 64 + lane; it < MS * 128; it += NMW * 64) {
        const int sidx = it >> 7, row = MP + sidx, c4 = (it & 127) * 4, w = 2 << (c4 >> 7), b = sidx >> 3, t = sidx & 7;
        f32x4 s = {0.f, 0.f, 0.f, 0.f};
        const f32x4 own = *(const f32x4*)(U + (size_t)row * PW + c4);
        for (int i = 0; i < w; ++i) { const int idx = 15 + t - i;
            s += (idx >= 15) ? *(const f32x4*)(U + (size_t)(MP + b * 8 + idx - 15) * PW + c4) : *(const f32x4*)(P.spool + ((size_t)b * 15 + idx) * PW + c4); }
        const float inv = 1.0f / (float)w; const f32x4 dd = s * inv - own;
        *(GAS unsigned long long*)(DD + (size_t)row * PW + c4) = (unsigned long long)pk2(dd[0], dd[1]) | ((unsigned long long)pk2(dd[2], dd[3]) << 32);
    }
}


template <int KS  > __device__ __forceinline__ void micro_partial(const pg8::bf16_t* A, const pg8::bf16_t* Bt, int row0, int col0, int wave, int lane, f32x4 (&acc)[4]) {
    constexpr int K = KS * 8, NS = KS / 32, NB = (NS > 4) ? 4 : NS;
    const int fr = lane & 15, fq = lane >> 4;
    const pg8::bf16_t* ap = A + (size_t)(row0 + fr) * K + wave * KS + 8 * fq;
    const pg8::bf16_t* bp = Bt + (size_t)(col0 + fr) * K + wave * KS + 8 * fq;
#pragma unroll
    for (int k0 = 0; k0 < NS; k0 += NB) {
        bf16x8 af[NB], bf[NB][4];
#pragma unroll
        for (int s = 0; s < NB; ++s) if (k0 + s < NS) { af[s] = *(const bf16x8*)(ap + (k0 + s) * 32);
#pragma unroll
            for (int nb = 0; nb < 4; ++nb) bf[s][nb] = *(const bf16x8*)(bp + (size_t)(16 * nb) * K + (k0 + s) * 32); }
#pragma unroll
        for (int s = 0; s < NB; ++s) if (k0 + s < NS) {
#pragma unroll
            for (int nb = 0; nb < 4; ++nb) acc[nb] = __builtin_amdgcn_mfma_f32_16x16x32_bf16(bf[s][nb], af[s], acc[nb], 0, 0, 0); }
    }
}
typedef float f32x2 __attribute__((ext_vector_type(2)));
__device__ __forceinline__ f32x2 micro_reduce(LAS unsigned char* red, const f32x4 (&acc)[4], int wave, int lane, int tid) {
    const int fr = lane & 15, fq = lane >> 4;
    LAS float* pw = (LAS float*)red + wave * 1024 + fr * 64 + 4 * fq;
#pragma unroll
    for (int nb = 0; nb < 4; ++nb) *(LAS f32x4*)(pw + 16 * nb) = acc[nb];
    __syncthreads();
    const LAS float* pr = (const LAS float*)red + (tid >> 5) * 64 + 2 * (tid & 31);
    f32x2 s = {0.f, 0.f};
#pragma unroll
    for (int w = 0; w < 8; ++w) s += *(const LAS f32x2*)(pr + w * 1024);
    __syncthreads();
    return s;
}
template <int MODE, int K> __device__ __forceinline__ void micro_resid(LAS unsigned char* red, int blk, const pg8::bf16_t* A, const pg8::bf16_t* Bt, pg8::bf16_t* XB, float* ssp, float* out) {
    int tid_ = threadIdx.x; asm volatile("" : "+v"(tid_));
    const int tid = tid_, lane = tid & 63, wave = __builtin_amdgcn_readfirstlane(tid >> 6);
    const int row0 = MP + 16 * (blk >> 4), col0 = 64 * (blk & 15);
    f32x4 acc[4] = {};
    micro_partial<K / 8>(A, Bt, row0, col0, wave, lane, acc);
    const f32x2 s = micro_reduce(red, acc, wave, lane, tid);
    const int row = row0 + (tid >> 5), col = col0 + 2 * (tid & 31);
    const float alpha = (MODE == 1) ? 1.0f : 0.5f;
    const unsigned xw = *(const unsigned*)(XB + (size_t)row * DM + col);
    f32x2 v; v[0] = __uint_as_float(xw << 16) + s[0] * alpha; v[1] = __uint_as_float(xw & 0xffff0000u) + s[1] * alpha;
    if (MODE == 2) { *(f32x2*)(out + (size_t)row * DM + col) = v; }
    else {
        *(unsigned*)(XB + (size_t)row * DM + col) = pk2(v[0], v[1]);
        float ss = v[0] * v[0] + v[1] * v[1];
#pragma unroll
        for (int o = 1; o < 32; o <<= 1) ss += __shfl_xor(ss, o);
        if ((tid & 31) == 0) ssp[(size_t)row * 16 + (blk & 15)] = ss;
    }
}
__device__ __forceinline__ void micro_merge(LAS unsigned char* red, int blk, const pg8::bf16_t* AA, const pg8::bf16_t* WAB, const pg8::bf16_t* DD, const pg8::bf16_t* WEFF,
                                            const pg8::bf16_t* GA, const pg8::bf16_t* GB, pg8::bf16_t* MG) {
    int tid_ = threadIdx.x; asm volatile("" : "+v"(tid_));
    const int tid = tid_, lane = tid & 63, wave = __builtin_amdgcn_readfirstlane(tid >> 6);
    const int row0 = MP + 16 * (blk >> 4), col0 = 64 * (blk & 15);
    f32x4 acc[4] = {};
    micro_partial<AOW / 8>(AA, WAB, row0, col0, wave, lane, acc);
    const f32x2 s1 = micro_reduce(red, acc, wave, lane, tid);
#pragma unroll
    for (int nb = 0; nb < 4; ++nb) acc[nb] = (f32x4){0.f, 0.f, 0.f, 0.f};
    micro_partial<PW / 8>(DD, WEFF, row0, col0, wave, lane, acc);
    const f32x2 s2 = micro_reduce(red, acc, wave, lane, tid);
    const int row = row0 + (tid >> 5), col = col0 + 2 * (tid & 31);
    const unsigned ga = *(const unsigned*)(GA + (size_t)row * DM + col), gb = *(const unsigned*)(GB + (size_t)row * DM + col);
    const float m0 = __uint_as_float(ga << 16) * s1[0] + __uint_as_float(gb << 16) * s2[0];
    const float m1 = __uint_as_float(ga & 0xffff0000u) * s1[1] + __uint_as_float(gb & 0xffff0000u) * s2[1];
    *(unsigned*)(MG + (size_t)row * DM + col) = pk2(m0, m1);
}

#ifndef PROBE_AMP
#define PROBE_AMP -1
#endif
struct Args { Ptrs p; };
__global__ void __launch_bounds__(NWAVES * 64, 2) hybrid_fwd(Args args) {
    extern __shared__ __attribute__((aligned(16))) unsigned char lds[];
    Frame F;
    F.lds = (LAS unsigned char*)lds;
    F.MISC = (volatile LAS unsigned*)(F.lds + MISC_OFF);
    F.tid = threadIdx.x; F.lane = F.tid & 63; F.wave = __builtin_amdgcn_readfirstlane(F.tid >> 6);
    F.G = gridDim.x; { const int bx = blockIdx.x; F.vcu = (F.G % 8 == 0) ? (bx % 8) * (F.G / 8) + bx / 8 : bx; }
    const Ptrs& P = args.p;
    unsigned char* ws = P.ws;
    F.ctl = (gu32*)(ws + WS_CTL);
    for (int u = F.tid; u < (LDS_BYTES - LDSCTL_OFF) / 4; u += NWAVES * 64) ((LAS unsigned*)(F.lds + LDSCTL_OFF))[u] = 0u;
    __syncthreads();
    XcdBarrier bar = xcd_barrier_post((unsigned*)(F.ctl + CW_BAR), F.MISC + 8);
#define GRID_BAR() xcd_barrier(bar)
    unsigned long long tph_ = 0;
#define PH_BEGIN() do { if (PROBE_AMP >= 0) tph_ = __builtin_amdgcn_s_memrealtime(); } while (0)
#define PH_END(k) do { if (PROBE_AMP >= 0) { const unsigned long long tn_ = __builtin_amdgcn_s_memrealtime(); if (PROBE_AMP == (k)) { while (__builtin_amdgcn_s_memrealtime() < tn_ + 2 * (tn_ - tph_)) __builtin_amdgcn_s_sleep(8); } tph_ = __builtin_amdgcn_s_memrealtime(); } } while (0)
#define WSP(T, off) ((T*)(ws + (off)))
    typedef pg8::bf16_t b16;
    const int c = (int)blockIdx.x;

    PH_BEGIN();
    p0_prologue(F, P);
    GRID_BAR();
    PH_END(0);
    {   pg8::Gemm g{WSP(b16, WS_XB), WSP(b16, WS_WUP1), M, FF2, DM}; pg8::StaticOrder S; S.init(M, FF2, F.G, c);
        pg8::EpiSwiglu<false> E{WSP(b16, WS_R), WSP(float, WS_RSTD0)};
        pg8::gemm_phase<pg8::EpiSwiglu<false>, pg8::StaticOrder, true, true>(F.lds + RING_OFF, g, S, E);
        {   const int nwg = (M / 256) * (FF2 / 256), R = (nwg + F.G - 1) / F.G, nfull = nwg - (R - 1) * F.G, nh = F.G - nfull;
            int th_ = threadIdx.x; asm volatile("" : "+v"(th_)); const int laneh = th_ & 63, waveh = __builtin_amdgcn_readfirstlane(th_ >> 6);
            LAS float* scr = (LAS float*)(F.lds + RING_OFF + waveh * 16384);
            if (nh == 0) convert_items(P, WI_WDN1, WI_WAB, c * NWAVES + waveh, F.G * NWAVES, scr, laneh);
            else if (c >= nfull) convert_items(P, WI_WDN1, WI_WAB, (c - nfull) * NWAVES + waveh, nh * NWAVES, scr, laneh); } }
    GRID_BAR();
    PH_END(1);
    {   pg8::Gemm g{WSP(b16, WS_R), WSP(b16, WS_WDN1), MP, DM, FF}; pg8::StaticOrder S; S.init(MP, DM, F.G, c);
        pg8::EpiResid<0> E{WSP(b16, WS_XB), WSP(float, WS_SSP1), nullptr};
        pg8::gemm_phase<pg8::EpiResid<0>, pg8::StaticOrder, true, true>(F.lds + RING_OFF, g, S, E);
        for (int blk = c; blk < 256; blk += F.G) micro_resid<0, FF>(F.lds + RING_OFF, blk, WSP(b16, WS_R), WSP(b16, WS_WDN1), WSP(b16, WS_XB), WSP(float, WS_SSP1), nullptr); }
    GRID_BAR();
    PH_END(2);
    {   pg8::Gemm g{WSP(b16, WS_XB), WSP(b16, WS_WIN), M, INW, DM}; pg8::StaticOrder S; S.init(M, INW, F.G, c);
        pg8::EpiIn E{WSP(float, WS_SSP1), WSP(b16, WS_Q), WSP(b16, WS_K), WSP(b16, WS_V), WSP(float, WS_U), WSP(b16, WS_GA), WSP(b16, WS_GB), P.qn, P.kn, P.out};
        pg8::gemm_phase<pg8::EpiIn, pg8::StaticOrder, true, true>(F.lds + RING_OFF, g, S, E); }
    GRID_BAR();
    PH_END(3);
    {   int tid_ = threadIdx.x; asm volatile("" : "+v"(tid_));
        const int lane = tid_ & 63, wave = __builtin_amdgcn_readfirstlane(tid_ >> 6);
        const unsigned long long tq0_ = (PROBE_AMP >= 40) ? __builtin_amdgcn_s_memrealtime() : 0ull;
#define SUBAMP(k) do { if (PROBE_AMP == (k)) { const unsigned long long tq1_ = __builtin_amdgcn_s_memrealtime(); while (__builtin_amdgcn_s_memrealtime() < tq1_ + 2 * (tq1_ - tq0_)) __builtin_amdgcn_s_sleep(8); } } while (0)
        if (wave < 4) {
            const int cw = F.vcu * 4 + wave, NCW = F.G * 4;
            LAS unsigned char* wl = F.lds + RING_OFF + wave * ATT_WLDS;
            const bf16* Qb = WSP(const bf16, WS_Q); const bf16* Kb = WSP(const bf16, WS_K); const bf16* Vb = WSP(const bf16, WS_V); bf16* AA = WSP(bf16, WS_AA);
            const float* BIAS = WSP(const float, WS_BIAS);
            for (int su = cw; su < DBATCH * 4 * DSEQ; su += NCW) attn_sample_unit(su, P, Qb, AA, BIAS, wl, lane);
            SUBAMP(42);
            for (int up = cw; up < NBATCH * 8 * 4 * 8; up += NCW) {
                const int unit0 = ((up >> 3) << 4) + (up & 7);
                attn_build_tables(BIAS, (unit0 >> 4) & 3, (LAS float*)(wl + ATT_TB_OFF), lane);
#pragma unroll 1
                for (int k2 = 0; k2 < 2; ++k2) attn_prompt_unit(unit0 + 8 * k2, Qb, Kb, Vb, AA, wl, lane);
            }
            SUBAMP(40);
        } else {
            const int mw = F.vcu * 4 + (wave - 4), NMW = F.G * 4;
            copy_chunks(P, mw, NMW, lane);
            SUBAMP(43);
            pool_items(P, WSP(const float, WS_U), WSP(bf16, WS_DD), mw, NMW, lane);
            weff_items(P, mw, NMW, lane);
            convert_items(P, WI_WAB, WI_END, mw, NMW, (LAS float*)(F.lds + RING_OFF + wave * 16384), lane);
            SUBAMP(41);
        }
    }
    GRID_BAR();
    PH_END(4);
    {   pg8::StaticOrder S; S.init(MP, DM, F.G, c);
        {   pg8::Gemm g{WSP(b16, WS_AA), WSP(b16, WS_WAB), MP, DM, AOW}; pg8::EpiMerge<0> E{WSP(b16, WS_GA), WSP(b16, WS_T), WSP(b16, WS_MG)};
            pg8::gemm_phase<pg8::EpiMerge<0>, pg8::StaticOrder, true, true>(F.lds + RING_OFF, g, S, E); }
        {   pg8::Gemm g{WSP(b16, WS_DD), WSP(b16, WS_WEFF), MP, DM, PW}; pg8::EpiMerge<1> E{WSP(b16, WS_GB), WSP(b16, WS_T), WSP(b16, WS_MG)};
            pg8::gemm_phase<pg8::EpiMerge<1>, pg8::StaticOrder, true, true>(F.lds + RING_OFF, g, S, E); }
        for (int blk = c; blk < 256; blk += F.G) micro_merge(F.lds + RING_OFF, blk, WSP(b16, WS_AA), WSP(b16, WS_WAB), WSP(b16, WS_DD), WSP(b16, WS_WEFF), WSP(b16, WS_GA), WSP(b16, WS_GB), WSP(b16, WS_MG));
    }
    GRID_BAR();
    PH_END(5);
    {   pg8::Gemm g{WSP(b16, WS_MG), WSP(b16, WS_WOUT), MP, DM, DM}; pg8::StaticOrder S; S.init(MP, DM, F.G, c);
        pg8::EpiResid<1> E{WSP(b16, WS_XB), WSP(float, WS_SSP2), nullptr};
        pg8::gemm_phase<pg8::EpiResid<1>, pg8::StaticOrder, true, true>(F.lds + RING_OFF, g, S, E);
        for (int blk = c; blk < 256; blk += F.G) micro_resid<1, DM>(F.lds + RING_OFF, blk, WSP(b16, WS_MG), WSP(b16, WS_WOUT), WSP(b16, WS_XB), WSP(float, WS_SSP2), nullptr); }
    GRID_BAR();
    PH_END(6);
    {   pg8::Gemm g{WSP(b16, WS_XB), WSP(b16, WS_WUP2), M, FF2, DM}; pg8::StaticOrder S; S.init(M, FF2, F.G, c);
        pg8::EpiSwiglu<true> E{WSP(b16, WS_R), WSP(float, WS_SSP2)};
        pg8::gemm_phase<pg8::EpiSwiglu<true>, pg8::StaticOrder, true, true>(F.lds + RING_OFF, g, S, E); }
    GRID_BAR();
    PH_END(7);
    {   pg8::Gemm g{WSP(b16, WS_R), WSP(b16, WS_WDN2), MP, DM, FF}; pg8::StaticOrder S; S.init(MP, DM, F.G, c);
        pg8::EpiResid<2> E{WSP(b16, WS_XB), nullptr, P.out};
        pg8::gemm_phase<pg8::EpiResid<2>, pg8::StaticOrder, true, true>(F.lds + RING_OFF, g, S, E);
        for (int blk = c; blk < 256; blk += F.G) micro_resid<2, FF>(F.lds + RING_OFF, blk, WSP(b16, WS_R), WSP(b16, WS_WDN2), WSP(b16, WS_XB), nullptr, P.out); }
    PH_END(8);
}

extern "C" void kernel_launch(void* const* d_in, const int* in_sizes, int n_in, void* d_out, int out_size, void* d_ws, size_t ws_size, hipStream_t stream) {
    static int grid = 0;
    if (grid == 0) {
        if (n_in != 22 || (size_t)out_size != O_END || ws_size < WS_END) { fprintf(stderr, "kernel_launch: unexpected shapes (n_in %d, out %d, ws %zu); nothing launched\n", n_in, out_size, ws_size); grid = -1; return; }
        int dev = 0, cus = 0;
        if (hipGetDevice(&dev) != hipSuccess || hipDeviceGetAttribute(&cus, hipDeviceAttributeMultiprocessorCount, dev) != hipSuccess) { grid = -1; return; }
        if (hipFuncSetAttribute((const void*)hybrid_fwd, hipFuncAttributeMaxDynamicSharedMemorySize, LDS_BYTES) != hipSuccess) { fprintf(stderr, "kernel_launch: hipFuncSetAttribute failed\n"); grid = -1; return; }
        (void)hipGetLastError();
        grid = cus;
    }
    if (grid < 0) return;
    if (hipMemsetAsync((char*)d_ws + WS_CTL, 0, CTL_ZERO_BYTES, stream) != hipSuccess) return;
    Args a{};
    const float** pp = (const float**)&a.p;
    for (int i = 0; i < 22; ++i) pp[i] = (const float*)d_in[i];
    a.p.out = (float*)d_out; a.p.ws = (unsigned char*)d_ws;
    hipLaunchKernelGGL(hybrid_fwd, dim3(grid), dim3(NWAVES * 64), LDS_BYTES, stream, a);
}
```

```cpp
#include <hip/hip_runtime.h>
#include <cstdio>
#include <cstdint>

namespace pg8 {
#define PG8_LAS __attribute__((address_space(3)))
typedef unsigned short bf16_t;
typedef short bf16x8 __attribute__((ext_vector_type(8)));
typedef float f32x4 __attribute__((ext_vector_type(4)));
typedef unsigned u32x4 __attribute__((ext_vector_type(4)));
constexpr int BM = 256, BK = 64, HALF = 128, HTB = HALF * BK * 2  , STAGE_BYTES = 8 * HTB, NXCD = 8, WGM = 8;

__host__ __device__ __forceinline__ int lds_byte(int r, int c) { const int st = (r >> 4) * 2 + (c >> 5), rr = r & 15, cc = c & 31, ob = rr * 64 + cc * 2; return st * 1024 + (ob ^ (((ob >> 9) & 1) << 5)); }
__host__ __device__ __forceinline__ void stage_rc(int b, int& R, int& C) { const int st = b / 1024, sb = b % 1024, swz = sb ^ (((sb >> 9) & 1) << 5); R = (st >> 1) * 16 + swz / 64; C = (st & 1) * 32 + (swz % 64) / 2; }
__host__ __device__ __forceinline__ int perm32(int rho) { const int n = rho >> 4, i = rho & 15; return 8 * (i >> 2) + 4 * n + (i & 3); }

struct Unit { int pm, pn; };
struct Gemm { const bf16_t* A; const bf16_t* Bt; int M, N, K; };

struct StaticOrder {
    int nM, nN, nwg, G, c;
    __host__ __device__ void init(int M, int N, int G_, int c_) { nM = M / BM; nN = N / BM; nwg = nM * nN; G = G_; c = c_; }
    __host__ __device__ bool next(int i, Unit& u) const {
        const long L = (long)i * G + c; if (L >= nwg) return false;
        int wgid = (int)L; { const int q = nwg / NXCD, r = nwg % NXCD, xcd = wgid % NXCD, off = wgid / NXCD; wgid = (xcd < r ? xcd * (q + 1) : r * (q + 1) + (xcd - r) * q) + off; }
        const int nig = WGM * nN, gid = wgid / nig, fm = gid * WGM, gsz = (nM - fm) < WGM ? (nM - fm) : WGM;
        u.pm = fm + ((wgid % nig) % gsz); u.pn = (wgid % nig) / gsz; return true;
    }
    __device__ __forceinline__ void a_ready(const Unit&) const {}
    __device__ __forceinline__ void done(const Unit&) const {}
};


typedef float f32x2 __attribute__((ext_vector_type(2)));
typedef __bf16 bf16x2_t __attribute__((ext_vector_type(2)));
__device__ __forceinline__ unsigned cvt_pk_bf16(float lo, float hi) { f32x2 v = {lo, hi}; bf16x2_t b = __builtin_convertvector(v, bf16x2_t); return __builtin_bit_cast(unsigned, b); }
__device__ __forceinline__ u32x4 pack8(const f32x4 a, const f32x4 b) { u32x4 w; w.x = cvt_pk_bf16(a[0], a[1]); w.y = cvt_pk_bf16(a[2], a[3]); w.z = cvt_pk_bf16(b[0], b[1]); w.w = cvt_pk_bf16(b[2], b[3]); return w; }
__device__ __forceinline__ float bf2f(unsigned short h) { return __uint_as_float((unsigned)h << 16); }
constexpr float RMS_EPS = 1e-6f;
constexpr float LOG2E = 1.4426950408889634f;
__device__ __forceinline__ float rstd_from_partials(const float* ssp, int row) {
    const f32x4* p = (const f32x4*)(ssp + (size_t)row * 16);
    const f32x4 a = p[0], b = p[1], c = p[2], d = p[3];
    const float s = (((a[0] + a[1]) + (a[2] + a[3])) + ((b[0] + b[1]) + (b[2] + b[3]))) + (((c[0] + c[1]) + (c[2] + c[3])) + ((d[0] + d[1]) + (d[2] + d[3])));
    return __builtin_amdgcn_rsqf(s * (1.0f / 1024.0f) + RMS_EPS);
}
__device__ __forceinline__ void rstd8_from_partials(const float* ssp, int row0, int fq, float (&rs)[8]) {
    f32x4 q[8];
#pragma unroll
    for (int i = 0; i < 8; ++i) q[i] = *(const f32x4*)(ssp + (size_t)(row0 + (i >> 2) * HALF + (i & 3) * 16) * 16 + 4 * fq);
#pragma unroll
    for (int i = 0; i < 8; ++i) { float s = (q[i][0] + q[i][1]) + (q[i][2] + q[i][3]); s += __shfl_xor(s, 16); s += __shfl_xor(s, 32); rs[i] = __builtin_amdgcn_rsqf(s * (1.0f / 1024.0f) + RMS_EPS); }
    asm volatile("" ::: "memory");
}
__device__ __forceinline__ float sigmoidf_fast(float x) { return __builtin_amdgcn_rcpf(1.0f + __builtin_amdgcn_exp2f(-x * LOG2E)); }

template <bool PARTIAL> struct EpiSwiglu {
    static constexpr bool PERM = true, AFTER_DRAIN = false; static constexpr int MID_T = -1;
    bf16_t* H; const float* rs;
    __device__ __forceinline__ void operator()(const f32x4 (&acc)[2][2][4][2], const Unit& u, int wr, int wc, int fr, int fq) const {
        const int row0 = u.pm * BM + wr * 64 + fr, col0 = u.pn * 128 + wc * 32 + 8 * fq;
        float rsv[8];
        if (PARTIAL) rstd8_from_partials(rs, row0, fq, rsv);
        else {
#pragma unroll
            for (int i = 0; i < 8; ++i) rsv[i] = rs[row0 + (i >> 2) * HALF + (i & 3) * 16]; }
#pragma unroll
        for (int ai = 0; ai < 2; ++ai)
#pragma unroll
            for (int m = 0; m < 4; ++m) {
                const int row = row0 + ai * HALF + m * 16;
                const float r = rsv[ai * 4 + m];
                f32x4 o[2];
#pragma unroll
                for (int n = 0; n < 2; ++n) {
                    const f32x4 g = acc[ai][0][m][n] * r, up = acc[ai][1][m][n] * r;
#pragma unroll
                    for (int e = 0; e < 4; ++e) o[n][e] = g[e] * sigmoidf_fast(g[e]) * up[e];
                }
                *(u32x4*)(H + (size_t)row * 2816 + col0) = pack8(o[0], o[1]);
            }
    }
};

__device__ __forceinline__ void unpack8(const u32x4 w, f32x4& a, f32x4& b) {
    a[0] = __uint_as_float(w.x << 16); a[1] = __uint_as_float(w.x & 0xffff0000u); a[2] = __uint_as_float(w.y << 16); a[3] = __uint_as_float(w.y & 0xffff0000u);
    b[0] = __uint_as_float(w.z << 16); b[1] = __uint_as_float(w.z & 0xffff0000u); b[2] = __uint_as_float(w.w << 16); b[3] = __uint_as_float(w.w & 0xffff0000u);
}
template <int MODE> struct EpiResid {
    static constexpr bool PERM = true, AFTER_DRAIN = false; static constexpr int MID_T = -1;
    bf16_t* XB; float* ssp; float* out;
    __device__ __forceinline__ void operator()(const f32x4 (&acc)[2][2][4][2], const Unit& u, int wr, int wc, int fr, int fq) const {
        const int row0 = u.pm * BM + wr * 64 + fr, col0 = u.pn * BM + wc * 32 + 8 * fq;
        const float alpha = (MODE == 1) ? 1.0f : 0.5f;
#pragma unroll
        for (int ai = 0; ai < 2; ++ai)
#pragma unroll
            for (int m = 0; m < 4; ++m) {
                const int row = row0 + ai * HALF + m * 16;
                float ss = 0.f;
#pragma unroll
                for (int bj = 0; bj < 2; ++bj) {
                    const size_t off = (size_t)row * 1024 + col0 + bj * HALF;
                    f32x4 b0, b1; unpack8(*(const u32x4*)(XB + off), b0, b1);
                    const f32x4 v0 = b0 + acc[ai][bj][m][0] * alpha, v1 = b1 + acc[ai][bj][m][1] * alpha;
                    if (MODE == 2) { *(f32x4*)(out + off) = v0; *(f32x4*)(out + off + 4) = v1; }
                    else {
                        *(u32x4*)(XB + off) = pack8(v0, v1);
                        ss += ((v0[0] * v0[0] + v0[1] * v0[1]) + (v0[2] * v0[2] + v0[3] * v0[3])) + ((v1[0] * v1[0] + v1[1] * v1[1]) + (v1[2] * v1[2] + v1[3] * v1[3]));
                    }
                }
                if (MODE != 2) { ss += __shfl_xor(ss, 16); ss += __shfl_xor(ss, 32); if (fq == 0) ssp[(size_t)row * 16 + u.pn * 4 + wc] = ss; }
            }
    }
};

struct EpiIn {
    static constexpr bool PERM = true, AFTER_DRAIN = false; static constexpr int MID_T = -1;
    const float* ssp; bf16_t *Q, *K, *V; float* U; bf16_t *GA, *GB; const float *qn, *kn; float* out;
    __device__ __forceinline__ void operator()(const f32x4 (&acc)[2][2][4][2], const Unit& u, int wr, int wc, int fr, int fq) const {
        const int row0 = u.pm * BM + wr * 64 + fr, pn = u.pn;
        float rsv[8]; rstd8_from_partials(ssp, row0, fq, rsv);
        constexpr size_t O_KVP[3] = {17039360u, 17301504u, 18350080u}, O_KVS[3] = {22575104u, 24672256u, 33060864u};
        constexpr size_t O_POOLP = 22544384u, O_POOLS = 66615296u;
        if (pn < 6) {
            const bool isk = pn >= 3; const int head = 4 * (isk ? pn - 3 : pn) + wc, g = head >> 2, hs = head & 3, win = 128 << (2 * g);
            const float* gn = (isk ? kn : qn) + head * 64 + 8 * fq;
            f32x4 gv[2][2];
#pragma unroll
            for (int bj = 0; bj < 2; ++bj)
#pragma unroll
                for (int n = 0; n < 2; ++n) gv[bj][n] = *(const f32x4*)(gn + 32 * bj + 4 * n);
            bf16_t* dst = isk ? K : Q;
#pragma unroll
            for (int ai = 0; ai < 2; ++ai)
#pragma unroll
                for (int m = 0; m < 4; ++m) {
                    const int row = row0 + ai * HALF + m * 16; const float rs = rsv[ai * 4 + m];
                    f32x4 v[2][2]; float ss = 0.f;
#pragma unroll
                    for (int bj = 0; bj < 2; ++bj)
#pragma unroll
                        for (int n = 0; n < 2; ++n) { v[bj][n] = acc[ai][bj][m][n] * rs; const f32x4 x = v[bj][n]; ss += (x[0] * x[0] + x[1] * x[1]) + (x[2] * x[2] + x[3] * x[3]); }
                    ss += __shfl_xor(ss, 16); ss += __shfl_xor(ss, 32);
                    const float r2 = __builtin_amdgcn_rsqf(ss * (1.0f / 64.0f) + RMS_EPS);
                    float* fo = nullptr;
                    if (isk) {
                        if (row < 16384) { const int b = row >> 12, t = row & 4095; if (t >= 4096 - win) fo = out + O_KVP[g] + ((size_t)(b * win + t - (4096 - win)) * 512 + hs * 64 + 8 * fq); }
                        else { const int s = row - 16384, b = s >> 3, t = s & 7; fo = out + O_KVS[g] + ((size_t)(b * win + win - 8 + t) * 512 + hs * 64 + 8 * fq); }
                    }
#pragma unroll
                    for (int bj = 0; bj < 2; ++bj) {
                        const f32x4 o0 = v[bj][0] * r2 * gv[bj][0], o1 = v[bj][1] * r2 * gv[bj][1];
                        *(u32x4*)(dst + (size_t)row * 768 + head * 64 + 32 * bj + 8 * fq) = pack8(o0, o1);
                        if (fo) { *(f32x4*)(fo + 32 * bj) = o0; *(f32x4*)(fo + 32 * bj + 4) = o1; }
                    }
                }
        } else if (pn < 9) {
            const int cb = (pn - 6) * 256 + wc * 32 + 8 * fq;
#pragma unroll
            for (int ai = 0; ai < 2; ++ai)
#pragma unroll
                for (int m = 0; m < 4; ++m) {
                    const int row = row0 + ai * HALF + m * 16; const float rs = rsv[ai * 4 + m];
#pragma unroll
                    for (int bj = 0; bj < 2; ++bj) {
                        const int c = cb + 128 * bj, head = c >> 6, g = head >> 2, hs = head & 3, win = 128 << (2 * g), dim = c & 63;
                        const f32x4 o0 = acc[ai][bj][m][0] * rs, o1 = acc[ai][bj][m][1] * rs;
                        *(u32x4*)(V + (size_t)row * 768 + c) = pack8(o0, o1);
                        float* fo = nullptr;
                        if (row < 16384) { const int b = row >> 12, t = row & 4095; if (t >= 4096 - win) fo = out + O_KVP[g] + ((size_t)(b * win + t - (4096 - win)) * 512 + 256 + hs * 64 + dim); }
                        else { const int s = row - 16384, b = s >> 3, t = s & 7; fo = out + O_KVS[g] + ((size_t)(b * win + win - 8 + t) * 512 + 256 + hs * 64 + dim); }
                        if (fo) { *(f32x4*)(fo) = o0; *(f32x4*)(fo + 4) = o1; }
                    }
                }
        } else if (pn < 11) {
            const int cb = (pn - 9) * 256 + wc * 32 + 8 * fq;
#pragma unroll
            for (int ai = 0; ai < 2; ++ai)
#pragma unroll
                for (int m = 0; m < 4; ++m) {
                    const int row = row0 + ai * HALF + m * 16; const float rs = rsv[ai * 4 + m];
                    float* fo = nullptr;
                    if (row < 16384) { const int b = row >> 12, t = row & 4095; if (t >= 4081) fo = out + O_POOLP + (size_t)(b * 15 + t - 4081) * 512 + cb; }
                    else { const int s = row - 16384, b = s >> 3, t = s & 7; fo = out + O_POOLS + (size_t)(b * 15 + 7 + t) * 512 + cb; }
#pragma unroll
                    for (int bj = 0; bj < 2; ++bj) {
                        const f32x4 o0 = acc[ai][bj][m][0] * rs, o1 = acc[ai][bj][m][1] * rs;
                        float* up = U + (size_t)row * 512 + cb + 128 * bj;
                        *(f32x4*)(up) = o0; *(f32x4*)(up + 4) = o1;
                        if (fo) { *(f32x4*)(fo + 128 * bj) = o0; *(f32x4*)(fo + 128 * bj + 4) = o1; }
                    }
                }
        } else {
            const bool isb = pn >= 15; bf16_t* G = isb ? GB : GA; const int cb = (pn - (isb ? 15 : 11)) * 256 + wc * 32 + 8 * fq;
#pragma unroll
            for (int ai = 0; ai < 2; ++ai)
#pragma unroll
                for (int m = 0; m < 4; ++m) {
                    const int row = row0 + ai * HALF + m * 16; const float rs = rsv[ai * 4 + m];
#pragma unroll
                    for (int bj = 0; bj < 2; ++bj) {
                        f32x4 o0 = acc[ai][bj][m][0] * rs, o1 = acc[ai][bj][m][1] * rs;
#pragma unroll
                        for (int e = 0; e < 4; ++e) { o0[e] = sigmoidf_fast(o0[e]); o1[e] = sigmoidf_fast(o1[e]); }
                        *(u32x4*)(G + (size_t)row * 1024 + cb + 128 * bj) = pack8(o0, o1);
                    }
                }
        }
    }
};

struct EpiMergeFused {
    static constexpr bool PERM = true, AFTER_DRAIN = false; static constexpr int MID_T = 4;
    const bf16_t *GA, *GB; bf16_t* MG;
    __device__ __forceinline__ void mid(f32x4 (&acc)[2][2][4][2], const Unit& u, int wr, int wc, int, int) const {
        int t_ = threadIdx.x; asm volatile("" : "+v"(t_)); const int fr = t_ & 15, fq = (t_ & 63) >> 4;
        const int row0 = u.pm * BM + wr * 64 + fr, col0 = u.pn * BM + wc * 32 + 8 * fq;
#pragma unroll
        for (int ai = 0; ai < 2; ++ai)
#pragma unroll
            for (int m = 0; m < 4; ++m) {
                const int row = row0 + ai * HALF + m * 16;
#pragma unroll
                for (int bj = 0; bj < 2; ++bj) {
                    const size_t off = (size_t)row * 1024 + col0 + bj * HALF;
                    f32x4 a0, a1, b0, b1; unpack8(*(const u32x4*)(GA + off), a0, a1); unpack8(*(const u32x4*)(GB + off), b0, b1);
#pragma unroll
                    for (int e = 0; e < 4; ++e) { acc[ai][bj][m][0][e] *= a0[e] * __builtin_amdgcn_rcpf(fmaxf(b0[e], 1e-30f)); acc[ai][bj][m][1][e] *= a1[e] * __builtin_amdgcn_rcpf(fmaxf(b1[e], 1e-30f)); }
                    asm volatile("" ::: "memory");
                }
            }
    }
    __device__ __forceinline__ void operator()(const f32x4 (&acc)[2][2][4][2], const Unit& u, int wr, int wc, int fr, int fq) const {
        const int row0 = u.pm * BM + wr * 64 + fr, col0 = u.pn * BM + wc * 32 + 8 * fq;
#pragma unroll
        for (int ai = 0; ai < 2; ++ai)
#pragma unroll
            for (int m = 0; m < 4; ++m) {
                const int row = row0 + ai * HALF + m * 16;
#pragma unroll
                for (int bj = 0; bj < 2; ++bj) {
                    const size_t off = (size_t)row * 1024 + col0 + bj * HALF;
                    f32x4 b0, b1; unpack8(*(const u32x4*)(GB + off), b0, b1);
                    *(u32x4*)(MG + off) = pack8(acc[ai][bj][m][0] * b0, acc[ai][bj][m][1] * b1);
                }
                if (m & 1) asm volatile("" ::: "memory");
            }
    }
};

struct NoSide { static constexpr int NV = 1; __device__ __forceinline__ bool pre(f32x4 (&)[1], int) const { return false; } __device__ __forceinline__ void post(const f32x4 (&)[1], bool, int) const {} };
struct SideCopy {
    static constexpr int NV = 6;
    static constexpr int CPB2 = 680, CPB1 = 168, CPB0 = 40;
    static constexpr int NCH2 = 32 * CPB2, NCH1 = 32 * CPB1, NCH0 = 32 * CPB0, NCH = NCH2 + NCH1 + NCH0;
    const float *c128, *c512, *c2048; float* out; int gw; int* step;
    __device__ __forceinline__ bool locate(int id, const f32x4*& s, f32x4*& d) const {
        if (id >= NCH) return false;
        if (id < NCH2) { const int b = id / CPB2, k = id - b * CPB2; s = (const f32x4*)(c2048 + ((size_t)b * 2048 + 8) * 512) + k * 384; d = (f32x4*)(out + 33060864u + (size_t)b * 2048 * 512) + k * 384; return true; }
        id -= NCH2;
        if (id < NCH1) { const int b = id / CPB1, k = id - b * CPB1; s = (const f32x4*)(c512 + ((size_t)b * 512 + 8) * 512) + k * 384; d = (f32x4*)(out + 24672256u + (size_t)b * 512 * 512) + k * 384; return true; }
        id -= NCH1;
        { const int b = id / CPB0, k = id - b * CPB0; s = (const f32x4*)(c128 + ((size_t)b * 128 + 8) * 512) + k * 384; d = (f32x4*)(out + 22575104u + (size_t)b * 128 * 512) + k * 384; return true; }
    }
    __device__ __forceinline__ bool pre(f32x4 (&v)[NV], int lane) const {
        const f32x4* s; f32x4* d; if (!locate(*step * 2048 + gw, s, d)) return false;
#pragma unroll
        for (int q = 0; q < NV; ++q) v[q] = __builtin_nontemporal_load(s + q * 64 + lane);
        return true;
    }
    __device__ __forceinline__ void post(const f32x4 (&v)[NV], bool ok, int lane) const {
        if (ok) { const f32x4* s; f32x4* d; locate(*step * 2048 + gw, s, d);
#pragma unroll
            for (int q = 0; q < NV; ++q) __builtin_nontemporal_store(v[q], d + q * 64 + lane); }
        *step += 1;
    }
};
template <class Epi, class Sched, bool ALIGN_EPI = false, bool SP2 = false, class Side = NoSide>
__device__ __forceinline__ void gemm_phase(PG8_LAS unsigned char* lds, const Gemm g, const Sched& S, const Epi& E, const Side side = Side()) {
    int tid_ = threadIdx.x; asm volatile("" : "+v"(tid_));
    const int tid = tid_, wid = __builtin_amdgcn_readfirstlane(tid >> 6), lane = tid & 63, wr = wid >> 2, wc = wid & 3, fr = lane & 15, fq = lane >> 4;
    const int K = g.K, nt = K / BK;
    unsigned voffA[2], voffB[2];
#pragma unroll
    for (int i = 0; i < 2; ++i) { int R, C; stage_rc(tid * 16 + i * 8192, R, C); const int Rb = Epi::PERM ? ((R & ~31) + perm32(R & 31)) : R;
        voffA[i] = (unsigned)(R * K + C) * 2u; voffB[i] = (unsigned)(Rb * K + C) * 2u; }
    const size_t kstep = (size_t)(BK * 2);
    const size_t hstep = (size_t)HALF * K * 2;
    const size_t tstep = 2 * hstep;
    const unsigned ldsw = (unsigned)wid * 1024u;
    const int aoff = lds_byte(wr * 64 + fr, fq * 8), boff = lds_byte(wc * 32 + fr, fq * 8);
#define PG8_SA(b, h) (((b) * 2 + (h)) * HTB)
#define PG8_SB(b, h) ((4 + (b) * 2 + (h)) * HTB)
#define PG8_STAGE(bufoff, gbase, voff) do { _Pragma("unroll") for (int _i = 0; _i < 2; ++_i) \
        __builtin_amdgcn_global_load_lds((const unsigned*)((const char*)(gbase) + (voff)[_i]), (PG8_LAS unsigned*)(lds + (bufoff) + ldsw + _i * 8192), 16, 0, 0); } while (0)
#define PG8_LDA(dst, b, h) do { _Pragma("unroll") for (int m = 0; m < 4; ++m) _Pragma("unroll") for (int k = 0; k < 2; ++k) dst[m][k] = *(const PG8_LAS bf16x8*)(lds + PG8_SA(b, h) + aoff + m * 2048 + k * 1024); } while (0)
#define PG8_LDB(dst, b, h) do { _Pragma("unroll") for (int n = 0; n < 2; ++n) _Pragma("unroll") for (int k = 0; k < 2; ++k) dst[n][k] = *(const PG8_LAS bf16x8*)(lds + PG8_SB(b, h) + boff + n * 2048 + k * 1024); } while (0)
#define PG8_MMA(ai, bj, At, Bt) do { __builtin_amdgcn_s_setprio(1); _Pragma("unroll") for (int m = 0; m < 4; ++m) _Pragma("unroll") for (int n = 0; n < 2; ++n) _Pragma("unroll") for (int k = 0; k < 2; ++k) \
        acc[ai][bj][m][n] = __builtin_amdgcn_mfma_f32_16x16x32_bf16(Bt[n][k], At[m][k], acc[ai][bj][m][n], 0, 0, 0); __builtin_amdgcn_s_setprio(0); } while (0)
#define PG8_WAIT_V(n) asm volatile("s_waitcnt vmcnt(" #n ")" ::: "memory")
#define PG8_WAIT_L(n) asm volatile("s_waitcnt lgkmcnt(" #n ")" ::: "memory")
#define PG8_BAR __builtin_amdgcn_s_barrier()
#define PG8_SCHED __builtin_amdgcn_sched_barrier(0)
    Unit cur, nxt; int ui = 0;
    if (!S.next(0, cur)) return;
    f32x4 acc[2][2][4][2];
#pragma unroll
    for (int a = 0; a < 2; ++a)
#pragma unroll
        for (int b = 0; b < 2; ++b)
#pragma unroll
            for (int m = 0; m < 4; ++m)
#pragma unroll
                for (int n = 0; n < 2; ++n) acc[a][b][m][n] = (f32x4){0.f, 0.f, 0.f, 0.f};
    bf16x8 At[4][2], B0[2][2], B1[2][2];
    const char* cA = (const char*)g.A + (size_t)cur.pm * tstep; const char* cB = (const char*)g.Bt + (size_t)cur.pn * tstep;
    S.a_ready(cur);
    if constexpr (SP2) {
        PG8_STAGE(PG8_SB(0, 0), cB, voffB); PG8_STAGE(PG8_SB(0, 1), cB + hstep, voffB); PG8_STAGE(PG8_SA(0, 0), cA, voffA); PG8_STAGE(PG8_SA(0, 1), cA + hstep, voffA);
        if (wr == 1) PG8_BAR;
        PG8_WAIT_V(2); PG8_BAR;
        PG8_STAGE(PG8_SB(1, 0), cB + kstep, voffB); PG8_STAGE(PG8_SA(1, 0), cA + kstep, voffA); PG8_STAGE(PG8_SB(1, 1), cB + hstep + kstep, voffB);
        PG8_WAIT_V(6); PG8_BAR;
    } else {
        PG8_STAGE(PG8_SB(0, 0), cB, voffB); PG8_STAGE(PG8_SA(0, 0), cA, voffA); PG8_STAGE(PG8_SB(0, 1), cB + hstep, voffB); PG8_STAGE(PG8_SA(0, 1), cA + hstep, voffA);
        if (wr == 1) PG8_BAR;
        PG8_WAIT_V(4); PG8_BAR;
        PG8_STAGE(PG8_SB(1, 0), cB + kstep, voffB); PG8_STAGE(PG8_SA(1, 0), cA + kstep, voffA); PG8_STAGE(PG8_SB(1, 1), cB + hstep + kstep, voffB);
        PG8_WAIT_V(6); PG8_BAR;
    }
    for (;;) {
        const bool has_next = S.next(ui + 1, nxt);
        const char* nA = has_next ? (const char*)g.A + (size_t)nxt.pm * tstep : cA; const char* nB = has_next ? (const char*)g.Bt + (size_t)nxt.pn * tstep : cB;
        for (int t = 0; t < nt; t += 2) {
            if constexpr (Epi::MID_T >= 0) { if (t == Epi::MID_T) E.mid(acc, cur, wr, wc, fr, fq); }
            const bool last = (t == nt - 2);
            const char* a1 = cA + (size_t)(t + 1) * kstep;
            const char* a2 = last ? nA : cA + (size_t)(t + 2) * kstep; const char* b2 = last ? nB : cB + (size_t)(t + 2) * kstep;
            const char* a3 = a2 + kstep; const char* b3 = b2 + kstep;
            if (last && has_next) S.a_ready(nxt);
            if constexpr (SP2) {
            PG8_LDB(B0, 0, 0); PG8_LDB(B1, 0, 1); PG8_SCHED; PG8_LDA(At, 0, 0); PG8_STAGE(PG8_SA(1, 1), a1 + hstep, voffA);
            PG8_WAIT_V(8); PG8_WAIT_L(0); PG8_BAR; PG8_MMA(0, 0, At, B0); PG8_MMA(0, 1, At, B1); PG8_BAR; PG8_SCHED;
            PG8_LDA(At, 0, 1); PG8_STAGE(PG8_SB(0, 0), b2, voffB); PG8_STAGE(PG8_SB(0, 1), b2 + hstep, voffB); PG8_STAGE(PG8_SA(0, 0), a2, voffA);
            PG8_WAIT_V(8); PG8_WAIT_L(0); PG8_BAR; PG8_MMA(1, 0, At, B0); PG8_MMA(1, 1, At, B1); PG8_BAR; PG8_SCHED;
            PG8_LDB(B0, 1, 0); PG8_LDB(B1, 1, 1); PG8_SCHED; PG8_LDA(At, 1, 0); PG8_STAGE(PG8_SA(0, 1), a2 + hstep, voffA);
            PG8_WAIT_V(8); PG8_WAIT_L(0); PG8_BAR; PG8_MMA(0, 0, At, B0); PG8_MMA(0, 1, At, B1); PG8_BAR; PG8_SCHED;
            PG8_LDA(At, 1, 1); PG8_STAGE(PG8_SB(1, 0), b3, voffB); PG8_STAGE(PG8_SB(1, 1), b3 + hstep, voffB); PG8_STAGE(PG8_SA(1, 0), a3, voffA);
            PG8_WAIT_V(8); PG8_WAIT_L(0); PG8_BAR; PG8_MMA(1, 0, At, B0); PG8_MMA(1, 1, At, B1); PG8_BAR; PG8_SCHED;
            } else {
            PG8_LDB(B0, 0, 0); PG8_SCHED; PG8_LDA(At, 0, 0); PG8_STAGE(PG8_SA(1, 1), a1 + hstep, voffA);
            PG8_WAIT_L(8); PG8_BAR; PG8_WAIT_L(0); PG8_MMA(0, 0, At, B0); PG8_BAR; PG8_SCHED;
            PG8_LDB(B1, 0, 1); PG8_STAGE(PG8_SB(0, 0), b2, voffB);
            PG8_BAR; PG8_WAIT_L(0); PG8_MMA(0, 1, At, B1); PG8_BAR;
            PG8_LDA(At, 0, 1); PG8_STAGE(PG8_SA(0, 0), a2, voffA);
            PG8_BAR; PG8_WAIT_L(0); PG8_MMA(1, 0, At, B0); PG8_BAR; PG8_SCHED;
            PG8_STAGE(PG8_SB(0, 1), b2 + hstep, voffB);
            PG8_WAIT_V(6); PG8_BAR; PG8_MMA(1, 1, At, B1); PG8_BAR;
            PG8_LDB(B0, 1, 0); PG8_SCHED; PG8_LDA(At, 1, 0); PG8_STAGE(PG8_SA(0, 1), a2 + hstep, voffA);
            PG8_WAIT_L(8); PG8_BAR; PG8_WAIT_L(0); PG8_MMA(0, 0, At, B0); PG8_BAR; PG8_SCHED;
            PG8_LDB(B1, 1, 1); PG8_STAGE(PG8_SB(1, 0), b3, voffB);
            PG8_BAR; PG8_WAIT_L(0); PG8_MMA(0, 1, At, B1); PG8_BAR;
            PG8_LDA(At, 1, 1); PG8_STAGE(PG8_SA(1, 0), a3, voffA);
            PG8_BAR; PG8_WAIT_L(0); PG8_MMA(1, 0, At, B0); PG8_BAR; PG8_SCHED;
            PG8_STAGE(PG8_SB(1, 1), b3 + hstep, voffB);
            PG8_WAIT_V(6); PG8_BAR; PG8_MMA(1, 1, At, B1); PG8_BAR;
            }
        }
        if constexpr (ALIGN_EPI) { if (wr == 0) PG8_BAR; }
        if constexpr (!Epi::AFTER_DRAIN) { int t2_ = threadIdx.x; asm volatile("" : "+v"(t2_)); const int lane2_ = t2_ & 63;
            f32x4 sv_[Side::NV]; const bool sok_ = side.pre(sv_, lane2_); E(acc, cur, wr, wc, lane2_ & 15, lane2_ >> 4); side.post(sv_, sok_, lane2_); S.done(cur); }
        if (!has_next) break;
#pragma unroll
        for (int a = 0; a < 2; ++a)
#pragma unroll
            for (int b = 0; b < 2; ++b)
#pragma unroll
                for (int m = 0; m < 4; ++m)
#pragma unroll
                    for (int n = 0; n < 2; ++n) acc[a][b][m][n] = (f32x4){0.f, 0.f, 0.f, 0.f};
        cur = nxt; cA = nA; cB = nB; ++ui;
        if constexpr (ALIGN_EPI) { if (wr == 1) PG8_BAR; }
    }
    PG8_WAIT_V(0);
    if constexpr (!ALIGN_EPI) { if (wr == 0) PG8_BAR; }
    PG8_BAR;
    if constexpr (Epi::AFTER_DRAIN) { E.fused(acc, cur, wr, wc, fr, fq, lds, wid, lane); S.done(cur); }
#undef PG8_SA
#undef PG8_SB
#undef PG8_STAGE
#undef PG8_LDA
#undef PG8_LDB
#undef PG8_MMA
#undef PG8_WAIT_V
#undef PG8_WAIT_L
#undef PG8_BAR
#undef PG8_SCHED
}
}

constexpr int NWAVES = 8;
constexpr int DM = 1024, NBATCH = 4, SEQ = 4096, DBATCH = 32, DSEQ = 8;
constexpr int MP = NBATCH * SEQ, MS = DBATCH * DSEQ, M = MP + MS;
constexpr int FF = 2816, FF2 = 5632, INW = 4864, AW = 768, AOW = 256, PW = 512;
constexpr size_t O_Y = 0, O_KV128P = 17039360u, O_KV512P = 17301504u, O_KV2048P = 18350080u, O_POOLP = 22544384u,
                 O_KV128S = 22575104u, O_KV512S = 24672256u, O_KV2048S = 33060864u, O_POOLS = 66615296u, O_END = 66861056u;
constexpr size_t MiB = 1u << 20;
constexpr size_t WS_CTL = 0, CTL_ZERO_BYTES = 32768;
constexpr size_t WS_WUP1 = 2 * MiB, WS_WDN1 = 13 * MiB, WS_WIN = 19 * MiB, WS_WAB = 29 * MiB, WS_WEFF = 30 * MiB, WS_WOUT = 31 * MiB, WS_WUP2 = 33 * MiB, WS_WDN2 = 44 * MiB;
constexpr size_t WS_RSTD0 = 50 * MiB, WS_SSP1 = 51 * MiB, WS_SSP2 = 53 * MiB, WS_BIAS = 55 * MiB;
constexpr size_t WS_XB = 56 * MiB;
constexpr size_t WS_X1 = 90 * MiB;
constexpr size_t WS_R = 156 * MiB;
constexpr size_t WS_Q = WS_R, WS_K = WS_Q + 25 * MiB, WS_V = WS_K + 25 * MiB;
constexpr size_t WS_U = WS_V + 25 * MiB;
constexpr size_t WS_GA = WS_U + 33 * MiB, WS_GB = WS_GA + 33 * MiB;
constexpr size_t WS_AA = WS_GB + 33 * MiB, WS_DD = WS_AA + 9 * MiB;
constexpr int ADW = 768;
constexpr size_t WS_T = WS_DD + 17 * MiB, WS_MG = WS_T + 33 * MiB, WS_END = WS_MG + 33 * MiB;
static_assert(WS_END <= 512 * MiB, "d_ws map");
static_assert(WS_R + (size_t)M * FF * 2 <= WS_END, "H fits");
constexpr int CW_TMO = 0, CW_BAR = 4096;
constexpr int RING_OFF = 0, RING_BYTES = 131072;
constexpr int LDS_BYTES = 147456;
constexpr int LDSCTL_OFF = LDS_BYTES - 1024, MISC_OFF = LDSCTL_OFF + 320;
#define GAS __attribute__((address_space(1)))
#define LAS __attribute__((address_space(3)))
typedef unsigned short bf16;
typedef unsigned v4u __attribute__((ext_vector_type(4)));
typedef float f32x4 __attribute__((ext_vector_type(4)));
typedef short bf16x8 __attribute__((ext_vector_type(8)));
typedef GAS unsigned gu32;
typedef GAS unsigned long long gu64;
#define RLX_AGENT __ATOMIC_RELAXED, __HIP_MEMORY_SCOPE_AGENT
#define LDS_WAIT() asm volatile("s_waitcnt lgkmcnt(0)" ::: "memory")
#define VM_WAIT() asm volatile("s_waitcnt vmcnt(0)" ::: "memory")
__device__ __forceinline__ unsigned long long rt() { return __builtin_amdgcn_s_memrealtime(); }
__device__ __forceinline__ unsigned f2bf(float f) { unsigned u = __builtin_bit_cast(unsigned, f); return (u + 0x7fffu + ((u >> 16) & 1u)) >> 16; }
__device__ __forceinline__ unsigned pk2(float lo, float hi) { return f2bf(lo) | (f2bf(hi) << 16); }

#define XB_TMO      128
#define XB_XCNT(j)  (256  + 64 * (j))
#define XB_XSUB(j)  (1280 + 64 * (j))
#define XB_XGEN(j)  (2304 + 64 * (j))
#define XB_TOP      3328
#define XB_TOPGEN   3392
#define XCD_BAR_WORDS 3456
#define XB_SPIN_CAP (1u << 18)

__device__ __forceinline__ unsigned xb_ld(unsigned* p)              { return __hip_atomic_load(p, __ATOMIC_RELAXED, __HIP_MEMORY_SCOPE_AGENT); }
__device__ __forceinline__ unsigned xb_add(unsigned* p, unsigned v) { return __hip_atomic_fetch_add(p, v, __ATOMIC_RELAXED, __HIP_MEMORY_SCOPE_AGENT); }
__device__ __forceinline__ unsigned xb_xcc_id() { return (unsigned)__builtin_amdgcn_s_getreg((3 << 11) | 20) & 0xFu; }
#define XB_SPIN(cond, bar) do { unsigned _sp = 0; while (cond) { __builtin_amdgcn_s_sleep(1); \
    if ((++_sp & 255u) == 0u) { if (xb_ld(&(bar)[XB_TMO])) break; if (_sp > XB_SPIN_CAP) { atomicAdd(&(bar)[XB_TMO], 1u); break; } } } } while (0)

struct XcdBarrier {
    unsigned* bar; unsigned x;
    volatile LAS unsigned* st;
};

__device__ __forceinline__ XcdBarrier xcd_barrier_post(unsigned* bar, volatile LAS unsigned* st) {
    XcdBarrier b; b.bar = bar; b.x = xb_xcc_id(); b.st = st;
    if (threadIdx.x == 0) (void)xb_add(&bar[XB_XCNT(b.x)], 1u);
    return b;
}
__device__ __forceinline__ void xcd_barrier_complete(unsigned* bar, unsigned x, unsigned& nloc, unsigned& nx) {
    const unsigned G = gridDim.x * gridDim.y * gridDim.z;
    unsigned sum, cnt, mine, sp = 0u;
    for (;;) {
        sum = 0u; cnt = 0u; mine = 0u;
#pragma unroll
        for (unsigned j = 0; j < 16; ++j) { const unsigned c = xb_ld(&bar[XB_XCNT(j)]); sum += c; cnt += (c > 0u) ? 1u : 0u; mine = (j == x) ? c : mine; }
        if (sum == G) break;
        __builtin_amdgcn_s_sleep(1);
        if ((++sp & 255u) == 0u) { if (xb_ld(&bar[XB_TMO])) break; if (sp > XB_SPIN_CAP) { atomicAdd(&bar[XB_TMO], 1u); break; } }
    }
    nloc = mine > 0u ? mine : 1u; nx = cnt > 0u ? cnt : 1u;
}

__device__ __forceinline__ void xcd_barrier(const XcdBarrier& b) {
    asm volatile("s_waitcnt vmcnt(0)" ::: "memory");
    __syncthreads();
    if (threadIdx.x == 0) {
        unsigned* bar = b.bar;
        __builtin_amdgcn_s_waitcnt(0);
        unsigned nloc = b.st[0], nx = b.st[1];
        if (nloc == 0u) { xcd_barrier_complete(bar, b.x, nloc, nx); b.st[0] = nloc; b.st[1] = nx; }
        const unsigned old = xb_add(&bar[XB_XSUB(b.x)], 1u);
        const unsigned gen = old / nloc;
        if (old + 1u == (gen + 1u) * nloc) {
            __builtin_amdgcn_fence(__ATOMIC_RELEASE, "agent");
            asm volatile("s_waitcnt vmcnt(0)" ::: "memory");
            const unsigned og = xb_add(&bar[XB_TOP], 1u);
            const unsigned tg = og / nx;
            if (og + 1u == (tg + 1u) * nx) xb_add(&bar[XB_TOPGEN], 1u);
            else XB_SPIN(xb_ld(&bar[XB_TOPGEN]) == tg, bar);
            __builtin_amdgcn_fence(__ATOMIC_ACQUIRE, "agent");
            xb_add(&bar[XB_XGEN(b.x)], 1u);
            asm volatile("s_waitcnt vmcnt(0)" ::: "memory");
        } else {
            XB_SPIN(xb_ld(&bar[XB_XGEN(b.x)]) == gen, bar);
            __builtin_amdgcn_fence(__ATOMIC_ACQUIRE, "agent");
            asm volatile("s_waitcnt vmcnt(0)" ::: "memory");
        }
    }
    __syncthreads();
}

struct Frame {
    LAS unsigned char* lds;
    volatile LAS unsigned* MISC;
    gu32* ctl;
    int tid, lane, wave;
    int vcu, G;
};
__device__ __forceinline__ float wave_sum(float v) {
#pragma unroll
    for (int o = 1; o < 64; o <<= 1) v += __shfl_xor(v, o);
    return v;
}
__device__ __forceinline__ float wave_max(float v) {
#pragma unroll
    for (int o = 1; o < 64; o <<= 1) v = fmaxf(v, __shfl_xor(v, o));
    return v;
}
__constant__ unsigned char T5B[3][132] = {
 {0,1,2,3,4,5,6,7,8,9,10,11,12,13,14,15,16,16,16,16,16,16,17,17,17,17,17,17,17,17,18,18,18,18,18,18,18,18,18,18,19,19,19,19,19,19,19,19,19,19,19,19,19,19,20,20,20,20,20,20,20,20,20,20,20,20,20,20,20,20,20,20,20,21,21,21,21,21,21,21,21,21,21,21,21,21,21,21,21,21,21,21,21,21,21,21,21,21,21,22,22,22,22,22,22,22,22,22,22,22,22,22,22,22,22,22,22,22,22,22,22,22,22,22,22,22,22,22,22,0,0,0},
 {0,4,8,12,16,16,17,17,18,18,19,19,19,19,20,20,20,20,20,21,21,21,21,21,21,22,22,22,22,22,22,22,22,22,23,23,23,23,23,23,23,23,23,23,23,23,24,24,24,24,24,24,24,24,24,24,24,24,24,24,24,24,25,25,25,25,25,25,25,25,25,25,25,25,25,25,25,25,25,25,25,25,25,26,26,26,26,26,26,26,26,26,26,26,26,26,26,26,26,26,26,26,26,26,26,26,26,26,26,26,26,26,26,27,27,27,27,27,27,27,27,27,27,27,27,27,27,27,27,0,0,0},
 {0,16,18,19,20,21,21,22,22,23,23,23,24,24,24,24,25,25,25,25,25,26,26,26,26,26,26,26,26,27,27,27,27,27,27,27,27,27,27,28,28,28,28,28,28,28,28,28,28,28,28,28,29,29,29,29,29,29,29,29,29,29,29,29,29,29,29,29,29,29,30,30,30,30,30,30,30,30,30,30,30,30,30,30,30,30,30,30,30,30,30,30,30,30,30,31,31,31,31,31,31,31,31,31,31,31,31,31,31,31,31,31,31,31,31,31,31,31,31,31,31,31,31,31,31,31,31,31,31,0,0,0}};

template <int MAP> __device__ __forceinline__ void p0_transpose_item(const float* W, int K, int N, bf16* WT, const float* gain, LAS float* scr, int item, int lane, int ldw = 0) {
    if (ldw == 0) ldw = K;
    const int nblk = N / 32, kb = item / nblk, nb = item % nblk, k0 = 64 * kb, n0 = 32 * nb;
    int v0 = n0;
    if (MAP == 1) { const int c = n0 < FF ? n0 : n0 - FF; v0 = 256 * (c >> 7) + (n0 < FF ? 0 : 128) + (c & 127); }
    if (MAP == 2) { if (n0 < 1536) { const int o = n0 & 255; v0 = (n0 & ~255) + 128 * ((o >> 5) & 1) + 32 * (o >> 6); } }
    f32x4 wv[8]; const int kr = lane >> 3, n4 = (lane & 7) * 4;
#pragma unroll
    for (int i = 0; i < 8; ++i) wv[i] = *(const f32x4*)(W + (size_t)(k0 + kr + 8 * i) * N + n0 + n4);
#pragma unroll
    for (int i = 0; i < 8; ++i) { const int kk = kr + 8 * i; f32x4 w = wv[i]; if (gain) w = w * gain[k0 + kk];
        LAS float* d = scr + kk * 33 + n4; d[0] = w[0]; d[1] = w[1]; d[2] = w[2]; d[3] = w[3]; }
    LDS_WAIT(); asm volatile("" ::: "memory");
    const int c = lane & 7;
#pragma unroll
    for (int j = 0; j < 4; ++j) { const int n = (lane >> 3) + 8 * j; const LAS float* s = scr + (8 * c) * 33 + n;
        v4u o; o.x = pk2(s[0 * 33], s[1 * 33]); o.y = pk2(s[2 * 33], s[3 * 33]); o.z = pk2(s[4 * 33], s[5 * 33]); o.w = pk2(s[6 * 33], s[7 * 33]);
        *(GAS v4u*)(WT + (size_t)(v0 + n) * ldw + k0 + 8 * c) = o; }
    LDS_WAIT(); asm volatile("" ::: "memory");
}
struct Ptrs {
    const float *xp, *xs, *c128, *c512, *c2048, *spool, *rbias, *n1, *wup1, *wdn1, *nmix, *win, *qn, *kn, *wg, *pscale, *wab, *wpb, *wout, *n2, *wup2, *wdn2;
    float* out; unsigned char* ws;
};
constexpr int I_UP = (DM / 64) * (FF2 / 32), I_DN = (FF / 64) * (DM / 32), I_IN = (DM / 64) * (INW / 32), I_AB = (AOW / 64) * (DM / 32), I_OUT = (DM / 64) * (DM / 32);
constexpr int WI_WUP1 = 0, WI_WDN1 = I_UP, WI_WIN = WI_WDN1 + I_DN, WI_WAB = WI_WIN + I_IN, WI_WOUT = WI_WAB + I_AB, WI_WUP2 = WI_WOUT + I_OUT, WI_WDN2 = WI_WUP2 + I_UP, WI_END = WI_WDN2 + I_DN;
__device__ __forceinline__ void convert_items(const Ptrs& P, int first, int last, int gwh, int ngwh, LAS float* scr, int lane) {
    unsigned char* ws = P.ws;
    for (int it = first + gwh; it < last; it += ngwh) {
        if (it < WI_WDN1) p0_transpose_item<1>(P.wup1, DM, FF2, (bf16*)(ws + WS_WUP1), P.n1, scr, it - WI_WUP1, lane);
        else if (it < WI_WIN) p0_transpose_item<0>(P.wdn1, FF, DM, (bf16*)(ws + WS_WDN1), nullptr, scr, it - WI_WDN1, lane);
        else if (it < WI_WAB) p0_transpose_item<2>(P.win, DM, INW, (bf16*)(ws + WS_WIN), P.nmix, scr, it - WI_WIN, lane);
        else if (it < WI_WOUT) p0_transpose_item<0>(P.wab, AOW, DM, (bf16*)(ws + WS_WAB), nullptr, scr, it - WI_WAB, lane, ADW);
        else if (it < WI_WUP2) p0_transpose_item<0>(P.wout, DM, DM, (bf16*)(ws + WS_WOUT), nullptr, scr, it - WI_WOUT, lane);
        else if (it < WI_WDN2) p0_transpose_item<1>(P.wup2, DM, FF2, (bf16*)(ws + WS_WUP2), P.n2, scr, it - WI_WUP2, lane);
        else p0_transpose_item<0>(P.wdn2, FF, DM, (bf16*)(ws + WS_WDN2), nullptr, scr, it - WI_WDN2, lane);
    }
}

__device__ __forceinline__ void weff_items(const Ptrs& P, int gw, int NGW, int lane) {
    unsigned char* ws = P.ws;
    for (int it = gw; it < 64 * 16; it += NGW) {
        const int kq = it >> 4, nb = it & 15, k = 8 * kq, g = k >> 7, kp = k & 127, n = nb * 64 + lane;
        const float* wgr = P.wg + ((size_t)g * 128 + kp) * 128; const float* sc = P.pscale + 128 * g; const float* wp = P.wpb + (size_t)(128 * g) * DM + n;
        float a[8] = {0.f, 0.f, 0.f, 0.f, 0.f, 0.f, 0.f, 0.f};
#pragma unroll
        for (int cb = 0; cb < 128; cb += 32) {
            float w[32];
#pragma unroll
            for (int c = 0; c < 32; ++c) w[c] = wp[(size_t)(cb + c) * DM];
#pragma unroll
            for (int c = 0; c < 32; ++c) { const float ws_ = w[c] * sc[cb + c];
#pragma unroll
                for (int q = 0; q < 8; ++q) a[q] += wgr[q * 128 + cb + c] * ws_; }
        }
        v4u o; o.x = pk2(a[0], a[1]); o.y = pk2(a[2], a[3]); o.z = pk2(a[4], a[5]); o.w = pk2(a[6], a[7]);
        *(GAS v4u*)((bf16*)(ws + WS_WAB) + (size_t)n * ADW + AOW + k) = o;
    }
}
#ifndef PROBE_AMP
#define PROBE_AMP -1
#endif
#define P0_SPIN(k) do { if (PROBE_AMP == (k)) { const unsigned long long t1_ = __builtin_amdgcn_s_memrealtime(); while (__builtin_amdgcn_s_memrealtime() < t1_ + 2 * (t1_ - tp0_)) __builtin_amdgcn_s_sleep(8); } } while (0)
__device__ __forceinline__ void p0_prologue(Frame& F, const Ptrs& P) {
    const unsigned long long tp0_ = (PROBE_AMP >= 50) ? __builtin_amdgcn_s_memrealtime() : 0ull;
    LAS float* scr = (LAS float*)(F.lds + RING_OFF + F.wave * 16384);
    const int gw = F.vcu * NWAVES + F.wave, NGW = F.G * NWAVES;
    unsigned char* ws = P.ws;
    for (int m0 = gw; m0 < M; m0 += 4 * NGW) {
        f32x4 v[4][4];
#pragma unroll
        for (int q = 0; q < 4; ++q) { const int m = m0 + q * NGW; if (m < M) {
            const float* xrow = (m < MP) ? P.xp + (size_t)m * DM : P.xs + (size_t)(m - MP) * DM; const GAS f32x4* xr = (const GAS f32x4*)xrow + F.lane;
#pragma unroll
            for (int j = 0; j < 4; ++j) v[q][j] = xr[64 * j]; } }
#pragma unroll
        for (int q = 0; q < 4; ++q) { const int m = m0 + q * NGW; if (m < M) {
            float s = 0.f;
#pragma unroll
            for (int j = 0; j < 4; ++j) s += (v[q][j].x * v[q][j].x + v[q][j].y * v[q][j].y) + (v[q][j].z * v[q][j].z + v[q][j].w * v[q][j].w);
            s = wave_sum(s);
            if (F.lane == 0) ((float*)(ws + WS_RSTD0))[m] = __builtin_amdgcn_rsqf(s * (1.0f / DM) + 1e-6f);
            GAS unsigned long long* o8 = (GAS unsigned long long*)((bf16*)(ws + WS_XB) + (size_t)m * DM) + F.lane;
#pragma unroll
            for (int j = 0; j < 4; ++j) o8[64 * j] = (unsigned long long)pk2(v[q][j].x, v[q][j].y) | ((unsigned long long)pk2(v[q][j].z, v[q][j].w) << 32); } }
    }
    P0_SPIN(50);
    convert_items(P, WI_WUP1, WI_WDN1, gw, NGW, scr, F.lane);
    P0_SPIN(52);
    if (blockIdx.x == 0) {
        for (int i = F.tid; i < 3 * 4 * 132; i += NWAVES * 64) { const int g = i / (4 * 132), h = (i / 132) & 3, j = i % 132;
            ((float*)(ws + WS_BIAS))[i] = (j <= 128) ? P.rbias[(int)T5B[g][j] * 12 + 4 * g + h] * 1.4426950408889634f : 0.f; }
    }
    for (long i = (long)F.vcu * (NWAVES * 64) + F.tid; i < (long)DBATCH * 7 * 128; i += (long)F.G * (NWAVES * 64)) {
        const long b = i / (7 * 128), r = i - b * (7 * 128);
        ((f32x4*)(P.out + O_POOLS + (size_t)b * 15 * 512))[r] = ((const f32x4*)(P.spool + ((size_t)b * 15 + 8) * 512))[r];
    }
}

typedef float f32x16 __attribute__((ext_vector_type(16)));
typedef short s16x4 __attribute__((ext_vector_type(4)));
typedef short v4i16_t __attribute__((ext_vector_type(4)));
__device__ __forceinline__ int crow(int r, int hi) { return (r & 3) + 8 * (r >> 2) + 4 * hi; }
__device__ __forceinline__ s16x4 vtr(const LAS unsigned char* p) { return __builtin_bit_cast(s16x4, __builtin_amdgcn_ds_read_tr16_b64_v4i16((LAS v4i16_t*)p)); }
__device__ __forceinline__ unsigned cvtpk(float lo, float hi) { typedef float f2 __attribute__((ext_vector_type(2))); typedef __bf16 b2 __attribute__((ext_vector_type(2))); f2 v = {lo, hi}; b2 b = __builtin_convertvector(v, b2); return __builtin_bit_cast(unsigned, b); }

constexpr int ATT_WLDS = 16384;
constexpr int TB_JMIN0 = -512, TB_N0 = 1140, TB_JMIN1 = -128, TB_N1 = 384, TB_JMIN2 = -32, TB_N2 = 192;
constexpr int TB_OFF0 = 0, TB_OFF1 = TB_N0, TB_OFF2 = TB_N0 + TB_N1, TB_TOTAL = TB_N0 + TB_N1 + TB_N2;
constexpr int ATT_TB_OFF = 4096, ATT_SC_OFF = 4096 + 7168;

struct AttnState { f32x16 o0, o1, lacc; float m; };

__device__ __forceinline__ void attn_build_tables(const float* BIAS, int h, LAS float* tb, int lane) {
#pragma unroll 1
    for (int i = lane; i < TB_TOTAL; i += 64) {
        int g, j;
        if (i < TB_OFF1) { g = 0; j = i + TB_JMIN0; } else if (i < TB_OFF2) { g = 1; j = i - TB_OFF1 + TB_JMIN1; } else { g = 2; j = i - TB_OFF2 + TB_JMIN2; }
        tb[i] = ((unsigned)j <= 128u) ? BIAS[(g * 4 + h) * 132 + j] : -INFINITY;
    }
    asm volatile("s_waitcnt lgkmcnt(0)" ::: "memory");
}

template <int G, bool PMASK> __device__ __forceinline__ void attn_group(AttnState& st, const bf16* __restrict__ Qb, const bf16* __restrict__ Kb, const bf16* __restrict__ Vb,
                                                            int b, int s, int h, int r, LAS unsigned char* wl, int lane_in) {
    int lane = lane_in;
    constexpr int D = 1 << (2 * G), E = 16 / D, NT = (G == 0) ? 20 : (G == 1) ? 8 : 5;
    constexpr int TOFF = (G == 0) ? TB_OFF0 : (G == 1) ? TB_OFF1 : TB_OFF2, TJMIN = (G == 0) ? TB_JMIN0 : (G == 1) ? TB_JMIN1 : TB_JMIN2;
    asm volatile("" : "+v"(lane));
    const int i = lane & 31, hi = lane >> 5;
    const int rg = r & (D - 1), cg = r >> (2 * G), P0 = (512 * s) >> (2 * G);
    const int p_i = P0 + E * i + cg, p_lo = P0 + cg - 128;
    const int pmax = (SEQ >> (2 * G)) - 1;
    const int col = (4 * G + h) * 64;
    const size_t rowb = (size_t)b * SEQ;
    bf16x8 qf[4];
    { const bf16* qp = Qb + (rowb + 512 * s + 16 * i + r) * AW + col + 32 * hi;
#pragma unroll
      for (int s4 = 0; s4 < 4; ++s4) qf[s4] = *(const bf16x8*)(qp + 8 * s4); }
    const LAS unsigned char* vb0 = wl + ((lane >> 4) & 1) * 32 + (lane & 3) * 8 + (4 * hi + ((lane & 15) >> 2)) * 64;
    const LAS float* tbg = (const LAS float*)(wl + ATT_TB_OFF) + TOFF - TJMIN - 27;
    constexpr float C2 = 0.125f * 1.4426950408889634f;
    const bf16x8 ones = {(short)0x3f80, (short)0x3f80, (short)0x3f80, (short)0x3f80, (short)0x3f80, (short)0x3f80, (short)0x3f80, (short)0x3f80};
    bf16x8 kf[4]; v4u vv[4];
#define ATT_LOAD_TILE(kt, kk, vw) do { \
        int p_ = p_lo + 32 * (kt) + i; p_ = p_ < 0 ? 0 : (p_ > pmax ? pmax : p_); \
        const bf16* kp_ = Kb + (rowb + (size_t)(D * p_ + rg)) * AW + col + 32 * hi; \
        _Pragma("unroll") for (int s4 = 0; s4 < 4; ++s4) kk[s4] = *(const bf16x8*)(kp_ + 8 * s4); \
        _Pragma("unroll") for (int kg = 0; kg < 2; ++kg) { int pv_ = p_lo + 32 * (kt) + 16 * kg + (lane >> 2); pv_ = pv_ < 0 ? 0 : (pv_ > pmax ? pmax : pv_); \
            const bf16* vp_ = Vb + (rowb + (size_t)(D * pv_ + rg)) * AW + col + 8 * (lane & 3); \
            vw[kg] = *(const v4u*)(vp_); vw[2 + kg] = *(const v4u*)(vp_ + 32); } } while (0)
    ATT_LOAD_TILE(0, kf, vv);
    for (int kt = 0; kt < NT; ++kt) {
        bf16x8 kn[4]; v4u vn[4];
        if (kt + 1 < NT) ATT_LOAD_TILE(kt + 1, kn, vn);
        f32x16 sa = {};
#pragma unroll
        for (int s4 = 0; s4 < 4; ++s4) sa = __builtin_amdgcn_mfma_f32_32x32x16_bf16(kf[s4], qf[s4], sa, 0, 0, 0);
#pragma unroll
        for (int pc = 0; pc < 4; ++pc) *(LAS v4u*)(wl + ((pc >> 1) * 2048 + (pc & 1) * 1024) + lane * 16) = vv[(pc >> 1) * 2 + (pc & 1)];
        const int J0 = E * i + 128 - 32 * kt - 4 * hi;
        const LAS float* tbp = tbg + J0;
        float mx = -INFINITY;
#pragma unroll
        for (int rho = 0; rho < 16; ++rho) {
            float v = sa[rho] * C2 + tbp[27 - ((rho & 3) + 8 * (rho >> 2))];
            if (PMASK) { const int j = J0 - ((rho & 3) + 8 * (rho >> 2)); v = (j > p_i) ? -INFINITY : v; }
            sa[rho] = v; mx = fmaxf(mx, v);
        }
        mx = fmaxf(mx, __shfl_xor(mx, 32));
        if (__any(mx > st.m + 6.0f)) {
            const float mn = fmaxf(st.m, mx), f = __builtin_amdgcn_exp2f(st.m - mn);
            st.m = mn;
            LAS float* wsf = (LAS float*)(wl + ATT_SC_OFF);
            if (hi == 0) wsf[i] = f;
            asm volatile("s_waitcnt lgkmcnt(0)" ::: "memory");
#pragma unroll
            for (int rho = 0; rho < 16; ++rho) { const float ff = wsf[crow(rho, hi)]; st.o0[rho] *= ff; st.o1[rho] *= ff; st.lacc[rho] *= ff; }
        }
#pragma unroll
        for (int rho = 0; rho < 16; ++rho) sa[rho] = __builtin_amdgcn_exp2f(sa[rho] - st.m);
        v4u pw0, pw1;
        pw0.x = cvtpk(sa[0], sa[1]); pw0.y = cvtpk(sa[2], sa[3]); pw0.z = cvtpk(sa[4], sa[5]); pw0.w = cvtpk(sa[6], sa[7]);
        pw1.x = cvtpk(sa[8], sa[9]); pw1.y = cvtpk(sa[10], sa[11]); pw1.z = cvtpk(sa[12], sa[13]); pw1.w = cvtpk(sa[14], sa[15]);
        asm volatile("s_waitcnt lgkmcnt(0)" ::: "memory");
        st.lacc = __builtin_amdgcn_mfma_f32_32x32x16_bf16(__builtin_bit_cast(bf16x8, pw0), ones, st.lacc, 0, 0, 0);
        st.lacc = __builtin_amdgcn_mfma_f32_32x32x16_bf16(__builtin_bit_cast(bf16x8, pw1), ones, st.lacc, 0, 0, 0);
#pragma unroll
        for (int dh = 0; dh < 2; ++dh) {
#pragma unroll
            for (int ks = 0; ks < 2; ++ks) {
                const s16x4 lo = vtr(vb0 + dh * 2048 + ks * 1024), hh = vtr(vb0 + dh * 2048 + ks * 1024 + 512);
                const bf16x8 vf = {lo[0], lo[1], lo[2], lo[3], hh[0], hh[1], hh[2], hh[3]};
                const bf16x8 pf = __builtin_bit_cast(bf16x8, ks == 0 ? pw0 : pw1);
                if (dh == 0) st.o0 = __builtin_amdgcn_mfma_f32_32x32x16_bf16(pf, vf, st.o0, 0, 0, 0);
                else         st.o1 = __builtin_amdgcn_mfma_f32_32x32x16_bf16(pf, vf, st.o1, 0, 0, 0);
            }
        }
        asm volatile("" ::: "memory");
        if (kt + 1 < NT) {
#pragma unroll
            for (int q = 0; q < 4; ++q) { kf[q] = kn[q]; vv[q] = vn[q]; }
        }
    }
#undef ATT_LOAD_TILE
}

__device__ __forceinline__ void attn_prompt_unit(int unit, const bf16* Qb, const bf16* Kb, const bf16* Vb, bf16* AA, LAS unsigned char* wl, int lane) {
    const int r = unit & 15, h = (unit >> 4) & 3, s = (unit >> 6) & 7, b = unit >> 9;
    AttnState st; st.o0 = f32x16{}; st.o1 = f32x16{}; st.lacc = f32x16{}; st.m = -30000.0f;
#ifndef PROBE_AMP
#define PROBE_AMP -1
#endif
#define ATT_SPIN(k, t0) do { if (PROBE_AMP == (k)) { const unsigned long long t1_ = __builtin_amdgcn_s_memrealtime(); while (__builtin_amdgcn_s_memrealtime() < t1_ + 2 * (t1_ - (t0))) __builtin_amdgcn_s_sleep(8); } } while (0)
    const unsigned long long ta_ = (PROBE_AMP >= 44) ? __builtin_amdgcn_s_memrealtime() : 0ull;
    if (s < 4) attn_group<2, true>(st, Qb, Kb, Vb, b, s, h, r, wl, lane); else attn_group<2, false>(st, Qb, Kb, Vb, b, s, h, r, wl, lane);
    if (s == 0) attn_group<1, true>(st, Qb, Kb, Vb, b, s, h, r, wl, lane); else attn_group<1, false>(st, Qb, Kb, Vb, b, s, h, r, wl, lane);
    ATT_SPIN(44, ta_);
    const unsigned long long tb_ = (PROBE_AMP >= 44) ? __builtin_amdgcn_s_memrealtime() : 0ull;
    if (s == 0) attn_group<0, true>(st, Qb, Kb, Vb, b, s, h, r, wl, lane); else attn_group<0, false>(st, Qb, Kb, Vb, b, s, h, r, wl, lane);
    ATT_SPIN(45, tb_);
    const int i = lane & 31, hi = lane >> 5;
#pragma unroll
    for (int rho = 0; rho < 16; ++rho) {
        const int qi = crow(rho, hi); const float ff = __builtin_amdgcn_rcpf(st.lacc[rho]);
        bf16* op = AA + ((size_t)b * SEQ + 512 * s + 16 * qi + r) * ADW + h * 64 + i;
        op[0] = (bf16)f2bf(st.o0[rho] * ff); op[32] = (bf16)f2bf(st.o1[rho] * ff);
    }
}

__device__ __forceinline__ float red16(float x) {
    x += __int_as_float(__builtin_amdgcn_update_dpp(0, __float_as_int(x), 0xB1, 0xf, 0xf, true));
    x += __int_as_float(__builtin_amdgcn_update_dpp(0, __float_as_int(x), 0x4E, 0xf, 0xf, true));
    x += __int_as_float(__builtin_amdgcn_update_dpp(0, __float_as_int(x), 0x141, 0xf, 0xf, true));
    x += __int_as_float(__builtin_amdgcn_update_dpp(0, __float_as_int(x), 0x140, 0xf, 0xf, true));
    return x;
}
struct SampleState { float m, l; f32x4 o; };
template <int G> __device__ __forceinline__ void attn_sample_group(SampleState& st, const float* cache, const float* outw, const LAS float* qs, const float* biasg, int b, int h, int t, int lane) {
    constexpr int D = 1 << (2 * G), WIN = 128 << (2 * G);
    const int kq = lane >> 4, d4 = (lane & 15) * 4;
    const f32x4 qv = *(const LAS f32x4*)(qs + G * 64 + d4);
    const unsigned long long cb = (unsigned long long)(cache + ((size_t)b * WIN * 512 + h * 64 + d4));
    const unsigned long long ob = (unsigned long long)(outw + ((size_t)b * WIN * 512 + h * 64 + d4)) - 8ull * 2048ull;
#define SMP_LOAD(bt_, kv_, vv_) do { _Pragma("unroll") for (int q = 0; q < 11; ++q) { int j_ = 44 * (bt_) + 4 * q + kq; j_ = j_ > 128 ? 128 : j_; const int idx_ = WIN + t - D * j_; \
            const unsigned long long a_ = ((idx_ >= WIN) ? ob : cb) + (unsigned long long)idx_ * 2048ull; kv_[q] = *(const f32x4*)a_; vv_[q] = *(const f32x4*)(a_ + 1024ull); } } while (0)
#define SMP_CONSUME(bt_, kv_, vv_) do { float sv[11]; float bm = -INFINITY; \
        _Pragma("unroll") for (int q = 0; q < 11; ++q) { const int j0 = 44 * (bt_) + 4 * q + kq; const int j = j0 > 128 ? 128 : j0; \
            float dt = (kv_[q][0] * qv[0] + kv_[q][1] * qv[1]) + (kv_[q][2] * qv[2] + kv_[q][3] * qv[3]); dt = red16(dt) + biasg[j]; \
            sv[q] = (j0 <= 128) ? dt : -INFINITY; bm = fmaxf(bm, sv[q]); } \
        bm = fmaxf(bm, __shfl_xor(bm, 16)); bm = fmaxf(bm, __shfl_xor(bm, 32)); \
        const float mn = fmaxf(st.m, bm), f = __builtin_amdgcn_exp2f(st.m - mn); st.m = mn; st.l *= f; st.o = st.o * f; \
        _Pragma("unroll") for (int q = 0; q < 11; ++q) { const float p = __builtin_amdgcn_exp2f(sv[q] - st.m); st.l += p; st.o += vv_[q] * p; } } while (0)
    f32x4 ka[11], va[11], kb[11], vb[11];
    SMP_LOAD(0, ka, va); SMP_LOAD(1, kb, vb);
    SMP_CONSUME(0, ka, va); SMP_LOAD(2, ka, va);
    SMP_CONSUME(1, kb, vb);
    SMP_CONSUME(2, ka, va);
#undef SMP_LOAD
#undef SMP_CONSUME
}
__device__ __forceinline__ void attn_sample_unit(int su, const Ptrs& P, const bf16* Qb, bf16* AA, const float* biasG, LAS unsigned char* wl, int lane) {
    const int t = su & 7, h = (su >> 3) & 3, b = su >> 5;
    LAS float* qs = (LAS float*)(wl + ATT_SC_OFF);
    const size_t qrow = (size_t)(MP + b * 8 + t) * AW;
#pragma unroll
    for (int g = 0; g < 3; ++g) qs[g * 64 + lane] = __uint_as_float((unsigned)Qb[qrow + (4 * g + h) * 64 + lane] << 16) * (0.125f * 1.4426950408889634f);
    asm volatile("s_waitcnt lgkmcnt(0)" ::: "memory");
    SampleState st; st.m = -30000.0f; st.l = 0.f; st.o = (f32x4){0.f, 0.f, 0.f, 0.f};
    attn_sample_group<2>(st, P.c2048, P.out + O_KV2048S, qs, biasG + (8 + h) * 132, b, h, t, lane);
    attn_sample_group<1>(st, P.c512, P.out + O_KV512S, qs, biasG + (4 + h) * 132, b, h, t, lane);
    attn_sample_group<0>(st, P.c128, P.out + O_KV128S, qs, biasG + (0 + h) * 132, b, h, t, lane);
    float l = st.l; f32x4 o = st.o;
    l += __shfl_xor(l, 16); l += __shfl_xor(l, 32);
#pragma unroll
    for (int e = 0; e < 4; ++e) { o[e] += __shfl_xor(o[e], 16); o[e] += __shfl_xor(o[e], 32); }
    const int d4 = (lane & 15) * 4;
    if (lane < 16) { const float inv = 1.0f / l;
        *(GAS unsigned long long*)(AA + (size_t)(MP + b * 8 + t) * ADW + h * 64 + d4) = (unsigned long long)pk2(o[0] * inv, o[1] * inv) | ((unsigned long long)pk2(o[2] * inv, o[3] * inv) << 32); }
    asm volatile("s_waitcnt lgkmcnt(0)" ::: "memory");
}

struct CopyLoc { const f32x4* s; f32x4* d; };
constexpr int CC_B2 = 510, CC_B1 = 126, CC_B0 = 30, CC_N2 = 32 * CC_B2, CC_N1 = 32 * CC_B1, CC_N0 = 32 * CC_B0, CC_TOTAL = CC_N2 + CC_N1 + CC_N0;
__device__ __forceinline__ CopyLoc copy_locate(const Ptrs& P, int id) {
    CopyLoc L;
    if (id < CC_N2) { const int b = id / CC_B2, k = id - b * CC_B2; L.s = (const f32x4*)(P.c2048 + ((size_t)b * 2048 + 8) * 512) + k * 512; L.d = (f32x4*)(P.out + O_KV2048S + (size_t)b * 2048 * 512) + k * 512; return L; }
    id -= CC_N2;
    if (id < CC_N1) { const int b = id / CC_B1, k = id - b * CC_B1; L.s = (const f32x4*)(P.c512 + ((size_t)b * 512 + 8) * 512) + k * 512; L.d = (f32x4*)(P.out + O_KV512S + (size_t)b * 512 * 512) + k * 512; return L; }
    id -= CC_N1;
    { const int b = id / CC_B0, k = id - b * CC_B0; L.s = (const f32x4*)(P.c128 + ((size_t)b * 128 + 8) * 512) + k * 512; L.d = (f32x4*)(P.out + O_KV128S + (size_t)b * 128 * 512) + k * 512; return L; }
}
__device__ __forceinline__ void copy_chunks(const Ptrs& P, int id_begin, int id_end, int mw, int NMW, int lane) {
    const int CC_N = id_end;
    f32x4 va[8], vb[8];
    int id = id_begin + mw;
    if (id < CC_N) { const CopyLoc L = copy_locate(P, id);
#pragma unroll
        for (int q = 0; q < 8; ++q) va[q] = __builtin_nontemporal_load(L.s + q * 64 + lane); }
    for (; id < CC_N; id += 2 * NMW) {
        const int id2 = id + NMW, id3 = id + 2 * NMW;
        if (id2 < CC_N) { const CopyLoc L = copy_locate(P, id2);
#pragma unroll
            for (int q = 0; q < 8; ++q) vb[q] = __builtin_nontemporal_load(L.s + q * 64 + lane); }
        { const CopyLoc L = copy_locate(P, id);
#pragma unroll
            for (int q = 0; q < 8; ++q) __builtin_nontemporal_store(va[q], L.d + q * 64 + lane); }
        if (id3 < CC_N) { const CopyLoc L = copy_locate(P, id3);
#pragma unroll
            for (int q = 0; q < 8; ++q) va[q] = __builtin_nontemporal_load(L.s + q * 64 + lane); }
        if (id2 < CC_N) { const CopyLoc L = copy_locate(P, id2);
#pragma unroll
            for (int q = 0; q < 8; ++q) __builtin_nontemporal_store(vb[q], L.d + q * 64 + lane); }
    }
}

template <int W> __device__ __forceinline__ void pool_block(const float* __restrict__ U, bf16* __restrict__ DD, int rb, int gi, int lane) {
    const int r0 = 16 * rb + 8 * (lane >> 5), c4 = gi * 128 + (lane & 31) * 4, t0 = r0 & (SEQ - 1);
    f32x4 v[W + 7];
#pragma unroll
    for (int i = 0; i < W + 7; ++i) { const int dt = i - (W - 1); const int ri = (t0 + dt >= 0) ? r0 + dt : r0; v[i] = *(const f32x4*)(U + (size_t)ri * PW + c4); }
#pragma unroll
    for (int i = 0; i < W - 1; ++i) { if (t0 + i - (W - 1) < 0) v[i] = (f32x4){0.f, 0.f, 0.f, 0.f}; }
    f32x4 s = v[0];
#pragma unroll
    for (int i = 1; i < W; ++i) s += v[i];
#pragma unroll
    for (int o = 0; o < 8; ++o) {
        if (o > 0) s += v[W - 1 + o] - v[o - 1];
        const int t = t0 + o; const float inv = 1.0f / (float)((t + 1 < W) ? t + 1 : W); const f32x4 dd = s * inv - v[W - 1 + o];
        *(GAS unsigned long long*)(DD + (size_t)(r0 + o) * ADW + AOW + c4) = (unsigned long long)pk2(dd[0], dd[1]) | ((unsigned long long)pk2(dd[2], dd[3]) << 32);
    }
}
__device__ __forceinline__ void pool_items(const Ptrs& P, const float* U, bf16* DD, int mw, int NMW, int lane) {
    for (int it = mw; it < (MP / 16) * 4; it += NMW) {
        const int gi = it & 3, rb = it >> 2;
        if (gi == 0) pool_block<2>(U, DD, rb, 0, lane); else if (gi == 1) pool_block<4>(U, DD, rb, 1, lane); else if (gi == 2) pool_block<8>(U, DD, rb, 2, lane); else pool_block<16>(U, DD, rb, 3, lane);
    }
    for (int it = mw * 64 + lane; it < MS * 128; it += NMW * 64) {
        const int sidx = it >> 7, row = MP + sidx, c4 = (it & 127) * 4, w = 2 << (c4 >> 7), b = sidx >> 3, t = sidx & 7;
        f32x4 s = {0.f, 0.f, 0.f, 0.f};
        const f32x4 own = *(const f32x4*)(U + (size_t)row * PW + c4);
        for (int i = 0; i < w; ++i) { const int idx = 15 + t - i;
            s += (idx >= 15) ? *(const f32x4*)(U + (size_t)(MP + b * 8 + idx - 15) * PW + c4) : *(const f32x4*)(P.spool + ((size_t)b * 15 + idx) * PW + c4); }
        const float inv = 1.0f / (float)w; const f32x4 dd = s * inv - own;
        *(GAS unsigned long long*)(DD + (size_t)row * ADW + AOW + c4) = (unsigned long long)pk2(dd[0], dd[1]) | ((unsigned long long)pk2(dd[2], dd[3]) << 32);
    }
}


template <int KS  , int LD  > __device__ __forceinline__ void micro_partial(const pg8::bf16_t* A, const pg8::bf16_t* Bt, int row0, int col0, int wave, int lane, f32x4 (&acc)[4]) {
    constexpr int K = LD, NS = KS / 32, NB = (NS > 4) ? 4 : NS;
    const int fr = lane & 15, fq = lane >> 4;
    const pg8::bf16_t* ap = A + (size_t)(row0 + fr) * K + wave * KS + 8 * fq;
    const pg8::bf16_t* bp = Bt + (size_t)(col0 + fr) * K + wave * KS + 8 * fq;
#pragma unroll
    for (int k0 = 0; k0 < NS; k0 += NB) {
        bf16x8 af[NB], bf[NB][4];
#pragma unroll
        for (int s = 0; s < NB; ++s) if (k0 + s < NS) { af[s] = *(const bf16x8*)(ap + (k0 + s) * 32);
#pragma unroll
            for (int nb = 0; nb < 4; ++nb) bf[s][nb] = *(const bf16x8*)(bp + (size_t)(16 * nb) * K + (k0 + s) * 32); }
#pragma unroll
        for (int s = 0; s < NB; ++s) if (k0 + s < NS) {
#pragma unroll
            for (int nb = 0; nb < 4; ++nb) acc[nb] = __builtin_amdgcn_mfma_f32_16x16x32_bf16(bf[s][nb], af[s], acc[nb], 0, 0, 0); }
    }
}
typedef float f32x2 __attribute__((ext_vector_type(2)));
__device__ __forceinline__ f32x2 micro_reduce(LAS unsigned char* red, const f32x4 (&acc)[4], int wave, int lane, int tid) {
    const int fr = lane & 15, fq = lane >> 4;
    LAS float* pw = (LAS float*)red + wave * 1024 + fr * 64 + 4 * fq;
#pragma unroll
    for (int nb = 0; nb < 4; ++nb) *(LAS f32x4*)(pw + 16 * nb) = acc[nb];
    __syncthreads();
    const LAS float* pr = (const LAS float*)red + (tid >> 5) * 64 + 2 * (tid & 31);
    f32x2 s = {0.f, 0.f};
#pragma unroll
    for (int w = 0; w < 8; ++w) s += *(const LAS f32x2*)(pr + w * 1024);
    __syncthreads();
    return s;
}
template <int MODE, int K> __device__ __forceinline__ void micro_resid(LAS unsigned char* red, int blk, const pg8::bf16_t* A, const pg8::bf16_t* Bt, pg8::bf16_t* XB, float* ssp, float* out) {
    int tid_ = threadIdx.x; asm volatile("" : "+v"(tid_));
    const int tid = tid_, lane = tid & 63, wave = __builtin_amdgcn_readfirstlane(tid >> 6);
    const int row0 = MP + 16 * (blk >> 4), col0 = 64 * (blk & 15);
    f32x4 acc[4] = {};
    micro_partial<K / 8, K>(A, Bt, row0, col0, wave, lane, acc);
    const f32x2 s = micro_reduce(red, acc, wave, lane, tid);
    const int row = row0 + (tid >> 5), col = col0 + 2 * (tid & 31);
    const float alpha = (MODE == 1) ? 1.0f : 0.5f;
    const unsigned xw = *(const unsigned*)(XB + (size_t)row * DM + col);
    f32x2 v; v[0] = __uint_as_float(xw << 16) + s[0] * alpha; v[1] = __uint_as_float(xw & 0xffff0000u) + s[1] * alpha;
    if (MODE == 2) { *(f32x2*)(out + (size_t)row * DM + col) = v; }
    else {
        *(unsigned*)(XB + (size_t)row * DM + col) = pk2(v[0], v[1]);
        float ss = v[0] * v[0] + v[1] * v[1];
#pragma unroll
        for (int o = 1; o < 32; o <<= 1) ss += __shfl_xor(ss, o);
        if ((tid & 31) == 0) ssp[(size_t)row * 16 + (blk & 15)] = ss;
    }
}
__device__ __forceinline__ void micro_merge(LAS unsigned char* red, int blk, const pg8::bf16_t* AA, const pg8::bf16_t* WAB, const pg8::bf16_t* DD, const pg8::bf16_t* WEFF,
                                            const pg8::bf16_t* GA, const pg8::bf16_t* GB, pg8::bf16_t* MG) {
    int tid_ = threadIdx.x; asm volatile("" : "+v"(tid_));
    const int tid = tid_, lane = tid & 63, wave = __builtin_amdgcn_readfirstlane(tid >> 6);
    const int row0 = MP + 16 * (blk >> 4), col0 = 64 * (blk & 15);
    f32x4 acc[4] = {};
    micro_partial<AOW / 8, ADW>(AA, WAB, row0, col0, wave, lane, acc);
    const f32x2 s1 = micro_reduce(red, acc, wave, lane, tid);
#pragma unroll
    for (int nb = 0; nb < 4; ++nb) acc[nb] = (f32x4){0.f, 0.f, 0.f, 0.f};
    micro_partial<PW / 8, ADW>(DD, WEFF, row0, col0, wave, lane, acc);
    const f32x2 s2 = micro_reduce(red, acc, wave, lane, tid);
    const int row = row0 + (tid >> 5), col = col0 + 2 * (tid & 31);
    const unsigned ga = *(const unsigned*)(GA + (size_t)row * DM + col), gb = *(const unsigned*)(GB + (size_t)row * DM + col);
    const float m0 = __uint_as_float(ga << 16) * s1[0] + __uint_as_float(gb << 16) * s2[0];
    const float m1 = __uint_as_float(ga & 0xffff0000u) * s1[1] + __uint_as_float(gb & 0xffff0000u) * s2[1];
    *(unsigned*)(MG + (size_t)row * DM + col) = pk2(m0, m1);
}

#ifndef PROBE_AMP
#define PROBE_AMP -1
#endif
struct Args { Ptrs p; };
__global__ void __launch_bounds__(NWAVES * 64, 2) hybrid_fwd(Args args) {
    extern __shared__ __attribute__((aligned(16))) unsigned char lds[];
    Frame F;
    F.lds = (LAS unsigned char*)lds;
    F.MISC = (volatile LAS unsigned*)(F.lds + MISC_OFF);
    F.tid = threadIdx.x; F.lane = F.tid & 63; F.wave = __builtin_amdgcn_readfirstlane(F.tid >> 6);
    F.G = gridDim.x; { const int bx = blockIdx.x; F.vcu = (F.G % 8 == 0) ? (bx % 8) * (F.G / 8) + bx / 8 : bx; }
    const Ptrs& P = args.p;
    unsigned char* ws = P.ws;
    F.ctl = (gu32*)(ws + WS_CTL);
    for (int u = F.tid; u < (LDS_BYTES - LDSCTL_OFF) / 4; u += NWAVES * 64) ((LAS unsigned*)(F.lds + LDSCTL_OFF))[u] = 0u;
    __syncthreads();
    XcdBarrier bar = xcd_barrier_post((unsigned*)(F.ctl + CW_BAR), F.MISC + 8);
#define GRID_BAR() xcd_barrier(bar)
    unsigned long long tph_ = 0;
#define PH_BEGIN() do { if (PROBE_AMP >= 0) tph_ = __builtin_amdgcn_s_memrealtime(); } while (0)
#define PH_END(k) do { if (PROBE_AMP >= 0) { const unsigned long long tn_ = __builtin_amdgcn_s_memrealtime(); if (PROBE_AMP == (k)) { while (__builtin_amdgcn_s_memrealtime() < tn_ + 2 * (tn_ - tph_)) __builtin_amdgcn_s_sleep(8); } tph_ = __builtin_amdgcn_s_memrealtime(); } } while (0)
#define WSP(T, off) ((T*)(ws + (off)))
    typedef pg8::bf16_t b16;
    const int c = (int)blockIdx.x;

    PH_BEGIN();
    p0_prologue(F, P);
    GRID_BAR();
    PH_END(0);
    {   pg8::Gemm g{WSP(b16, WS_XB), WSP(b16, WS_WUP1), M, FF2, DM}; pg8::StaticOrder S; S.init(M, FF2, F.G, c);
        pg8::EpiSwiglu<false> E{WSP(b16, WS_R), WSP(float, WS_RSTD0)};
        pg8::gemm_phase<pg8::EpiSwiglu<false>, pg8::StaticOrder, true, true>(F.lds + RING_OFF, g, S, E);
        {   const int nwg = (M / 256) * (FF2 / 256), R = (nwg + F.G - 1) / F.G, nfull = nwg - (R - 1) * F.G, nh = F.G - nfull;
            int th_ = threadIdx.x; asm volatile("" : "+v"(th_)); const int laneh = th_ & 63, waveh = __builtin_amdgcn_readfirstlane(th_ >> 6);
            LAS float* scr = (LAS float*)(F.lds + RING_OFF + waveh * 16384);
            if (nh == 0) convert_items(P, WI_WDN1, WI_WAB, c * NWAVES + waveh, F.G * NWAVES, scr, laneh);
            else if (c >= nfull) convert_items(P, WI_WDN1, WI_WAB, (c - nfull) * NWAVES + waveh, nh * NWAVES, scr, laneh); } }
    GRID_BAR();
    PH_END(1);
    {   pg8::Gemm g{WSP(b16, WS_R), WSP(b16, WS_WDN1), MP, DM, FF}; pg8::StaticOrder S; S.init(MP, DM, F.G, c);
        pg8::EpiResid<0> E{WSP(b16, WS_XB), WSP(float, WS_SSP1), nullptr};
        pg8::gemm_phase<pg8::EpiResid<0>, pg8::StaticOrder, true, true>(F.lds + RING_OFF, g, S, E);
        for (int blk = c; blk < 256; blk += F.G) micro_resid<0, FF>(F.lds + RING_OFF, blk, WSP(b16, WS_R), WSP(b16, WS_WDN1), WSP(b16, WS_XB), WSP(float, WS_SSP1), nullptr); }
    GRID_BAR();
    PH_END(2);
    {   pg8::Gemm g{WSP(b16, WS_XB), WSP(b16, WS_WIN), M, INW, DM}; pg8::StaticOrder S; S.init(M, INW, F.G, c);
        pg8::EpiIn E{WSP(float, WS_SSP1), WSP(b16, WS_Q), WSP(b16, WS_K), WSP(b16, WS_V), WSP(float, WS_U), WSP(b16, WS_GA), WSP(b16, WS_GB), P.qn, P.kn, P.out};
        pg8::gemm_phase<pg8::EpiIn, pg8::StaticOrder, true, true>(F.lds + RING_OFF, g, S, E); }
    GRID_BAR();
    PH_END(3);
    {   int tid_ = threadIdx.x; asm volatile("" : "+v"(tid_));
        const int lane = tid_ & 63, wave = __builtin_amdgcn_readfirstlane(tid_ >> 6);
        const unsigned long long tq0_ = (PROBE_AMP >= 40) ? __builtin_amdgcn_s_memrealtime() : 0ull;
#define SUBAMP(k) do { if (PROBE_AMP == (k)) { const unsigned long long tq1_ = __builtin_amdgcn_s_memrealtime(); while (__builtin_amdgcn_s_memrealtime() < tq1_ + 2 * (tq1_ - tq0_)) __builtin_amdgcn_s_sleep(8); } } while (0)
        constexpr int CC_SPLIT = (CC_TOTAL * 55) / 100;
        LAS unsigned char* wl = F.lds + RING_OFF + wave * ATT_WLDS;
        const bf16* Qb = WSP(const bf16, WS_Q); const bf16* Kb = WSP(const bf16, WS_K); const bf16* Vb = WSP(const bf16, WS_V); bf16* AA = WSP(bf16, WS_AA);
        const float* BIAS = WSP(const float, WS_BIAS);
        if (wave < 4) {
            const int cw = F.vcu * 4 + wave, NCW = F.G * 4;
            for (int up = cw; up < NBATCH * 8 * 4 * 8; up += NCW) {
                const int unit0 = ((up >> 3) << 4) + (up & 7);
                attn_build_tables(BIAS, (unit0 >> 4) & 3, (LAS float*)(wl + ATT_TB_OFF), lane);
#pragma unroll 1
                for (int k2 = 0; k2 < 2; ++k2) attn_prompt_unit(unit0 + 8 * k2, Qb, Kb, Vb, AA, wl, lane);
            }
            SUBAMP(40);
            int lane3 = threadIdx.x; asm volatile("" : "+v"(lane3)); lane3 &= 63;
            copy_chunks(P, CC_SPLIT, CC_TOTAL, cw, NCW, lane3);
        } else {
            const int mw = F.vcu * 4 + (wave - 4), NMW = F.G * 4;
            pool_items(P, WSP(const float, WS_U), WSP(bf16, WS_AA), mw, NMW, lane);
            weff_items(P, mw, NMW, lane);
            convert_items(P, WI_WAB, WI_END, mw, NMW, (LAS float*)wl, lane);
            int lane3 = threadIdx.x; asm volatile("" : "+v"(lane3)); lane3 &= 63;
            for (int su = mw; su < DBATCH * 4 * DSEQ; su += NMW) attn_sample_unit(su, P, Qb, AA, BIAS, wl, lane3);
            SUBAMP(41);
            int lane4 = threadIdx.x; asm volatile("" : "+v"(lane4)); lane4 &= 63;
            copy_chunks(P, 0, CC_SPLIT, mw, NMW, lane4);
        }
    }
    GRID_BAR();
    PH_END(4);
    {   pg8::Gemm g{WSP(b16, WS_AA), WSP(b16, WS_WAB), MP, DM, ADW}; pg8::StaticOrder S; S.init(MP, DM, F.G, c);
        pg8::EpiMergeFused E{WSP(b16, WS_GA), WSP(b16, WS_GB), WSP(b16, WS_MG)};
        pg8::gemm_phase<pg8::EpiMergeFused, pg8::StaticOrder, true, true>(F.lds + RING_OFF, g, S, E);
        for (int blk = c; blk < 256; blk += F.G) micro_merge(F.lds + RING_OFF, blk, WSP(b16, WS_AA), WSP(b16, WS_WAB), WSP(b16, WS_AA) + AOW, WSP(b16, WS_WAB) + AOW, WSP(b16, WS_GA), WSP(b16, WS_GB), WSP(b16, WS_MG));
    }
    GRID_BAR();
    PH_END(5);
    {   pg8::Gemm g{WSP(b16, WS_MG), WSP(b16, WS_WOUT), MP, DM, DM}; pg8::StaticOrder S; S.init(MP, DM, F.G, c);
        pg8::EpiResid<1> E{WSP(b16, WS_XB), WSP(float, WS_SSP2), nullptr};
        pg8::gemm_phase<pg8::EpiResid<1>, pg8::StaticOrder, true, true>(F.lds + RING_OFF, g, S, E);
        for (int blk = c; blk < 256; blk += F.G) micro_resid<1, DM>(F.lds + RING_OFF, blk, WSP(b16, WS_MG), WSP(b16, WS_WOUT), WSP(b16, WS_XB), WSP(float, WS_SSP2), nullptr); }
    GRID_BAR();
    PH_END(6);
    {   pg8::Gemm g{WSP(b16, WS_XB), WSP(b16, WS_WUP2), M, FF2, DM}; pg8::StaticOrder S; S.init(M, FF2, F.G, c);
        pg8::EpiSwiglu<true> E{WSP(b16, WS_R), WSP(float, WS_SSP2)};
        pg8::gemm_phase<pg8::EpiSwiglu<true>, pg8::StaticOrder, true, true>(F.lds + RING_OFF, g, S, E); }
    GRID_BAR();
    PH_END(7);
    {   pg8::Gemm g{WSP(b16, WS_R), WSP(b16, WS_WDN2), MP, DM, FF}; pg8::StaticOrder S; S.init(MP, DM, F.G, c);
        pg8::EpiResid<2> E{WSP(b16, WS_XB), nullptr, P.out};
        pg8::gemm_phase<pg8::EpiResid<2>, pg8::StaticOrder, true, true>(F.lds + RING_OFF, g, S, E);
        for (int blk = c; blk < 256; blk += F.G) micro_resid<2, FF>(F.lds + RING_OFF, blk, WSP(b16, WS_R), WSP(b16, WS_WDN2), WSP(b16, WS_XB), nullptr, P.out); }
    PH_END(8);
}

extern "C" void kernel_launch(void* const* d_in, const int* in_sizes, int n_in, void* d_out, int out_size, void* d_ws, size_t ws_size, hipStream_t stream) {
    static int grid = 0;
    if (grid == 0) {
        if (n_in != 22 || (size_t)out_size != O_END || ws_size < WS_END) { fprintf(stderr, "kernel_launch: unexpected shapes (n_in %d, out %d, ws %zu); nothing launched\n", n_in, out_size, ws_size); grid = -1; return; }
        int dev = 0, cus = 0;
        if (hipGetDevice(&dev) != hipSuccess || hipDeviceGetAttribute(&cus, hipDeviceAttributeMultiprocessorCount, dev) != hipSuccess) { grid = -1; return; }
        if (hipFuncSetAttribute((const void*)hybrid_fwd, hipFuncAttributeMaxDynamicSharedMemorySize, LDS_BYTES) != hipSuccess) { fprintf(stderr, "kernel_launch: hipFuncSetAttribute failed\n"); grid = -1; return; }
        (void)hipGetLastError();
        grid = cus;
    }
    if (grid < 0) return;
    if (hipMemsetAsync((char*)d_ws + WS_CTL, 0, CTL_ZERO_BYTES, stream) != hipSuccess) return;
    Args a{};
    const float** pp = (const float**)&a.p;
    for (int i = 0; i < 22; ++i) pp[i] = (const float*)d_in[i];
    a.p.out = (float*)d_out; a.p.ws = (unsigned char*)d_ws;
    hipLaunchKernelGGL(hybrid_fwd, dim3(grid), dim3(NWAVES * 64), LDS_BYTES, stream, a);
}
```

```cpp
#include <hip/hip_runtime.h>
#include <cstdio>
#include <cstdint>

namespace pg8 {
#define PG8_LAS __attribute__((address_space(3)))
typedef unsigned short bf16_t;
typedef short bf16x8 __attribute__((ext_vector_type(8)));
typedef float f32x4 __attribute__((ext_vector_type(4)));
typedef unsigned u32x4 __attribute__((ext_vector_type(4)));
constexpr int BM = 256, BK = 64, HALF = 128, HTB = HALF * BK * 2  , STAGE_BYTES = 8 * HTB, NXCD = 8, WGM = 8;

__host__ __device__ __forceinline__ int lds_byte(int r, int c) { const int st = (r >> 4) * 2 + (c >> 5), rr = r & 15, cc = c & 31, ob = rr * 64 + cc * 2; return st * 1024 + (ob ^ (((ob >> 9) & 1) << 5)); }
__host__ __device__ __forceinline__ void stage_rc(int b, int& R, int& C) { const int st = b / 1024, sb = b % 1024, swz = sb ^ (((sb >> 9) & 1) << 5); R = (st >> 1) * 16 + swz / 64; C = (st & 1) * 32 + (swz % 64) / 2; }
__host__ __device__ __forceinline__ int perm32(int rho) { const int n = rho >> 4, i = rho & 15; return 8 * (i >> 2) + 4 * n + (i & 3); }

struct Unit { int pm, pn; };
struct Gemm { const bf16_t* A; const bf16_t* Bt; int M, N, K; };

struct StaticOrder {
    int nM, nN, nwg, G, c;
    __host__ __device__ void init(int M, int N, int G_, int c_) { nM = M / BM; nN = N / BM; nwg = nM * nN; G = G_; c = c_; }
    __host__ __device__ bool next(int i, Unit& u) const {
        const long L = (long)i * G + c; if (L >= nwg) return false;
        int wgid = (int)L; { const int q = nwg / NXCD, r = nwg % NXCD, xcd = wgid % NXCD, off = wgid / NXCD; wgid = (xcd < r ? xcd * (q + 1) : r * (q + 1) + (xcd - r) * q) + off; }
        const int nig = WGM * nN, gid = wgid / nig, fm = gid * WGM, gsz = (nM - fm) < WGM ? (nM - fm) : WGM;
        u.pm = fm + ((wgid % nig) % gsz); u.pn = (wgid % nig) / gsz; return true;
    }
    __device__ __forceinline__ void a_ready(const Unit&) const {}
    __device__ __forceinline__ void done(const Unit&) const {}
};


typedef float f32x2 __attribute__((ext_vector_type(2)));
typedef __bf16 bf16x2_t __attribute__((ext_vector_type(2)));
__device__ __forceinline__ unsigned cvt_pk_bf16(float lo, float hi) { f32x2 v = {lo, hi}; bf16x2_t b = __builtin_convertvector(v, bf16x2_t); return __builtin_bit_cast(unsigned, b); }
__device__ __forceinline__ u32x4 pack8(const f32x4 a, const f32x4 b) { u32x4 w; w.x = cvt_pk_bf16(a[0], a[1]); w.y = cvt_pk_bf16(a[2], a[3]); w.z = cvt_pk_bf16(b[0], b[1]); w.w = cvt_pk_bf16(b[2], b[3]); return w; }
__device__ __forceinline__ float bf2f(unsigned short h) { return __uint_as_float((unsigned)h << 16); }
constexpr float RMS_EPS = 1e-6f;
constexpr float LOG2E = 1.4426950408889634f;
__device__ __forceinline__ float rstd_from_partials(const float* ssp, int row) {
    const f32x4* p = (const f32x4*)(ssp + (size_t)row * 16);
    const f32x4 a = p[0], b = p[1], c = p[2], d = p[3];
    const float s = (((a[0] + a[1]) + (a[2] + a[3])) + ((b[0] + b[1]) + (b[2] + b[3]))) + (((c[0] + c[1]) + (c[2] + c[3])) + ((d[0] + d[1]) + (d[2] + d[3])));
    return __builtin_amdgcn_rsqf(s * (1.0f / 1024.0f) + RMS_EPS);
}
__device__ __forceinline__ void rstd8_from_partials(const float* ssp, int row0, int fq, float (&rs)[8]) {
    f32x4 q[8];
#pragma unroll
    for (int i = 0; i < 8; ++i) q[i] = *(const f32x4*)(ssp + (size_t)(row0 + (i >> 2) * HALF + (i & 3) * 16) * 16 + 4 * fq);
#pragma unroll
    for (int i = 0; i < 8; ++i) { float s = (q[i][0] + q[i][1]) + (q[i][2] + q[i][3]); s += __shfl_xor(s, 16); s += __shfl_xor(s, 32); rs[i] = __builtin_amdgcn_rsqf(s * (1.0f / 1024.0f) + RMS_EPS); }
    asm volatile("" ::: "memory");
}
__device__ __forceinline__ float sigmoidf_fast(float x) { return __builtin_amdgcn_rcpf(1.0f + __builtin_amdgcn_exp2f(-x * LOG2E)); }

template <bool PARTIAL> struct EpiSwiglu {
    static constexpr bool PERM = true, AFTER_DRAIN = false; static constexpr int MID_T = -1;
    bf16_t* H; const float* rs;
    __device__ __forceinline__ void operator()(const f32x4 (&acc)[2][2][4][2], const Unit& u, int wr, int wc, int fr, int fq) const {
        const int row0 = u.pm * BM + wr * 64 + fr, col0 = u.pn * 128 + wc * 32 + 8 * fq;
        float rsv[8];
        if (PARTIAL) rstd8_from_partials(rs, row0, fq, rsv);
        else {
#pragma unroll
            for (int i = 0; i < 8; ++i) rsv[i] = rs[row0 + (i >> 2) * HALF + (i & 3) * 16]; }
#pragma unroll
        for (int ai = 0; ai < 2; ++ai)
#pragma unroll
            for (int m = 0; m < 4; ++m) {
                const int row = row0 + ai * HALF + m * 16;
                const float r = rsv[ai * 4 + m];
                f32x4 o[2];
#pragma unroll
                for (int n = 0; n < 2; ++n) {
                    const f32x4 g = acc[ai][0][m][n] * r, up = acc[ai][1][m][n] * r;
#pragma unroll
                    for (int e = 0; e < 4; ++e) o[n][e] = g[e] * sigmoidf_fast(g[e]) * up[e];
                }
                *(u32x4*)(H + (size_t)row * 2816 + col0) = pack8(o[0], o[1]);
            }
    }
};

__device__ __forceinline__ void unpack8(const u32x4 w, f32x4& a, f32x4& b) {
    a[0] = __uint_as_float(w.x << 16); a[1] = __uint_as_float(w.x & 0xffff0000u); a[2] = __uint_as_float(w.y << 16); a[3] = __uint_as_float(w.y & 0xffff0000u);
    b[0] = __uint_as_float(w.z << 16); b[1] = __uint_as_float(w.z & 0xffff0000u); b[2] = __uint_as_float(w.w << 16); b[3] = __uint_as_float(w.w & 0xffff0000u);
}
template <int MODE> struct EpiResid {
    static constexpr bool PERM = true, AFTER_DRAIN = false; static constexpr int MID_T = -1;
    bf16_t* XB; float* ssp; float* out;
    __device__ __forceinline__ void operator()(const f32x4 (&acc)[2][2][4][2], const Unit& u, int wr, int wc, int fr, int fq) const {
        const int row0 = u.pm * BM + wr * 64 + fr, col0 = u.pn * BM + wc * 32 + 8 * fq;
        const float alpha = (MODE == 1) ? 1.0f : 0.5f;
#pragma unroll
        for (int ai = 0; ai < 2; ++ai)
#pragma unroll
            for (int m = 0; m < 4; ++m) {
                const int row = row0 + ai * HALF + m * 16;
                float ss = 0.f;
#pragma unroll
                for (int bj = 0; bj < 2; ++bj) {
                    const size_t off = (size_t)row * 1024 + col0 + bj * HALF;
                    f32x4 b0, b1; unpack8(*(const u32x4*)(XB + off), b0, b1);
                    const f32x4 v0 = b0 + acc[ai][bj][m][0] * alpha, v1 = b1 + acc[ai][bj][m][1] * alpha;
                    if (MODE == 2) { *(f32x4*)(out + off) = v0; *(f32x4*)(out + off + 4) = v1; }
                    else {
                        *(u32x4*)(XB + off) = pack8(v0, v1);
                        ss += ((v0[0] * v0[0] + v0[1] * v0[1]) + (v0[2] * v0[2] + v0[3] * v0[3])) + ((v1[0] * v1[0] + v1[1] * v1[1]) + (v1[2] * v1[2] + v1[3] * v1[3]));
                    }
                }
                if (MODE != 2) { ss += __shfl_xor(ss, 16); ss += __shfl_xor(ss, 32); if (fq == 0) ssp[(size_t)row * 16 + u.pn * 4 + wc] = ss; }
            }
    }
};

struct EpiIn {
    static constexpr bool PERM = true, AFTER_DRAIN = false; static constexpr int MID_T = -1;
    const float* ssp; bf16_t *Q, *K, *V; float* U; bf16_t *GA, *GB; const float *qn, *kn; float* out;
    __device__ __forceinline__ void operator()(const f32x4 (&acc)[2][2][4][2], const Unit& u, int wr, int wc, int fr, int fq) const {
        const int row0 = u.pm * BM + wr * 64 + fr, pn = u.pn;
        float rsv[8]; rstd8_from_partials(ssp, row0, fq, rsv);
        constexpr size_t O_KVP[3] = {17039360u, 17301504u, 18350080u}, O_KVS[3] = {22575104u, 24672256u, 33060864u};
        constexpr size_t O_POOLP = 22544384u, O_POOLS = 66615296u;
        if (pn < 6) {
            const bool isk = pn >= 3; const int head = 4 * (isk ? pn - 3 : pn) + wc, g = head >> 2, hs = head & 3, win = 128 << (2 * g);
            const float* gn = (isk ? kn : qn) + head * 64 + 8 * fq;
            f32x4 gv[2][2];
#pragma unroll
            for (int bj = 0; bj < 2; ++bj)
#pragma unroll
                for (int n = 0; n < 2; ++n) gv[bj][n] = *(const f32x4*)(gn + 32 * bj + 4 * n);
            bf16_t* dst = isk ? K : Q;
#pragma unroll
            for (int ai = 0; ai < 2; ++ai)
#pragma unroll
                for (int m = 0; m < 4; ++m) {
                    const int row = row0 + ai * HALF + m * 16; const float rs = rsv[ai * 4 + m];
                    f32x4 v[2][2]; float ss = 0.f;
#pragma unroll
                    for (int bj = 0; bj < 2; ++bj)
#pragma unroll
                        for (int n = 0; n < 2; ++n) { v[bj][n] = acc[ai][bj][m][n] * rs; const f32x4 x = v[bj][n]; ss += (x[0] * x[0] + x[1] * x[1]) + (x[2] * x[2] + x[3] * x[3]); }
                    ss += __shfl_xor(ss, 16); ss += __shfl_xor(ss, 32);
                    const float r2 = __builtin_amdgcn_rsqf(ss * (1.0f / 64.0f) + RMS_EPS);
                    float* fo = nullptr;
                    if (isk) {
                        if (row < 16384) { const int b = row >> 12, t = row & 4095; if (t >= 4096 - win) fo = out + O_KVP[g] + ((size_t)(b * win + t - (4096 - win)) * 512 + hs * 64 + 8 * fq); }
                        else { const int s = row - 16384, b = s >> 3, t = s & 7; fo = out + O_KVS[g] + ((size_t)(b * win + win - 8 + t) * 512 + hs * 64 + 8 * fq); }
                    }
#pragma unroll
                    for (int bj = 0; bj < 2; ++bj) {
                        const f32x4 o0 = v[bj][0] * r2 * gv[bj][0], o1 = v[bj][1] * r2 * gv[bj][1];
                        *(u32x4*)(dst + (size_t)row * 768 + head * 64 + 32 * bj + 8 * fq) = pack8(o0, o1);
                        if (fo) { *(f32x4*)(fo + 32 * bj) = o0; *(f32x4*)(fo + 32 * bj + 4) = o1; }
                    }
                }
        } else if (pn < 9) {
            const int cb = (pn - 6) * 256 + wc * 32 + 8 * fq;
#pragma unroll
            for (int ai = 0; ai < 2; ++ai)
#pragma unroll
                for (int m = 0; m < 4; ++m) {
                    const int row = row0 + ai * HALF + m * 16; const float rs = rsv[ai * 4 + m];
#pragma unroll
                    for (int bj = 0; bj < 2; ++bj) {
                        const int c = cb + 128 * bj, head = c >> 6, g = head >> 2, hs = head & 3, win = 128 << (2 * g), dim = c & 63;
                        const f32x4 o0 = acc[ai][bj][m][0] * rs, o1 = acc[ai][bj][m][1] * rs;
                        *(u32x4*)(V + (size_t)row * 768 + c) = pack8(o0, o1);
                        float* fo = nullptr;
                        if (row < 16384) { const int b = row >> 12, t = row & 4095; if (t >= 4096 - win) fo = out + O_KVP[g] + ((size_t)(b * win + t - (4096 - win)) * 512 + 256 + hs * 64 + dim); }
                        else { const int s = row - 16384, b = s >> 3, t = s & 7; fo = out + O_KVS[g] + ((size_t)(b * win + win - 8 + t) * 512 + 256 + hs * 64 + dim); }
                        if (fo) { *(f32x4*)(fo) = o0; *(f32x4*)(fo + 4) = o1; }
                    }
                }
        } else if (pn < 11) {
            const int cb = (pn - 9) * 256 + wc * 32 + 8 * fq;
#pragma unroll
            for (int ai = 0; ai < 2; ++ai)
#pragma unroll
                for (int m = 0; m < 4; ++m) {
                    const int row = row0 + ai * HALF + m * 16; const float rs = rsv[ai * 4 + m];
                    float* fo = nullptr;
                    if (row < 16384) { const int b = row >> 12, t = row & 4095; if (t >= 4081) fo = out + O_POOLP + (size_t)(b * 15 + t - 4081) * 512 + cb; }
                    else { const int s = row - 16384, b = s >> 3, t = s & 7; fo = out + O_POOLS + (size_t)(b * 15 + 7 + t) * 512 + cb; }
#pragma unroll
                    for (int bj = 0; bj < 2; ++bj) {
                        const f32x4 o0 = acc[ai][bj][m][0] * rs, o1 = acc[ai][bj][m][1] * rs;
                        float* up = U + (size_t)row * 512 + cb + 128 * bj;
                        *(f32x4*)(up) = o0; *(f32x4*)(up + 4) = o1;
                        if (fo) { *(f32x4*)(fo + 128 * bj) = o0; *(f32x4*)(fo + 128 * bj + 4) = o1; }
                    }
                }
        } else {
            const bool isb = pn >= 15; bf16_t* G = isb ? GB : GA; const int cb = (pn - (isb ? 15 : 11)) * 256 + wc * 32 + 8 * fq;
#pragma unroll
            for (int ai = 0; ai < 2; ++ai)
#pragma unroll
                for (int m = 0; m < 4; ++m) {
                    const int row = row0 + ai * HALF + m * 16; const float rs = rsv[ai * 4 + m];
#pragma unroll
                    for (int bj = 0; bj < 2; ++bj) {
                        f32x4 o0 = acc[ai][bj][m][0] * rs, o1 = acc[ai][bj][m][1] * rs;
#pragma unroll
                        for (int e = 0; e < 4; ++e) { o0[e] = sigmoidf_fast(o0[e]); o1[e] = sigmoidf_fast(o1[e]); }
                        *(u32x4*)(G + (size_t)row * 1024 + cb + 128 * bj) = pack8(o0, o1);
                    }
                }
        }
    }
};

struct EpiMergeFused {
    static constexpr bool PERM = true, AFTER_DRAIN = false; static constexpr int MID_T = 4;
    const bf16_t *GA, *GB; bf16_t* MG;
    __device__ __forceinline__ void mid(f32x4 (&acc)[2][2][4][2], const Unit& u, int wr, int wc, int, int) const {
        int t_ = threadIdx.x; asm volatile("" : "+v"(t_)); const int fr = t_ & 15, fq = (t_ & 63) >> 4;
        const int row0 = u.pm * BM + wr * 64 + fr, col0 = u.pn * BM + wc * 32 + 8 * fq;
#pragma unroll
        for (int ai = 0; ai < 2; ++ai)
#pragma unroll
            for (int m = 0; m < 4; ++m) {
                const int row = row0 + ai * HALF + m * 16;
#pragma unroll
                for (int bj = 0; bj < 2; ++bj) {
                    const size_t off = (size_t)row * 1024 + col0 + bj * HALF;
                    f32x4 a0, a1, b0, b1; unpack8(*(const u32x4*)(GA + off), a0, a1); unpack8(*(const u32x4*)(GB + off), b0, b1);
#pragma unroll
                    for (int e = 0; e < 4; ++e) { acc[ai][bj][m][0][e] *= a0[e] * __builtin_amdgcn_rcpf(fmaxf(b0[e], 1e-30f)); acc[ai][bj][m][1][e] *= a1[e] * __builtin_amdgcn_rcpf(fmaxf(b1[e], 1e-30f)); }
                    asm volatile("" ::: "memory");
                }
            }
    }
    __device__ __forceinline__ void operator()(const f32x4 (&acc)[2][2][4][2], const Unit& u, int wr, int wc, int fr, int fq) const {
        const int row0 = u.pm * BM + wr * 64 + fr, col0 = u.pn * BM + wc * 32 + 8 * fq;
#pragma unroll
        for (int ai = 0; ai < 2; ++ai)
#pragma unroll
            for (int m = 0; m < 4; ++m) {
                const int row = row0 + ai * HALF + m * 16;
#pragma unroll
                for (int bj = 0; bj < 2; ++bj) {
                    const size_t off = (size_t)row * 1024 + col0 + bj * HALF;
                    f32x4 b0, b1; unpack8(*(const u32x4*)(GB + off), b0, b1);
                    *(u32x4*)(MG + off) = pack8(acc[ai][bj][m][0] * b0, acc[ai][bj][m][1] * b1);
                }
                if (m & 1) asm volatile("" ::: "memory");
            }
    }
};

struct NoSide { static constexpr int NV = 1; __device__ __forceinline__ bool pre(f32x4 (&)[1], int) const { return false; } __device__ __forceinline__ void post(const f32x4 (&)[1], bool, int) const {} };
struct SideCopy {
    static constexpr int NV = 6;
    static constexpr int CPB2 = 680, CPB1 = 168, CPB0 = 40;
    static constexpr int NCH2 = 32 * CPB2, NCH1 = 32 * CPB1, NCH0 = 32 * CPB0, NCH = NCH2 + NCH1 + NCH0;
    const float *c128, *c512, *c2048; float* out; int gw; int* step;
    __device__ __forceinline__ bool locate(int id, const f32x4*& s, f32x4*& d) const {
        if (id >= NCH) return false;
        if (id < NCH2) { const int b = id / CPB2, k = id - b * CPB2; s = (const f32x4*)(c2048 + ((size_t)b * 2048 + 8) * 512) + k * 384; d = (f32x4*)(out + 33060864u + (size_t)b * 2048 * 512) + k * 384; return true; }
        id -= NCH2;
        if (id < NCH1) { const int b = id / CPB1, k = id - b * CPB1; s = (const f32x4*)(c512 + ((size_t)b * 512 + 8) * 512) + k * 384; d = (f32x4*)(out + 24672256u + (size_t)b * 512 * 512) + k * 384; return true; }
        id -= NCH1;
        { const int b = id / CPB0, k = id - b * CPB0; s = (const f32x4*)(c128 + ((size_t)b * 128 + 8) * 512) + k * 384; d = (f32x4*)(out + 22575104u + (size_t)b * 128 * 512) + k * 384; return true; }
    }
    __device__ __forceinline__ bool pre(f32x4 (&v)[NV], int lane) const {
        const f32x4* s; f32x4* d; if (!locate(*step * 2048 + gw, s, d)) return false;
#pragma unroll
        for (int q = 0; q < NV; ++q) v[q] = __builtin_nontemporal_load(s + q * 64 + lane);
        return true;
    }
    __device__ __forceinline__ void post(const f32x4 (&v)[NV], bool ok, int lane) const {
        if (ok) { const f32x4* s; f32x4* d; locate(*step * 2048 + gw, s, d);
#pragma unroll
            for (int q = 0; q < NV; ++q) __builtin_nontemporal_store(v[q], d + q * 64 + lane); }
        *step += 1;
    }
};
template <class Epi, class Sched, bool ALIGN_EPI = false, bool SP2 = false, class Side = NoSide>
__device__ __forceinline__ void gemm_phase(PG8_LAS unsigned char* lds, const Gemm g, const Sched& S, const Epi& E, const Side side = Side()) {
    int tid_ = threadIdx.x; asm volatile("" : "+v"(tid_));
    const int tid = tid_, wid = __builtin_amdgcn_readfirstlane(tid >> 6), lane = tid & 63, wr = wid >> 2, wc = wid & 3, fr = lane & 15, fq = lane >> 4;
    const int K = g.K, nt = K / BK;
    unsigned voffA[2], voffB[2];
#pragma unroll
    for (int i = 0; i < 2; ++i) { int R, C; stage_rc(tid * 16 + i * 8192, R, C); const int Rb = Epi::PERM ? ((R & ~31) + perm32(R & 31)) : R;
        voffA[i] = (unsigned)(R * K + C) * 2u; voffB[i] = (unsigned)(Rb * K + C) * 2u; }
    const size_t kstep = (size_t)(BK * 2);
    const size_t hstep = (size_t)HALF * K * 2;
    const size_t tstep = 2 * hstep;
    const unsigned ldsw = (unsigned)wid * 1024u;
    const int aoff = lds_byte(wr * 64 + fr, fq * 8), boff = lds_byte(wc * 32 + fr, fq * 8);
#define PG8_SA(b, h) (((b) * 2 + (h)) * HTB)
#define PG8_SB(b, h) ((4 + (b) * 2 + (h)) * HTB)
#define PG8_STAGE(bufoff, gbase, voff) do { _Pragma("unroll") for (int _i = 0; _i < 2; ++_i) \
        __builtin_amdgcn_global_load_lds((const unsigned*)((const char*)(gbase) + (voff)[_i]), (PG8_LAS unsigned*)(lds + (bufoff) + ldsw + _i * 8192), 16, 0, 0); } while (0)
#define PG8_LDA(dst, b, h) do { _Pragma("unroll") for (int m = 0; m < 4; ++m) _Pragma("unroll") for (int k = 0; k < 2; ++k) dst[m][k] = *(const PG8_LAS bf16x8*)(lds + PG8_SA(b, h) + aoff + m * 2048 + k * 1024); } while (0)
#define PG8_LDB(dst, b, h) do { _Pragma("unroll") for (int n = 0; n < 2; ++n) _Pragma("unroll") for (int k = 0; k < 2; ++k) dst[n][k] = *(const PG8_LAS bf16x8*)(lds + PG8_SB(b, h) + boff + n * 2048 + k * 1024); } while (0)
#define PG8_MMA(ai, bj, At, Bt) do { __builtin_amdgcn_s_setprio(1); _Pragma("unroll") for (int m = 0; m < 4; ++m) _Pragma("unroll") for (int n = 0; n < 2; ++n) _Pragma("unroll") for (int k = 0; k < 2; ++k) \
        acc[ai][bj][m][n] = __builtin_amdgcn_mfma_f32_16x16x32_bf16(Bt[n][k], At[m][k], acc[ai][bj][m][n], 0, 0, 0); __builtin_amdgcn_s_setprio(0); } while (0)
#define PG8_WAIT_V(n) asm volatile("s_waitcnt vmcnt(" #n ")" ::: "memory")
#define PG8_WAIT_L(n) asm volatile("s_waitcnt lgkmcnt(" #n ")" ::: "memory")
#define PG8_BAR __builtin_amdgcn_s_barrier()
#define PG8_SCHED __builtin_amdgcn_sched_barrier(0)
    Unit cur, nxt; int ui = 0;
    if (!S.next(0, cur)) return;
    f32x4 acc[2][2][4][2];
#pragma unroll
    for (int a = 0; a < 2; ++a)
#pragma unroll
        for (int b = 0; b < 2; ++b)
#pragma unroll
            for (int m = 0; m < 4; ++m)
#pragma unroll
                for (int n = 0; n < 2; ++n) acc[a][b][m][n] = (f32x4){0.f, 0.f, 0.f, 0.f};
    bf16x8 At[4][2], B0[2][2], B1[2][2];
    const char* cA = (const char*)g.A + (size_t)cur.pm * tstep; const char* cB = (const char*)g.Bt + (size_t)cur.pn * tstep;
    S.a_ready(cur);
    if constexpr (SP2) {
        PG8_STAGE(PG8_SB(0, 0), cB, voffB); PG8_STAGE(PG8_SB(0, 1), cB + hstep, voffB); PG8_STAGE(PG8_SA(0, 0), cA, voffA); PG8_STAGE(PG8_SA(0, 1), cA + hstep, voffA);
        if (wr == 1) PG8_BAR;
        PG8_WAIT_V(2); PG8_BAR;
        PG8_STAGE(PG8_SB(1, 0), cB + kstep, voffB); PG8_STAGE(PG8_SA(1, 0), cA + kstep, voffA); PG8_STAGE(PG8_SB(1, 1), cB + hstep + kstep, voffB);
        PG8_WAIT_V(6); PG8_BAR;
    } else {
        PG8_STAGE(PG8_SB(0, 0), cB, voffB); PG8_STAGE(PG8_SA(0, 0), cA, voffA); PG8_STAGE(PG8_SB(0, 1), cB + hstep, voffB); PG8_STAGE(PG8_SA(0, 1), cA + hstep, voffA);
        if (wr == 1) PG8_BAR;
        PG8_WAIT_V(4); PG8_BAR;
        PG8_STAGE(PG8_SB(1, 0), cB + kstep, voffB); PG8_STAGE(PG8_SA(1, 0), cA + kstep, voffA); PG8_STAGE(PG8_SB(1, 1), cB + hstep + kstep, voffB);
        PG8_WAIT_V(6); PG8_BAR;
    }
    for (;;) {
        const bool has_next = S.next(ui + 1, nxt);
        const char* nA = has_next ? (const char*)g.A + (size_t)nxt.pm * tstep : cA; const char* nB = has_next ? (const char*)g.Bt + (size_t)nxt.pn * tstep : cB;
        for (int t = 0; t < nt; t += 2) {
            if constexpr (Epi::MID_T >= 0) { if (t == Epi::MID_T) E.mid(acc, cur, wr, wc, fr, fq); }
            const bool last = (t == nt - 2);
            const char* a1 = cA + (size_t)(t + 1) * kstep;
            const char* a2 = last ? nA : cA + (size_t)(t + 2) * kstep; const char* b2 = last ? nB : cB + (size_t)(t + 2) * kstep;
            const char* a3 = a2 + kstep; const char* b3 = b2 + kstep;
            if (last && has_next) S.a_ready(nxt);
            if constexpr (SP2) {
            PG8_LDB(B0, 0, 0); PG8_LDB(B1, 0, 1); PG8_SCHED; PG8_LDA(At, 0, 0); PG8_STAGE(PG8_SA(1, 1), a1 + hstep, voffA);
            PG8_WAIT_V(8); PG8_WAIT_L(0); PG8_BAR; PG8_MMA(0, 0, At, B0); PG8_MMA(0, 1, At, B1); PG8_BAR; PG8_SCHED;
            PG8_LDA(At, 0, 1); PG8_STAGE(PG8_SB(0, 0), b2, voffB); PG8_STAGE(PG8_SB(0, 1), b2 + hstep, voffB); PG8_STAGE(PG8_SA(0, 0), a2, voffA);
            PG8_WAIT_V(8); PG8_WAIT_L(0); PG8_BAR; PG8_MMA(1, 0, At, B0); PG8_MMA(1, 1, At, B1); PG8_BAR; PG8_SCHED;
            PG8_LDB(B0, 1, 0); PG8_LDB(B1, 1, 1); PG8_SCHED; PG8_LDA(At, 1, 0); PG8_STAGE(PG8_SA(0, 1), a2 + hstep, voffA);
            PG8_WAIT_V(8); PG8_WAIT_L(0); PG8_BAR; PG8_MMA(0, 0, At, B0); PG8_MMA(0, 1, At, B1); PG8_BAR; PG8_SCHED;
            PG8_LDA(At, 1, 1); PG8_STAGE(PG8_SB(1, 0), b3, voffB); PG8_STAGE(PG8_SB(1, 1), b3 + hstep, voffB); PG8_STAGE(PG8_SA(1, 0), a3, voffA);
            PG8_WAIT_V(8); PG8_WAIT_L(0); PG8_BAR; PG8_MMA(1, 0, At, B0); PG8_MMA(1, 1, At, B1); PG8_BAR; PG8_SCHED;
            } else {
            PG8_LDB(B0, 0, 0); PG8_SCHED; PG8_LDA(At, 0, 0); PG8_STAGE(PG8_SA(1, 1), a1 + hstep, voffA);
            PG8_WAIT_L(8); PG8_BAR; PG8_WAIT_L(0); PG8_MMA(0, 0, At, B0); PG8_BAR; PG8_SCHED;
            PG8_LDB(B1, 0, 1); PG8_STAGE(PG8_SB(0, 0), b2, voffB);
            PG8_BAR; PG8_WAIT_L(0); PG8_MMA(0, 1, At, B1); PG8_BAR;
            PG8_LDA(At, 0, 1); PG8_STAGE(PG8_SA(0, 0), a2, voffA);
            PG8_BAR; PG8_WAIT_L(0); PG8_MMA(1, 0, At, B0); PG8_BAR; PG8_SCHED;
            PG8_STAGE(PG8_SB(0, 1), b2 + hstep, voffB);
            PG8_WAIT_V(6); PG8_BAR; PG8_MMA(1, 1, At, B1); PG8_BAR;
            PG8_LDB(B0, 1, 0); PG8_SCHED; PG8_LDA(At, 1, 0); PG8_STAGE(PG8_SA(0, 1), a2 + hstep, voffA);
            PG8_WAIT_L(8); PG8_BAR; PG8_WAIT_L(0); PG8_MMA(0, 0, At, B0); PG8_BAR; PG8_SCHED;
            PG8_LDB(B1, 1, 1); PG8_STAGE(PG8_SB(1, 0), b3, voffB);
            PG8_BAR; PG8_WAIT_L(0); PG8_MMA(0, 1, At, B1); PG8_BAR;
            PG8_LDA(At, 1, 1); PG8_STAGE(PG8_SA(1, 0), a3, voffA);
            PG8_BAR; PG8_WAIT_L(0); PG8_MMA(1, 0, At, B0); PG8_BAR; PG8_SCHED;
            PG8_STAGE(PG8_SB(1, 1), b3 + hstep, voffB);
            PG8_WAIT_V(6); PG8_BAR; PG8_MMA(1, 1, At, B1); PG8_BAR;
            }
        }
        if constexpr (ALIGN_EPI) { if (wr == 0) PG8_BAR; }
        if constexpr (!Epi::AFTER_DRAIN) { int t2_ = threadIdx.x; asm volatile("" : "+v"(t2_)); const int lane2_ = t2_ & 63;
            f32x4 sv_[Side::NV]; const bool sok_ = side.pre(sv_, lane2_); E(acc, cur, wr, wc, lane2_ & 15, lane2_ >> 4); side.post(sv_, sok_, lane2_); S.done(cur); }
        if (!has_next) break;
#pragma unroll
        for (int a = 0; a < 2; ++a)
#pragma unroll
            for (int b = 0; b < 2; ++b)
#pragma unroll
                for (int m = 0; m < 4; ++m)
#pragma unroll
                    for (int n = 0; n < 2; ++n) acc[a][b][m][n] = (f32x4){0.f, 0.f, 0.f, 0.f};
        cur = nxt; cA = nA; cB = nB; ++ui;
        if constexpr (ALIGN_EPI) { if (wr == 1) PG8_BAR; }
    }
    PG8_WAIT_V(0);
    if constexpr (!ALIGN_EPI) { if (wr == 0) PG8_BAR; }
    PG8_BAR;
    if constexpr (Epi::AFTER_DRAIN) { E.fused(acc, cur, wr, wc, fr, fq, lds, wid, lane); S.done(cur); }
#undef PG8_SA
#undef PG8_SB
#undef PG8_STAGE
#undef PG8_LDA
#undef PG8_LDB
#undef PG8_MMA
#undef PG8_WAIT_V
#undef PG8_WAIT_L
#undef PG8_BAR
#undef PG8_SCHED
}
}

constexpr int NWAVES = 8;
constexpr int DM = 1024, NBATCH = 4, SEQ = 4096, DBATCH = 32, DSEQ = 8;
constexpr int MP = NBATCH * SEQ, MS = DBATCH * DSEQ, M = MP + MS;
constexpr int FF = 2816, FF2 = 5632, INW = 4864, AW = 768, AOW = 256, PW = 512;
constexpr size_t O_Y = 0, O_KV128P = 17039360u, O_KV512P = 17301504u, O_KV2048P = 18350080u, O_POOLP = 22544384u,
                 O_KV128S = 22575104u, O_KV512S = 24672256u, O_KV2048S = 33060864u, O_POOLS = 66615296u, O_END = 66861056u;
constexpr size_t MiB = 1u << 20;
constexpr size_t WS_CTL = 0, CTL_ZERO_BYTES = 32768;
constexpr size_t WS_WUP1 = 2 * MiB, WS_WDN1 = 13 * MiB, WS_WIN = 19 * MiB, WS_WAB = 29 * MiB, WS_WEFF = 30 * MiB, WS_WOUT = 31 * MiB, WS_WUP2 = 33 * MiB, WS_WDN2 = 44 * MiB;
constexpr size_t WS_RSTD0 = 50 * MiB, WS_SSP1 = 51 * MiB, WS_SSP2 = 53 * MiB, WS_BIAS = 55 * MiB;
constexpr size_t WS_XB = 56 * MiB;
constexpr size_t WS_X1 = 90 * MiB;
constexpr size_t WS_R = 156 * MiB;
constexpr size_t WS_Q = WS_R, WS_K = WS_Q + 25 * MiB, WS_V = WS_K + 25 * MiB;
constexpr size_t WS_U = WS_V + 25 * MiB;
constexpr size_t WS_GA = WS_U + 33 * MiB, WS_GB = WS_GA + 33 * MiB;
constexpr size_t WS_AA = WS_GB + 33 * MiB, WS_DD = WS_AA + 9 * MiB;
constexpr int ADW = 768;
constexpr size_t WS_T = WS_DD + 17 * MiB, WS_MG = WS_T + 33 * MiB, WS_END = WS_MG + 33 * MiB;
static_assert(WS_END <= 512 * MiB, "d_ws map");
static_assert(WS_R + (size_t)M * FF * 2 <= WS_END, "H fits");
constexpr int CW_TMO = 0, CW_BAR = 4096;
constexpr int RING_OFF = 0, RING_BYTES = 131072;
constexpr int LDS_BYTES = 147456;
constexpr int LDSCTL_OFF = LDS_BYTES - 1024, MISC_OFF = LDSCTL_OFF + 320;
#define GAS __attribute__((address_space(1)))
#define LAS __attribute__((address_space(3)))
typedef unsigned short bf16;
typedef unsigned v4u __attribute__((ext_vector_type(4)));
typedef float f32x4 __attribute__((ext_vector_type(4)));
typedef short bf16x8 __attribute__((ext_vector_type(8)));
typedef GAS unsigned gu32;
typedef GAS unsigned long long gu64;
#define RLX_AGENT __ATOMIC_RELAXED, __HIP_MEMORY_SCOPE_AGENT
#define LDS_WAIT() asm volatile("s_waitcnt lgkmcnt(0)" ::: "memory")
#define VM_WAIT() asm volatile("s_waitcnt vmcnt(0)" ::: "memory")
__device__ __forceinline__ unsigned long long rt() { return __builtin_amdgcn_s_memrealtime(); }
__device__ __forceinline__ unsigned f2bf(float f) { unsigned u = __builtin_bit_cast(unsigned, f); return (u + 0x7fffu + ((u >> 16) & 1u)) >> 16; }
__device__ __forceinline__ unsigned pk2(float lo, float hi) { return f2bf(lo) | (f2bf(hi) << 16); }

#define XB_TMO      128
#define XB_XCNT(j)  (256  + 64 * (j))
#define XB_XSUB(j)  (1280 + 64 * (j))
#define XB_XGEN(j)  (2304 + 64 * (j))
#define XB_TOP      3328
#define XB_TOPGEN   3392
#define XCD_BAR_WORDS 3456
#define XB_SPIN_CAP (1u << 18)

__device__ __forceinline__ unsigned xb_ld(unsigned* p)              { return __hip_atomic_load(p, __ATOMIC_RELAXED, __HIP_MEMORY_SCOPE_AGENT); }
__device__ __forceinline__ unsigned xb_add(unsigned* p, unsigned v) { return __hip_atomic_fetch_add(p, v, __ATOMIC_RELAXED, __HIP_MEMORY_SCOPE_AGENT); }
__device__ __forceinline__ unsigned xb_xcc_id() { return (unsigned)__builtin_amdgcn_s_getreg((3 << 11) | 20) & 0xFu; }
#define XB_SPIN(cond, bar) do { unsigned _sp = 0; while (cond) { __builtin_amdgcn_s_sleep(1); \
    if ((++_sp & 255u) == 0u) { if (xb_ld(&(bar)[XB_TMO])) break; if (_sp > XB_SPIN_CAP) { atomicAdd(&(bar)[XB_TMO], 1u); break; } } } } while (0)

struct XcdBarrier {
    unsigned* bar; unsigned x;
    volatile LAS unsigned* st;
};

__device__ __forceinline__ XcdBarrier xcd_barrier_post(unsigned* bar, volatile LAS unsigned* st) {
    XcdBarrier b; b.bar = bar; b.x = xb_xcc_id(); b.st = st;
    if (threadIdx.x == 0) (void)xb_add(&bar[XB_XCNT(b.x)], 1u);
    return b;
}
__device__ __forceinline__ void xcd_barrier_complete(unsigned* bar, unsigned x, unsigned& nloc, unsigned& nx) {
    const unsigned G = gridDim.x * gridDim.y * gridDim.z;
    unsigned sum, cnt, mine, sp = 0u;
    for (;;) {
        sum = 0u; cnt = 0u; mine = 0u;
#pragma unroll
        for (unsigned j = 0; j < 16; ++j) { const unsigned c = xb_ld(&bar[XB_XCNT(j)]); sum += c; cnt += (c > 0u) ? 1u : 0u; mine = (j == x) ? c : mine; }
        if (sum == G) break;
        __builtin_amdgcn_s_sleep(1);
        if ((++sp & 255u) == 0u) { if (xb_ld(&bar[XB_TMO])) break; if (sp > XB_SPIN_CAP) { atomicAdd(&bar[XB_TMO], 1u); break; } }
    }
    nloc = mine > 0u ? mine : 1u; nx = cnt > 0u ? cnt : 1u;
}

__device__ __forceinline__ void xcd_barrier(const XcdBarrier& b) {
    asm volatile("s_waitcnt vmcnt(0)" ::: "memory");
    __syncthreads();
    if (threadIdx.x == 0) {
        unsigned* bar = b.bar;
        __builtin_amdgcn_s_waitcnt(0);
        unsigned nloc = b.st[0], nx = b.st[1];
        if (nloc == 0u) { xcd_barrier_complete(bar, b.x, nloc, nx); b.st[0] = nloc; b.st[1] = nx; }
        const unsigned old = xb_add(&bar[XB_XSUB(b.x)], 1u);
        const unsigned gen = old / nloc;
        if (old + 1u == (gen + 1u) * nloc) {
            __builtin_amdgcn_fence(__ATOMIC_RELEASE, "agent");
            asm volatile("s_waitcnt vmcnt(0)" ::: "memory");
            const unsigned og = xb_add(&bar[XB_TOP], 1u);
            const unsigned tg = og / nx;
            if (og + 1u == (tg + 1u) * nx) xb_add(&bar[XB_TOPGEN], 1u);
            else XB_SPIN(xb_ld(&bar[XB_TOPGEN]) == tg, bar);
            __builtin_amdgcn_fence(__ATOMIC_ACQUIRE, "agent");
            xb_add(&bar[XB_XGEN(b.x)], 1u);
            asm volatile("s_waitcnt vmcnt(0)" ::: "memory");
        } else {
            XB_SPIN(xb_ld(&bar[XB_XGEN(b.x)]) == gen, bar);
            __builtin_amdgcn_fence(__ATOMIC_ACQUIRE, "agent");
            asm volatile("s_waitcnt vmcnt(0)" ::: "memory");
        }
    }
    __syncthreads();
}

struct Frame {
    LAS unsigned char* lds;
    volatile LAS unsigned* MISC;
    gu32* ctl;
    int tid, lane, wave;
    int vcu, G;
};
__device__ __forceinline__ float wave_sum(float v) {
#pragma unroll
    for (int o = 1; o < 64; o <<= 1) v += __shfl_xor(v, o);
    return v;
}
__device__ __forceinline__ float wave_max(float v) {
#pragma unroll
    for (int o = 1; o < 64; o <<= 1) v = fmaxf(v, __shfl_xor(v, o));
    return v;
}
__constant__ unsigned char T5B[3][132] = {
 {0,1,2,3,4,5,6,7,8,9,10,11,12,13,14,15,16,16,16,16,16,16,17,17,17,17,17,17,17,17,18,18,18,18,18,18,18,18,18,18,19,19,19,19,19,19,19,19,19,19,19,19,19,19,20,20,20,20,20,20,20,20,20,20,20,20,20,20,20,20,20,20,20,21,21,21,21,21,21,21,21,21,21,21,21,21,21,21,21,21,21,21,21,21,21,21,21,21,21,22,22,22,22,22,22,22,22,22,22,22,22,22,22,22,22,22,22,22,22,22,22,22,22,22,22,22,22,22,22,0,0,0},
 {0,4,8,12,16,16,17,17,18,18,19,19,19,19,20,20,20,20,20,21,21,21,21,21,21,22,22,22,22,22,22,22,22,22,23,23,23,23,23,23,23,23,23,23,23,23,24,24,24,24,24,24,24,24,24,24,24,24,24,24,24,24,25,25,25,25,25,25,25,25,25,25,25,25,25,25,25,25,25,25,25,25,25,26,26,26,26,26,26,26,26,26,26,26,26,26,26,26,26,26,26,26,26,26,26,26,26,26,26,26,26,26,26,27,27,27,27,27,27,27,27,27,27,27,27,27,27,27,27,0,0,0},
 {0,16,18,19,20,21,21,22,22,23,23,23,24,24,24,24,25,25,25,25,25,26,26,26,26,26,26,26,26,27,27,27,27,27,27,27,27,27,27,28,28,28,28,28,28,28,28,28,28,28,28,28,29,29,29,29,29,29,29,29,29,29,29,29,29,29,29,29,29,29,30,30,30,30,30,30,30,30,30,30,30,30,30,30,30,30,30,30,30,30,30,30,30,30,30,31,31,31,31,31,31,31,31,31,31,31,31,31,31,31,31,31,31,31,31,31,31,31,31,31,31,31,31,31,31,31,31,31,31,0,0,0}};

template <int MAP> __device__ __forceinline__ void p0_transpose_item(const float* W, int K, int N, bf16* WT, const float* gain, LAS float* scr, int item, int lane, int ldw = 0) {
    if (ldw == 0) ldw = K;
    const int nblk = N / 32, kb = item / nblk, nb = item % nblk, k0 = 64 * kb, n0 = 32 * nb;
    int v0 = n0;
    if (MAP == 1) { const int c = n0 < FF ? n0 : n0 - FF; v0 = 256 * (c >> 7) + (n0 < FF ? 0 : 128) + (c & 127); }
    if (MAP == 2) { if (n0 < 1536) { const int o = n0 & 255; v0 = (n0 & ~255) + 128 * ((o >> 5) & 1) + 32 * (o >> 6); } }
    f32x4 wv[8]; const int kr = lane >> 3, n4 = (lane & 7) * 4;
#pragma unroll
    for (int i = 0; i < 8; ++i) wv[i] = *(const f32x4*)(W + (size_t)(k0 + kr + 8 * i) * N + n0 + n4);
#pragma unroll
    for (int i = 0; i < 8; ++i) { const int kk = kr + 8 * i; f32x4 w = wv[i]; if (gain) w = w * gain[k0 + kk];
        LAS float* d = scr + kk * 33 + n4; d[0] = w[0]; d[1] = w[1]; d[2] = w[2]; d[3] = w[3]; }
    LDS_WAIT(); asm volatile("" ::: "memory");
    const int c = lane & 7;
#pragma unroll
    for (int j = 0; j < 4; ++j) { const int n = (lane >> 3) + 8 * j; const LAS float* s = scr + (8 * c) * 33 + n;
        v4u o; o.x = pk2(s[0 * 33], s[1 * 33]); o.y = pk2(s[2 * 33], s[3 * 33]); o.z = pk2(s[4 * 33], s[5 * 33]); o.w = pk2(s[6 * 33], s[7 * 33]);
        *(GAS v4u*)(WT + (size_t)(v0 + n) * ldw + k0 + 8 * c) = o; }
    LDS_WAIT(); asm volatile("" ::: "memory");
}
struct Ptrs {
    const float *xp, *xs, *c128, *c512, *c2048, *spool, *rbias, *n1, *wup1, *wdn1, *nmix, *win, *qn, *kn, *wg, *pscale, *wab, *wpb, *wout, *n2, *wup2, *wdn2;
    float* out; unsigned char* ws;
};
constexpr int I_UP = (DM / 64) * (FF2 / 32), I_DN = (FF / 64) * (DM / 32), I_IN = (DM / 64) * (INW / 32), I_AB = (AOW / 64) * (DM / 32), I_OUT = (DM / 64) * (DM / 32);
constexpr int WI_WUP1 = 0, WI_WDN1 = I_UP, WI_WIN = WI_WDN1 + I_DN, WI_WAB = WI_WIN + I_IN, WI_WOUT = WI_WAB + I_AB, WI_WUP2 = WI_WOUT + I_OUT, WI_WDN2 = WI_WUP2 + I_UP, WI_END = WI_WDN2 + I_DN;
__device__ __forceinline__ void convert_items(const Ptrs& P, int first, int last, int gwh, int ngwh, LAS float* scr, int lane) {
    unsigned char* ws = P.ws;
    for (int it = first + gwh; it < last; it += ngwh) {
        if (it < WI_WDN1) p0_transpose_item<1>(P.wup1, DM, FF2, (bf16*)(ws + WS_WUP1), P.n1, scr, it - WI_WUP1, lane);
        else if (it < WI_WIN) p0_transpose_item<0>(P.wdn1, FF, DM, (bf16*)(ws + WS_WDN1), nullptr, scr, it - WI_WDN1, lane);
        else if (it < WI_WAB) p0_transpose_item<2>(P.win, DM, INW, (bf16*)(ws + WS_WIN), P.nmix, scr, it - WI_WIN, lane);
        else if (it < WI_WOUT) p0_transpose_item<0>(P.wab, AOW, DM, (bf16*)(ws + WS_WAB), nullptr, scr, it - WI_WAB, lane, ADW);
        else if (it < WI_WUP2) p0_transpose_item<0>(P.wout, DM, DM, (bf16*)(ws + WS_WOUT), nullptr, scr, it - WI_WOUT, lane);
        else if (it < WI_WDN2) p0_transpose_item<1>(P.wup2, DM, FF2, (bf16*)(ws + WS_WUP2), P.n2, scr, it - WI_WUP2, lane);
        else p0_transpose_item<0>(P.wdn2, FF, DM, (bf16*)(ws + WS_WDN2), nullptr, scr, it - WI_WDN2, lane);
    }
}

__device__ __forceinline__ void weff_items(const Ptrs& P, int gw, int NGW, int lane) {
    unsigned char* ws = P.ws;
    for (int it = gw; it < 64 * 16; it += NGW) {
        const int kq = it >> 4, nb = it & 15, k = 8 * kq, g = k >> 7, kp = k & 127, n = nb * 64 + lane;
        const float* wgr = P.wg + ((size_t)g * 128 + kp) * 128; const float* sc = P.pscale + 128 * g; const float* wp = P.wpb + (size_t)(128 * g) * DM + n;
        float a[8] = {0.f, 0.f, 0.f, 0.f, 0.f, 0.f, 0.f, 0.f};
#pragma unroll
        for (int cb = 0; cb < 128; cb += 32) {
            float w[32];
#pragma unroll
            for (int c = 0; c < 32; ++c) w[c] = wp[(size_t)(cb + c) * DM];
#pragma unroll
            for (int c = 0; c < 32; ++c) { const float ws_ = w[c] * sc[cb + c];
#pragma unroll
                for (int q = 0; q < 8; ++q) a[q] += wgr[q * 128 + cb + c] * ws_; }
        }
        v4u o; o.x = pk2(a[0], a[1]); o.y = pk2(a[2], a[3]); o.z = pk2(a[4], a[5]); o.w = pk2(a[6], a[7]);
        *(GAS v4u*)((bf16*)(ws + WS_WAB) + (size_t)n * ADW + AOW + k) = o;
    }
}
#ifndef PROBE_AMP
#define PROBE_AMP -1
#endif
#define P0_SPIN(k) do { if (PROBE_AMP == (k)) { const unsigned long long t1_ = __builtin_amdgcn_s_memrealtime(); while (__builtin_amdgcn_s_memrealtime() < t1_ + 2 * (t1_ - tp0_)) __builtin_amdgcn_s_sleep(8); } } while (0)
__device__ __forceinline__ void p0_prologue(Frame& F, const Ptrs& P) {
    const unsigned long long tp0_ = (PROBE_AMP >= 50) ? __builtin_amdgcn_s_memrealtime() : 0ull;
    LAS float* scr = (LAS float*)(F.lds + RING_OFF + F.wave * 16384);
    const int gw = F.vcu * NWAVES + F.wave, NGW = F.G * NWAVES;
    unsigned char* ws = P.ws;
    for (int m0 = gw; m0 < M; m0 += 4 * NGW) {
        f32x4 v[4][4];
#pragma unroll
        for (int q = 0; q < 4; ++q) { const int m = m0 + q * NGW; if (m < M) {
            const float* xrow = (m < MP) ? P.xp + (size_t)m * DM : P.xs + (size_t)(m - MP) * DM; const GAS f32x4* xr = (const GAS f32x4*)xrow + F.lane;
#pragma unroll
            for (int j = 0; j < 4; ++j) v[q][j] = xr[64 * j]; } }
#pragma unroll
        for (int q = 0; q < 4; ++q) { const int m = m0 + q * NGW; if (m < M) {
            float s = 0.f;
#pragma unroll
            for (int j = 0; j < 4; ++j) s += (v[q][j].x * v[q][j].x + v[q][j].y * v[q][j].y) + (v[q][j].z * v[q][j].z + v[q][j].w * v[q][j].w);
            s = wave_sum(s);
            if (F.lane == 0) ((float*)(ws + WS_RSTD0))[m] = __builtin_amdgcn_rsqf(s * (1.0f / DM) + 1e-6f);
            GAS unsigned long long* o8 = (GAS unsigned long long*)((bf16*)(ws + WS_XB) + (size_t)m * DM) + F.lane;
#pragma unroll
            for (int j = 0; j < 4; ++j) o8[64 * j] = (unsigned long long)pk2(v[q][j].x, v[q][j].y) | ((unsigned long long)pk2(v[q][j].z, v[q][j].w) << 32); } }
    }
    P0_SPIN(50);
    convert_items(P, WI_WUP1, WI_WDN1, gw, NGW, scr, F.lane);
    P0_SPIN(52);
    if (blockIdx.x == 0) {
        for (int i = F.tid; i < 3 * 4 * 132; i += NWAVES * 64) { const int g = i / (4 * 132), h = (i / 132) & 3, j = i % 132;
            ((float*)(ws + WS_BIAS))[i] = (j <= 128) ? P.rbias[(int)T5B[g][j] * 12 + 4 * g + h] * 1.4426950408889634f : 0.f; }
    }
    for (long i = (long)F.vcu * (NWAVES * 64) + F.tid; i < (long)DBATCH * 7 * 128; i += (long)F.G * (NWAVES * 64)) {
        const long b = i / (7 * 128), r = i - b * (7 * 128);
        ((f32x4*)(P.out + O_POOLS + (size_t)b * 15 * 512))[r] = ((const f32x4*)(P.spool + ((size_t)b * 15 + 8) * 512))[r];
    }
}

typedef float f32x16 __attribute__((ext_vector_type(16)));
typedef short s16x4 __attribute__((ext_vector_type(4)));
typedef short v4i16_t __attribute__((ext_vector_type(4)));
__device__ __forceinline__ int crow(int r, int hi) { return (r & 3) + 8 * (r >> 2) + 4 * hi; }
__device__ __forceinline__ s16x4 vtr(const LAS unsigned char* p) { return __builtin_bit_cast(s16x4, __builtin_amdgcn_ds_read_tr16_b64_v4i16((LAS v4i16_t*)p)); }
__device__ __forceinline__ unsigned cvtpk(float lo, float hi) { typedef float f2 __attribute__((ext_vector_type(2))); typedef __bf16 b2 __attribute__((ext_vector_type(2))); f2 v = {lo, hi}; b2 b = __builtin_convertvector(v, b2); return __builtin_bit_cast(unsigned, b); }

constexpr int ATT_WLDS = 16384;
constexpr int TB_JMIN1 = -128, TB_N1 = 384, TB_JMIN2 = -32, TB_N2 = 192, TB0_S = 72, TB0_COPY = 16 * TB0_S;
constexpr int TB_OFF1 = 0, TB_OFF2 = TB_N1, TB_OFF0 = TB_N1 + TB_N2, TB_TOTAL = TB_N1 + TB_N2 + 2 * TB0_COPY;
constexpr int ATT_TB_OFF = 4096, ATT_SC_OFF = 4096 + 4 * TB_TOTAL;
static_assert(ATT_SC_OFF + 768 <= ATT_WLDS, "per-wave LDS map");

struct AttnState { f32x16 o0, o1, lacc; float m; };

__device__ __forceinline__ void attn_build_tables(const float* BIAS, int h, LAS float* tb, LAS float* stage, int lane_in) {
    int lane = lane_in; asm volatile("" : "+v"(lane));
    float raw[7];
#pragma unroll
    for (int q = 0; q < 7; ++q) { const int i = q * 64 + lane; raw[q] = (i < 3 * 132) ? BIAS[((i / 132) * 4 + h) * 132 + (i % 132)] : 0.f; }
#pragma unroll
    for (int q = 0; q < 7; ++q) { const int i = q * 64 + lane; if (i < 3 * 132) stage[i] = raw[q]; }
    asm volatile("s_waitcnt lgkmcnt(0)" ::: "memory");
#pragma unroll 1
    for (int i = lane; i < TB_OFF0; i += 64) {
        int g, j;
        if (i < TB_OFF2) { g = 1; j = i - TB_OFF1 + TB_JMIN1; } else { g = 2; j = i - TB_OFF2 + TB_JMIN2; }
        const bool ok = (unsigned)j <= 128u;
        const float v = stage[g * 132 + (ok ? j : 0)];
        tb[i] = ok ? v : -INFINITY;
    }
#pragma unroll 1
    for (int i = lane; i < 2 * TB0_COPY; i += 64) {
        const int k = i / TB0_COPY, xp = i - k * TB0_COPY, j = xp - 512 - 4 * k;
        const bool ok = (unsigned)j <= 128u;
        const float v = stage[ok ? j : 0];
        tb[TB_OFF0 + k * TB0_COPY + (xp & 15) * TB0_S + (xp >> 4)] = ok ? v : -INFINITY;
    }
    asm volatile("s_waitcnt lgkmcnt(0)" ::: "memory");
}

template <int G, bool PMASK> __device__ __forceinline__ void attn_group(AttnState& st, const bf16* __restrict__ Qb, const bf16* __restrict__ Kb, const bf16* __restrict__ Vb,
                                                            int b, int s, int h, int r, LAS unsigned char* wl, int lane_in) {
    int lane = lane_in;
    constexpr int D = 1 << (2 * G), E = 16 / D, NT = (G == 0) ? 20 : (G == 1) ? 8 : 5;
    constexpr int TOFF = (G == 1) ? TB_OFF1 : TB_OFF2, TJMIN = (G == 1) ? TB_JMIN1 : TB_JMIN2;
    asm volatile("" : "+v"(lane));
    const int i = lane & 31, hi = lane >> 5;
    const int rg = r & (D - 1), cg = r >> (2 * G), P0 = (512 * s) >> (2 * G);
    const int p_i = P0 + E * i + cg, p_lo = P0 + cg - 128;
    const int pmax = (SEQ >> (2 * G)) - 1;
    const int col = (4 * G + h) * 64;
    const size_t rowb = (size_t)b * SEQ;
    bf16x8 qf[4];
    { const bf16* qp = Qb + (rowb + 512 * s + 16 * i + r) * AW + col + 32 * hi;
#pragma unroll
      for (int s4 = 0; s4 < 4; ++s4) qf[s4] = *(const bf16x8*)(qp + 8 * s4); }
    const LAS unsigned char* vb0 = wl + ((lane >> 4) & 1) * 32 + (lane & 3) * 8 + (4 * hi + ((lane & 15) >> 2)) * 64;
    const LAS float* tbg = (G == 0) ? (const LAS float*)(wl + ATT_TB_OFF) + TB_OFF0 + hi * TB0_COPY + i + 38
                                    : (const LAS float*)(wl + ATT_TB_OFF) + TOFF - TJMIN - 27;
    constexpr float C2 = 0.125f * 1.4426950408889634f;
    const bf16x8 ones = {(short)0x3f80, (short)0x3f80, (short)0x3f80, (short)0x3f80, (short)0x3f80, (short)0x3f80, (short)0x3f80, (short)0x3f80};
    bf16x8 kf[4]; v4u vv[4];
#define ATT_LOAD_TILE(kt, kk, vw) do { \
        int p_ = p_lo + 32 * (kt) + i; p_ = p_ < 0 ? 0 : (p_ > pmax ? pmax : p_); \
        const bf16* kp_ = Kb + (rowb + (size_t)(D * p_ + rg)) * AW + col + 32 * hi; \
        _Pragma("unroll") for (int s4 = 0; s4 < 4; ++s4) kk[s4] = *(const bf16x8*)(kp_ + 8 * s4); \
        _Pragma("unroll") for (int kg = 0; kg < 2; ++kg) { int pv_ = p_lo + 32 * (kt) + 16 * kg + (lane >> 2); pv_ = pv_ < 0 ? 0 : (pv_ > pmax ? pmax : pv_); \
            const bf16* vp_ = Vb + (rowb + (size_t)(D * pv_ + rg)) * AW + col + 8 * (lane & 3); \
            vw[kg] = *(const v4u*)(vp_); vw[2 + kg] = *(const v4u*)(vp_ + 32); } } while (0)
    ATT_LOAD_TILE(0, kf, vv);
    for (int kt = 0; kt < NT; ++kt) {
        bf16x8 kn[4]; v4u vn[4];
        if (kt + 1 < NT) ATT_LOAD_TILE(kt + 1, kn, vn);
        f32x16 sa = {};
#pragma unroll
        for (int s4 = 0; s4 < 4; ++s4) sa = __builtin_amdgcn_mfma_f32_32x32x16_bf16(kf[s4], qf[s4], sa, 0, 0, 0);
#pragma unroll
        for (int pc = 0; pc < 4; ++pc) *(LAS v4u*)(wl + ((pc >> 1) * 2048 + (pc & 1) * 1024) + lane * 16) = vv[(pc >> 1) * 2 + (pc & 1)];
        const int J0 = E * i + 128 - 32 * kt - 4 * hi;
        const LAS float* tbp = (G == 0) ? tbg - 2 * kt : tbg + J0;
        float mx = -INFINITY;
#pragma unroll
        for (int rho = 0; rho < 16; ++rho) {
            constexpr int dummy_ = 0; const int c_ = (rho & 3) + 8 * (rho >> 2);
            float v = sa[rho] * C2 + ((G == 0) ? tbp[((16 - (c_ & 15)) & 15) * TB0_S - ((c_ + 15) >> 4) + 2] : tbp[27 - c_]);
            if (PMASK) { const int j = J0 - ((rho & 3) + 8 * (rho >> 2)); v = (j > p_i) ? -INFINITY : v; }
            sa[rho] = v; mx = fmaxf(mx, v);
        }
        mx = fmaxf(mx, __shfl_xor(mx, 32));
        if (__any(mx > st.m + 6.0f)) {
            const float mn = fmaxf(st.m, mx), f = __builtin_amdgcn_exp2f(st.m - mn);
            st.m = mn;
            LAS float* wsf = (LAS float*)(wl + ATT_SC_OFF);
            if (hi == 0) wsf[i] = f;
            asm volatile("s_waitcnt lgkmcnt(0)" ::: "memory");
#pragma unroll
            for (int rho = 0; rho < 16; ++rho) { const float ff = wsf[crow(rho, hi)]; st.o0[rho] *= ff; st.o1[rho] *= ff; st.lacc[rho] *= ff; }
        }
#pragma unroll
        for (int rho = 0; rho < 16; ++rho) sa[rho] = __builtin_amdgcn_exp2f(sa[rho] - st.m);
        v4u pw0, pw1;
        pw0.x = cvtpk(sa[0], sa[1]); pw0.y = cvtpk(sa[2], sa[3]); pw0.z = cvtpk(sa[4], sa[5]); pw0.w = cvtpk(sa[6], sa[7]);
        pw1.x = cvtpk(sa[8], sa[9]); pw1.y = cvtpk(sa[10], sa[11]); pw1.z = cvtpk(sa[12], sa[13]); pw1.w = cvtpk(sa[14], sa[15]);
        asm volatile("s_waitcnt lgkmcnt(0)" ::: "memory");
        st.lacc = __builtin_amdgcn_mfma_f32_32x32x16_bf16(__builtin_bit_cast(bf16x8, pw0), ones, st.lacc, 0, 0, 0);
        st.lacc = __builtin_amdgcn_mfma_f32_32x32x16_bf16(__builtin_bit_cast(bf16x8, pw1), ones, st.lacc, 0, 0, 0);
#pragma unroll
        for (int dh = 0; dh < 2; ++dh) {
#pragma unroll
            for (int ks = 0; ks < 2; ++ks) {
                const s16x4 lo = vtr(vb0 + dh * 2048 + ks * 1024), hh = vtr(vb0 + dh * 2048 + ks * 1024 + 512);
                const bf16x8 vf = {lo[0], lo[1], lo[2], lo[3], hh[0], hh[1], hh[2], hh[3]};
                const bf16x8 pf = __builtin_bit_cast(bf16x8, ks == 0 ? pw0 : pw1);
                if (dh == 0) st.o0 = __builtin_amdgcn_mfma_f32_32x32x16_bf16(pf, vf, st.o0, 0, 0, 0);
                else         st.o1 = __builtin_amdgcn_mfma_f32_32x32x16_bf16(pf, vf, st.o1, 0, 0, 0);
            }
        }
        asm volatile("" ::: "memory");
        if (kt + 1 < NT) {
#pragma unroll
            for (int q = 0; q < 4; ++q) { kf[q] = kn[q]; vv[q] = vn[q]; }
        }
    }
#undef ATT_LOAD_TILE
}

__device__ __forceinline__ void attn_prompt_unit(int unit, const bf16* Qb, const bf16* Kb, const bf16* Vb, bf16* AA, LAS unsigned char* wl, int lane) {
    const int r = unit & 15, h = (unit >> 4) & 3, s = (unit >> 6) & 7, b = unit >> 9;
    AttnState st; st.o0 = f32x16{}; st.o1 = f32x16{}; st.lacc = f32x16{}; st.m = -30000.0f;
#ifndef PROBE_AMP
#define PROBE_AMP -1
#endif
#define ATT_SPIN(k, t0) do { if (PROBE_AMP == (k)) { const unsigned long long t1_ = __builtin_amdgcn_s_memrealtime(); while (__builtin_amdgcn_s_memrealtime() < t1_ + 2 * (t1_ - (t0))) __builtin_amdgcn_s_sleep(8); } } while (0)
    const unsigned long long ta_ = (PROBE_AMP >= 44) ? __builtin_amdgcn_s_memrealtime() : 0ull;
    if (s < 4) attn_group<2, true>(st, Qb, Kb, Vb, b, s, h, r, wl, lane); else attn_group<2, false>(st, Qb, Kb, Vb, b, s, h, r, wl, lane);
    if (s == 0) attn_group<1, true>(st, Qb, Kb, Vb, b, s, h, r, wl, lane); else attn_group<1, false>(st, Qb, Kb, Vb, b, s, h, r, wl, lane);
    ATT_SPIN(44, ta_);
    const unsigned long long tb_ = (PROBE_AMP >= 44) ? __builtin_amdgcn_s_memrealtime() : 0ull;
    if (s == 0) attn_group<0, true>(st, Qb, Kb, Vb, b, s, h, r, wl, lane); else attn_group<0, false>(st, Qb, Kb, Vb, b, s, h, r, wl, lane);
    ATT_SPIN(45, tb_);
    const int i = lane & 31, hi = lane >> 5;
#pragma unroll
    for (int rho = 0; rho < 16; ++rho) {
        const int qi = crow(rho, hi); const float ff = __builtin_amdgcn_rcpf(st.lacc[rho]);
        bf16* op = AA + ((size_t)b * SEQ + 512 * s + 16 * qi + r) * ADW + h * 64 + i;
        op[0] = (bf16)f2bf(st.o0[rho] * ff); op[32] = (bf16)f2bf(st.o1[rho] * ff);
    }
}

__device__ __forceinline__ float red16(float x) {
    x += __int_as_float(__builtin_amdgcn_update_dpp(0, __float_as_int(x), 0xB1, 0xf, 0xf, true));
    x += __int_as_float(__builtin_amdgcn_update_dpp(0, __float_as_int(x), 0x4E, 0xf, 0xf, true));
    x += __int_as_float(__builtin_amdgcn_update_dpp(0, __float_as_int(x), 0x141, 0xf, 0xf, true));
    x += __int_as_float(__builtin_amdgcn_update_dpp(0, __float_as_int(x), 0x140, 0xf, 0xf, true));
    return x;
}
struct SampleState { float m, l; f32x4 o; };
template <int G> __device__ __forceinline__ void attn_sample_group(SampleState& st, const float* cache, const float* outw, const LAS float* qs, const float* biasg, int b, int h, int t, int lane) {
    constexpr int D = 1 << (2 * G), WIN = 128 << (2 * G);
    const int kq = lane >> 4, d4 = (lane & 15) * 4;
    const f32x4 qv = *(const LAS f32x4*)(qs + G * 64 + d4);
    const unsigned long long cb = (unsigned long long)(cache + ((size_t)b * WIN * 512 + h * 64 + d4));
    const unsigned long long ob = (unsigned long long)(outw + ((size_t)b * WIN * 512 + h * 64 + d4)) - 8ull * 2048ull;
#define SMP_LOAD(bt_, kv_, vv_) do { _Pragma("unroll") for (int q = 0; q < 11; ++q) { int j_ = 44 * (bt_) + 4 * q + kq; j_ = j_ > 128 ? 128 : j_; const int idx_ = WIN + t - D * j_; \
            const unsigned long long a_ = ((idx_ >= WIN) ? ob : cb) + (unsigned long long)idx_ * 2048ull; kv_[q] = *(const f32x4*)a_; vv_[q] = *(const f32x4*)(a_ + 1024ull); } } while (0)
#define SMP_CONSUME(bt_, kv_, vv_) do { float sv[11]; float bm = -INFINITY; \
        _Pragma("unroll") for (int q = 0; q < 11; ++q) { const int j0 = 44 * (bt_) + 4 * q + kq; const int j = j0 > 128 ? 128 : j0; \
            float dt = (kv_[q][0] * qv[0] + kv_[q][1] * qv[1]) + (kv_[q][2] * qv[2] + kv_[q][3] * qv[3]); dt = red16(dt) + biasg[j]; \
            sv[q] = (j0 <= 128) ? dt : -INFINITY; bm = fmaxf(bm, sv[q]); } \
        bm = fmaxf(bm, __shfl_xor(bm, 16)); bm = fmaxf(bm, __shfl_xor(bm, 32)); \
        const float mn = fmaxf(st.m, bm), f = __builtin_amdgcn_exp2f(st.m - mn); st.m = mn; st.l *= f; st.o = st.o * f; \
        _Pragma("unroll") for (int q = 0; q < 11; ++q) { const float p = __builtin_amdgcn_exp2f(sv[q] - st.m); st.l += p; st.o += vv_[q] * p; } } while (0)
    f32x4 ka[11], va[11], kb[11], vb[11];
    SMP_LOAD(0, ka, va); SMP_LOAD(1, kb, vb);
    SMP_CONSUME(0, ka, va); SMP_LOAD(2, ka, va);
    SMP_CONSUME(1, kb, vb);
    SMP_CONSUME(2, ka, va);
#undef SMP_LOAD
#undef SMP_CONSUME
}
__device__ __forceinline__ void attn_sample_unit(int su, const Ptrs& P, const bf16* Qb, bf16* AA, const float* biasG, LAS unsigned char* wl, int lane) {
    const int t = su & 7, h = (su >> 3) & 3, b = su >> 5;
    LAS float* qs = (LAS float*)(wl + ATT_SC_OFF);
    const size_t qrow = (size_t)(MP + b * 8 + t) * AW;
#pragma unroll
    for (int g = 0; g < 3; ++g) qs[g * 64 + lane] = __uint_as_float((unsigned)Qb[qrow + (4 * g + h) * 64 + lane] << 16) * (0.125f * 1.4426950408889634f);
    asm volatile("s_waitcnt lgkmcnt(0)" ::: "memory");
    SampleState st; st.m = -30000.0f; st.l = 0.f; st.o = (f32x4){0.f, 0.f, 0.f, 0.f};
    attn_sample_group<2>(st, P.c2048, P.out + O_KV2048S, qs, biasG + (8 + h) * 132, b, h, t, lane);
    attn_sample_group<1>(st, P.c512, P.out + O_KV512S, qs, biasG + (4 + h) * 132, b, h, t, lane);
    attn_sample_group<0>(st, P.c128, P.out + O_KV128S, qs, biasG + (0 + h) * 132, b, h, t, lane);
    float l = st.l; f32x4 o = st.o;
    l += __shfl_xor(l, 16); l += __shfl_xor(l, 32);
#pragma unroll
    for (int e = 0; e < 4; ++e) { o[e] += __shfl_xor(o[e], 16); o[e] += __shfl_xor(o[e], 32); }
    const int d4 = (lane & 15) * 4;
    if (lane < 16) { const float inv = 1.0f / l;
        *(GAS unsigned long long*)(AA + (size_t)(MP + b * 8 + t) * ADW + h * 64 + d4) = (unsigned long long)pk2(o[0] * inv, o[1] * inv) | ((unsigned long long)pk2(o[2] * inv, o[3] * inv) << 32); }
    asm volatile("s_waitcnt lgkmcnt(0)" ::: "memory");
}

struct CopyLoc { const f32x4* s; f32x4* d; };
constexpr int CC_B2 = 510, CC_B1 = 126, CC_B0 = 30, CC_N2 = 32 * CC_B2, CC_N1 = 32 * CC_B1, CC_N0 = 32 * CC_B0, CC_TOTAL = CC_N2 + CC_N1 + CC_N0;
__device__ __forceinline__ CopyLoc copy_locate(const Ptrs& P, int id) {
    CopyLoc L;
    if (id < CC_N2) { const int b = id / CC_B2, k = id - b * CC_B2; L.s = (const f32x4*)(P.c2048 + ((size_t)b * 2048 + 8) * 512) + k * 512; L.d = (f32x4*)(P.out + O_KV2048S + (size_t)b * 2048 * 512) + k * 512; return L; }
    id -= CC_N2;
    if (id < CC_N1) { const int b = id / CC_B1, k = id - b * CC_B1; L.s = (const f32x4*)(P.c512 + ((size_t)b * 512 + 8) * 512) + k * 512; L.d = (f32x4*)(P.out + O_KV512S + (size_t)b * 512 * 512) + k * 512; return L; }
    id -= CC_N1;
    { const int b = id / CC_B0, k = id - b * CC_B0; L.s = (const f32x4*)(P.c128 + ((size_t)b * 128 + 8) * 512) + k * 512; L.d = (f32x4*)(P.out + O_KV128S + (size_t)b * 128 * 512) + k * 512; return L; }
}
__device__ __forceinline__ void copy_chunks(const Ptrs& P, int id_begin, int id_end, int mw, int NMW, int lane) {
    const int CC_N = id_end;
    f32x4 va[8], vb[8];
    int id = id_begin + mw;
    if (id < CC_N) { const CopyLoc L = copy_locate(P, id);
#pragma unroll
        for (int q = 0; q < 8; ++q) va[q] = __builtin_nontemporal_load(L.s + q * 64 + lane); }
    for (; id < CC_N; id += 2 * NMW) {
        const int id2 = id + NMW, id3 = id + 2 * NMW;
        if (id2 < CC_N) { const CopyLoc L = copy_locate(P, id2);
#pragma unroll
            for (int q = 0; q < 8; ++q) vb[q] = __builtin_nontemporal_load(L.s + q * 64 + lane); }
        { const CopyLoc L = copy_locate(P, id);
#pragma unroll
            for (int q = 0; q < 8; ++q) __builtin_nontemporal_store(va[q], L.d + q * 64 + lane); }
        if (id3 < CC_N) { const CopyLoc L = copy_locate(P, id3);
#pragma unroll
            for (int q = 0; q < 8; ++q) va[q] = __builtin_nontemporal_load(L.s + q * 64 + lane); }
        if (id2 < CC_N) { const CopyLoc L = copy_locate(P, id2);
#pragma unroll
            for (int q = 0; q < 8; ++q) __builtin_nontemporal_store(vb[q], L.d + q * 64 + lane); }
    }
}

template <int W> __device__ __forceinline__ void pool_block(const float* __restrict__ U, bf16* __restrict__ DD, int rb, int gi, int lane) {
    const int r0 = 16 * rb + 8 * (lane >> 5), c4 = gi * 128 + (lane & 31) * 4, t0 = r0 & (SEQ - 1);
    f32x4 v[W + 7];
#pragma unroll
    for (int i = 0; i < W + 7; ++i) { const int dt = i - (W - 1); const int ri = (t0 + dt >= 0) ? r0 + dt : r0; v[i] = *(const f32x4*)(U + (size_t)ri * PW + c4); }
#pragma unroll
    for (int i = 0; i < W - 1; ++i) { if (t0 + i - (W - 1) < 0) v[i] = (f32x4){0.f, 0.f, 0.f, 0.f}; }
    f32x4 s = v[0];
#pragma unroll
    for (int i = 1; i < W; ++i) s += v[i];
#pragma unroll
    for (int o = 0; o < 8; ++o) {
        if (o > 0) s += v[W - 1 + o] - v[o - 1];
        const int t = t0 + o; const float inv = 1.0f / (float)((t + 1 < W) ? t + 1 : W); const f32x4 dd = s * inv - v[W - 1 + o];
        *(GAS unsigned long long*)(DD + (size_t)(r0 + o) * ADW + AOW + c4) = (unsigned long long)pk2(dd[0], dd[1]) | ((unsigned long long)pk2(dd[2], dd[3]) << 32);
    }
}
__device__ __forceinline__ void pool_items(const Ptrs& P, const float* U, bf16* DD, int mw, int NMW, int lane) {
    for (int it = mw; it < (MP / 16) * 4; it += NMW) {
        const int gi = it & 3, rb = it >> 2;
        if (gi == 0) pool_block<2>(U, DD, rb, 0, lane); else if (gi == 1) pool_block<4>(U, DD, rb, 1, lane); else if (gi == 2) pool_block<8>(U, DD, rb, 2, lane); else pool_block<16>(U, DD, rb, 3, lane);
    }
    for (int it = mw * 64 + lane; it < MS * 128; it += NMW * 64) {
        const int sidx = it >> 7, row = MP + sidx, c4 = (it & 127) * 4, w = 2 << (c4 >> 7), b = sidx >> 3, t = sidx & 7;
        f32x4 s = {0.f, 0.f, 0.f, 0.f};
        const f32x4 own = *(const f32x4*)(U + (size_t)row * PW + c4);
        for (int i = 0; i < w; ++i) { const int idx = 15 + t - i;
            s += (idx >= 15) ? *(const f32x4*)(U + (size_t)(MP + b * 8 + idx - 15) * PW + c4) : *(const f32x4*)(P.spool + ((size_t)b * 15 + idx) * PW + c4); }
        const float inv = 1.0f / (float)w; const f32x4 dd = s * inv - own;
        *(GAS unsigned long long*)(DD + (size_t)row * ADW + AOW + c4) = (unsigned long long)pk2(dd[0], dd[1]) | ((unsigned long long)pk2(dd[2], dd[3]) << 32);
    }
}


template <int KS  , int LD  > __device__ __forceinline__ void micro_partial(const pg8::bf16_t* A, const pg8::bf16_t* Bt, int row0, int col0, int wave, int lane, f32x4 (&acc)[4]) {
    constexpr int K = LD, NS = KS / 32, NB = (NS > 4) ? 4 : NS;
    const int fr = lane & 15, fq = lane >> 4;
    const pg8::bf16_t* ap = A + (size_t)(row0 + fr) * K + wave * KS + 8 * fq;
    const pg8::bf16_t* bp = Bt + (size_t)(col0 + fr) * K + wave * KS + 8 * fq;
#pragma unroll
    for (int k0 = 0; k0 < NS; k0 += NB) {
        bf16x8 af[NB], bf[NB][4];
#pragma unroll
        for (int s = 0; s < NB; ++s) if (k0 + s < NS) { af[s] = *(const bf16x8*)(ap + (k0 + s) * 32);
#pragma unroll
            for (int nb = 0; nb < 4; ++nb) bf[s][nb] = *(const bf16x8*)(bp + (size_t)(16 * nb) * K + (k0 + s) * 32); }
#pragma unroll
        for (int s = 0; s < NB; ++s) if (k0 + s < NS) {
#pragma unroll
            for (int nb = 0; nb < 4; ++nb) acc[nb] = __builtin_amdgcn_mfma_f32_16x16x32_bf16(bf[s][nb], af[s], acc[nb], 0, 0, 0); }
    }
}
typedef float f32x2 __attribute__((ext_vector_type(2)));
__device__ __forceinline__ f32x2 micro_reduce(LAS unsigned char* red, const f32x4 (&acc)[4], int wave, int lane, int tid) {
    const int fr = lane & 15, fq = lane >> 4;
    LAS float* pw = (LAS float*)red + wave * 1024 + fr * 64 + 4 * fq;
#pragma unroll
    for (int nb = 0; nb < 4; ++nb) *(LAS f32x4*)(pw + 16 * nb) = acc[nb];
    __syncthreads();
    const LAS float* pr = (const LAS float*)red + (tid >> 5) * 64 + 2 * (tid & 31);
    f32x2 s = {0.f, 0.f};
#pragma unroll
    for (int w = 0; w < 8; ++w) s += *(const LAS f32x2*)(pr + w * 1024);
    __syncthreads();
    return s;
}
template <int MODE, int K> __device__ __forceinline__ void micro_resid(LAS unsigned char* red, int blk, const pg8::bf16_t* A, const pg8::bf16_t* Bt, pg8::bf16_t* XB, float* ssp, float* out) {
    int tid_ = threadIdx.x; asm volatile("" : "+v"(tid_));
    const int tid = tid_, lane = tid & 63, wave = __builtin_amdgcn_readfirstlane(tid >> 6);
    const int row0 = MP + 16 * (blk >> 4), col0 = 64 * (blk & 15);
    f32x4 acc[4] = {};
    micro_partial<K / 8, K>(A, Bt, row0, col0, wave, lane, acc);
    const f32x2 s = micro_reduce(red, acc, wave, lane, tid);
    const int row = row0 + (tid >> 5), col = col0 + 2 * (tid & 31);
    const float alpha = (MODE == 1) ? 1.0f : 0.5f;
    const unsigned xw = *(const unsigned*)(XB + (size_t)row * DM + col);
    f32x2 v; v[0] = __uint_as_float(xw << 16) + s[0] * alpha; v[1] = __uint_as_float(xw & 0xffff0000u) + s[1] * alpha;
    if (MODE == 2) { *(f32x2*)(out + (size_t)row * DM + col) = v; }
    else {
        *(unsigned*)(XB + (size_t)row * DM + col) = pk2(v[0], v[1]);
        float ss = v[0] * v[0] + v[1] * v[1];
#pragma unroll
        for (int o = 1; o < 32; o <<= 1) ss += __shfl_xor(ss, o);
        if ((tid & 31) == 0) ssp[(size_t)row * 16 + (blk & 15)] = ss;
    }
}
__device__ __forceinline__ void micro_merge(LAS unsigned char* red, int blk, const pg8::bf16_t* AA, const pg8::bf16_t* WAB, const pg8::bf16_t* DD, const pg8::bf16_t* WEFF,
                                            const pg8::bf16_t* GA, const pg8::bf16_t* GB, pg8::bf16_t* MG) {
    int tid_ = threadIdx.x; asm volatile("" : "+v"(tid_));
    const int tid = tid_, lane = tid & 63, wave = __builtin_amdgcn_readfirstlane(tid >> 6);
    const int row0 = MP + 16 * (blk >> 4), col0 = 64 * (blk & 15);
    f32x4 acc[4] = {};
    micro_partial<AOW / 8, ADW>(AA, WAB, row0, col0, wave, lane, acc);
    const f32x2 s1 = micro_reduce(red, acc, wave, lane, tid);
#pragma unroll
    for (int nb = 0; nb < 4; ++nb) acc[nb] = (f32x4){0.f, 0.f, 0.f, 0.f};
    micro_partial<PW / 8, ADW>(DD, WEFF, row0, col0, wave, lane, acc);
    const f32x2 s2 = micro_reduce(red, acc, wave, lane, tid);
    const int row = row0 + (tid >> 5), col = col0 + 2 * (tid & 31);
    const unsigned ga = *(const unsigned*)(GA + (size_t)row * DM + col), gb = *(const unsigned*)(GB + (size_t)row * DM + col);
    const float m0 = __uint_as_float(ga << 16) * s1[0] + __uint_as_float(gb << 16) * s2[0];
    const float m1 = __uint_as_float(ga & 0xffff0000u) * s1[1] + __uint_as_float(gb & 0xffff0000u) * s2[1];
    *(unsigned*)(MG + (size_t)row * DM + col) = pk2(m0, m1);
}

#ifndef PROBE_AMP
#define PROBE_AMP -1
#endif
struct Args { Ptrs p; };
__global__ void __launch_bounds__(NWAVES * 64, 2) hybrid_fwd(Args args) {
    extern __shared__ __attribute__((aligned(16))) unsigned char lds[];
    Frame F;
    F.lds = (LAS unsigned char*)lds;
    F.MISC = (volatile LAS unsigned*)(F.lds + MISC_OFF);
    F.tid = threadIdx.x; F.lane = F.tid & 63; F.wave = __builtin_amdgcn_readfirstlane(F.tid >> 6);
    F.G = gridDim.x; { const int bx = blockIdx.x; F.vcu = (F.G % 8 == 0) ? (bx % 8) * (F.G / 8) + bx / 8 : bx; }
    const Ptrs& P = args.p;
    unsigned char* ws = P.ws;
    F.ctl = (gu32*)(ws + WS_CTL);
    for (int u = F.tid; u < (LDS_BYTES - LDSCTL_OFF) / 4; u += NWAVES * 64) ((LAS unsigned*)(F.lds + LDSCTL_OFF))[u] = 0u;
    __syncthreads();
    XcdBarrier bar = xcd_barrier_post((unsigned*)(F.ctl + CW_BAR), F.MISC + 8);
#define GRID_BAR() xcd_barrier(bar)
    unsigned long long tph_ = 0;
#define PH_BEGIN() do { if (PROBE_AMP >= 0) tph_ = __builtin_amdgcn_s_memrealtime(); } while (0)
#define PH_END(k) do { if (PROBE_AMP >= 0) { const unsigned long long tn_ = __builtin_amdgcn_s_memrealtime(); if (PROBE_AMP == (k)) { while (__builtin_amdgcn_s_memrealtime() < tn_ + 2 * (tn_ - tph_)) __builtin_amdgcn_s_sleep(8); } tph_ = __builtin_amdgcn_s_memrealtime(); } } while (0)
#define WSP(T, off) ((T*)(ws + (off)))
    typedef pg8::bf16_t b16;
    const int c = (int)blockIdx.x;

    PH_BEGIN();
    p0_prologue(F, P);
    GRID_BAR();
    PH_END(0);
    {   pg8::Gemm g{WSP(b16, WS_XB), WSP(b16, WS_WUP1), M, FF2, DM}; pg8::StaticOrder S; S.init(M, FF2, F.G, c);
        pg8::EpiSwiglu<false> E{WSP(b16, WS_R), WSP(float, WS_RSTD0)};
        pg8::gemm_phase<pg8::EpiSwiglu<false>, pg8::StaticOrder, true, true>(F.lds + RING_OFF, g, S, E);
        {   const int nwg = (M / 256) * (FF2 / 256), R = (nwg + F.G - 1) / F.G, nfull = nwg - (R - 1) * F.G, nh = F.G - nfull;
            int th_ = threadIdx.x; asm volatile("" : "+v"(th_)); const int laneh = th_ & 63, waveh = __builtin_amdgcn_readfirstlane(th_ >> 6);
            LAS float* scr = (LAS float*)(F.lds + RING_OFF + waveh * 16384);
            if (nh == 0) convert_items(P, WI_WDN1, WI_WAB, c * NWAVES + waveh, F.G * NWAVES, scr, laneh);
            else if (c >= nfull) convert_items(P, WI_WDN1, WI_WAB, (c - nfull) * NWAVES + waveh, nh * NWAVES, scr, laneh); } }
    GRID_BAR();
    PH_END(1);
    {   pg8::Gemm g{WSP(b16, WS_R), WSP(b16, WS_WDN1), MP, DM, FF}; pg8::StaticOrder S; S.init(MP, DM, F.G, c);
        pg8::EpiResid<0> E{WSP(b16, WS_XB), WSP(float, WS_SSP1), nullptr};
        pg8::gemm_phase<pg8::EpiResid<0>, pg8::StaticOrder, true, true>(F.lds + RING_OFF, g, S, E);
        for (int blk = c; blk < 256; blk += F.G) micro_resid<0, FF>(F.lds + RING_OFF, blk, WSP(b16, WS_R), WSP(b16, WS_WDN1), WSP(b16, WS_XB), WSP(float, WS_SSP1), nullptr); }
    GRID_BAR();
    PH_END(2);
    {   pg8::Gemm g{WSP(b16, WS_XB), WSP(b16, WS_WIN), M, INW, DM}; pg8::StaticOrder S; S.init(M, INW, F.G, c);
        pg8::EpiIn E{WSP(float, WS_SSP1), WSP(b16, WS_Q), WSP(b16, WS_K), WSP(b16, WS_V), WSP(float, WS_U), WSP(b16, WS_GA), WSP(b16, WS_GB), P.qn, P.kn, P.out};
        pg8::gemm_phase<pg8::EpiIn, pg8::StaticOrder, true, true>(F.lds + RING_OFF, g, S, E); }
    GRID_BAR();
    PH_END(3);
    {   int tid_ = threadIdx.x; asm volatile("" : "+v"(tid_));
        const int lane = tid_ & 63, wave = __builtin_amdgcn_readfirstlane(tid_ >> 6);
        const unsigned long long tq0_ = (PROBE_AMP >= 40) ? __builtin_amdgcn_s_memrealtime() : 0ull;
#define SUBAMP(k) do { if (PROBE_AMP == (k)) { const unsigned long long tq1_ = __builtin_amdgcn_s_memrealtime(); while (__builtin_amdgcn_s_memrealtime() < tq1_ + 2 * (tq1_ - tq0_)) __builtin_amdgcn_s_sleep(8); } } while (0)
        constexpr int CC_SPLIT = (CC_TOTAL * 55) / 100;
        LAS unsigned char* wl = F.lds + RING_OFF + wave * ATT_WLDS;
        const bf16* Qb = WSP(const bf16, WS_Q); const bf16* Kb = WSP(const bf16, WS_K); const bf16* Vb = WSP(const bf16, WS_V); bf16* AA = WSP(bf16, WS_AA);
        const float* BIAS = WSP(const float, WS_BIAS);
        if (wave < 4) {
            const int cw = F.vcu * 4 + wave, NCW = F.G * 4;
            for (int up = cw; up < NBATCH * 8 * 4 * 8; up += NCW) {
                const int unit0 = ((up >> 3) << 4) + (up & 7);
                attn_build_tables(BIAS, (unit0 >> 4) & 3, (LAS float*)(wl + ATT_TB_OFF), (LAS float*)wl, lane);
#pragma unroll 1
                for (int k2 = 0; k2 < 2; ++k2) attn_prompt_unit(unit0 + 8 * k2, Qb, Kb, Vb, AA, wl, lane);
            }
            SUBAMP(40);
            int lane3 = threadIdx.x; asm volatile("" : "+v"(lane3)); lane3 &= 63;
            copy_chunks(P, CC_SPLIT, CC_TOTAL, cw, NCW, lane3);
        } else {
            const int mw = F.vcu * 4 + (wave - 4), NMW = F.G * 4;
            pool_items(P, WSP(const float, WS_U), WSP(bf16, WS_AA), mw, NMW, lane);
            weff_items(P, mw, NMW, lane);
            convert_items(P, WI_WAB, WI_END, mw, NMW, (LAS float*)wl, lane);
            int lane3 = threadIdx.x; asm volatile("" : "+v"(lane3)); lane3 &= 63;
            for (int su = mw; su < DBATCH * 4 * DSEQ; su += NMW) attn_sample_unit(su, P, Qb, AA, BIAS, wl, lane3);
            SUBAMP(41);
            int lane4 = threadIdx.x; asm volatile("" : "+v"(lane4)); lane4 &= 63;
            copy_chunks(P, 0, CC_SPLIT, mw, NMW, lane4);
        }
    }
    GRID_BAR();
    PH_END(4);
    {   pg8::Gemm g{WSP(b16, WS_AA), WSP(b16, WS_WAB), MP, DM, ADW}; pg8::StaticOrder S; S.init(MP, DM, F.G, c);
        pg8::EpiMergeFused E{WSP(b16, WS_GA), WSP(b16, WS_GB), WSP(b16, WS_MG)};
        pg8::gemm_phase<pg8::EpiMergeFused, pg8::StaticOrder, true, true>(F.lds + RING_OFF, g, S, E);
        for (int blk = c; blk < 256; blk += F.G) micro_merge(F.lds + RING_OFF, blk, WSP(b16, WS_AA), WSP(b16, WS_WAB), WSP(b16, WS_AA) + AOW, WSP(b16, WS_WAB) + AOW, WSP(b16, WS_GA), WSP(b16, WS_GB), WSP(b16, WS_MG));
    }
    GRID_BAR();
    PH_END(5);
    {   pg8::Gemm g{WSP(b16, WS_MG), WSP(b16, WS_WOUT), MP, DM, DM}; pg8::StaticOrder S; S.init(MP, DM, F.G, c);
        pg8::EpiResid<1> E{WSP(b16, WS_XB), WSP(float, WS_SSP2), nullptr};
        pg8::gemm_phase<pg8::EpiResid<1>, pg8::StaticOrder, true, true>(F.lds + RING_OFF, g, S, E);
        for (int blk = c; blk < 256; blk += F.G) micro_resid<1, DM>(F.lds + RING_OFF, blk, WSP(b16, WS_MG), WSP(b16, WS_WOUT), WSP(b16, WS_XB), WSP(float, WS_SSP2), nullptr); }
    GRID_BAR();
    PH_END(6);
    {   pg8::Gemm g{WSP(b16, WS_XB), WSP(b16, WS_WUP2), M, FF2, DM}; pg8::StaticOrder S; S.init(M, FF2, F.G, c);
        pg8::EpiSwiglu<true> E{WSP(b16, WS_R), WSP(float, WS_SSP2)};
        pg8::gemm_phase<pg8::EpiSwiglu<true>, pg8::StaticOrder, true, true>(F.lds + RING_OFF, g, S, E); }
    GRID_BAR();
    PH_END(7);
    {   pg8::Gemm g{WSP(b16, WS_R), WSP(b16, WS_WDN2), MP, DM, FF}; pg8::StaticOrder S; S.init(MP, DM, F.G, c);
        pg8::EpiResid<2> E{WSP(b16, WS_XB), nullptr, P.out};
        pg8::gemm_phase<pg8::EpiResid<2>, pg8::StaticOrder, true, true>(F.lds + RING_OFF, g, S, E);
        for (int blk = c; blk < 256; blk += F.G) micro_resid<2, FF>(F.lds + RING_OFF, blk, WSP(b16, WS_R), WSP(b16, WS_WDN2), WSP(b16, WS_XB), nullptr, P.out); }
    PH_END(8);
}

extern "C" void kernel_launch(void* const* d_in, const int* in_sizes, int n_in, void* d_out, int out_size, void* d_ws, size_t ws_size, hipStream_t stream) {
    static int grid = 0;
    if (grid == 0) {
        if (n_in != 22 || (size_t)out_size != O_END || ws_size < WS_END) { fprintf(stderr, "kernel_launch: unexpected shapes (n_in %d, out %d, ws %zu); nothing launched\n", n_in, out_size, ws_size); grid = -1; return; }
        int dev = 0, cus = 0;
        if (hipGetDevice(&dev) != hipSuccess || hipDeviceGetAttribute(&cus, hipDeviceAttributeMultiprocessorCount, dev) != hipSuccess) { grid = -1; return; }
        if (hipFuncSetAttribute((const void*)hybrid_fwd, hipFuncAttributeMaxDynamicSharedMemorySize, LDS_BYTES) != hipSuccess) { fprintf(stderr, "kernel_launch: hipFuncSetAttribute failed\n"); grid = -1; return; }
        (void)hipGetLastError();
        grid = cus;
    }
    if (grid < 0) return;
    if (hipMemsetAsync((char*)d_ws + WS_CTL, 0, CTL_ZERO_BYTES, stream) != hipSuccess) return;
    Args a{};
    const float** pp = (const float**)&a.p;
    for (int i = 0; i < 22; ++i) pp[i] = (const float*)d_in[i];
    a.p.out = (float*)d_out; a.p.ws = (unsigned char*)d_ws;
    hipLaunchKernelGGL(hybrid_fwd, dim3(grid), dim3(NWAVES * 64), LDS_BYTES, stream, a);
}
```
